# Optimizing an MI355X kernel written in HIP

```python
import math, functools
import jax, jax.numpy as jnp
from jax import lax
import numpy as np

D_MODEL = 2048
BATCH = 8
SEQ = 4096
DEPTH = 4

GRID_W = 64
CTX_LEN = 256
CHUNK = 128
VW = 2048
H_R = 8
R_DK = 128
R_DV = VW // H_R
H_M = 8
M_DK = 128
M_DV = VW // H_M
R_QK = H_R * R_DK
M_QK = H_M * M_DK
N_GATES = 4 * H_M
IN_SIZES = (R_QK, R_QK, VW, VW, M_QK, M_QK, VW, VW, N_GATES, 2 * D_MODEL)
IN_COLS = 2 * R_QK + 2 * VW + 2 * M_QK + 2 * VW + N_GATES + 2 * D_MODEL
D_FF = 5632
CONV_W = 3
N_MOD = 6
ROPE_BASE = 10000.0
EPS = 1e-6

kernel_name = 'hybrid_retention_mlstm_convffn_dit'


def rms_norm(x, g):
    xf = x.astype(jnp.float32)
    y = xf * lax.rsqrt(jnp.mean(xf * xf, axis=-1, keepdims=True) + EPS)
    return (y * g.astype(jnp.float32)).astype(x.dtype)


def head_rms(y, g):
    H, d = y.shape[1], y.shape[3]
    y = y * lax.rsqrt(jnp.mean(y * y, axis=-1, keepdims=True) + EPS)
    return y * g.astype(jnp.float32).reshape(H, 1, d)


def modulate(h, shift, scale):
    return h * (1 + scale) + shift


def dwconv(x, w, b):
    T = x.shape[1]
    half = w.shape[0] // 2
    xp = jnp.pad(x, ((0, 0), (half, half), (0, 0)))
    out = b
    for k in range(w.shape[0]):
        out = out + xp[:, k:k + T] * w[k]
    return out


def split_cols(p, sizes):
    offs, o = [], 0
    for s in sizes[:-1]:
        o += s
        offs.append(o)
    return jnp.split(p, offs, axis=-1)


def split_heads(x, h):
    B, T, _ = x.shape
    return x.reshape(B, T, h, -1).transpose(0, 2, 1, 3)


def merge_heads(x):
    B, H, T, d = x.shape
    return x.transpose(0, 2, 1, 3).reshape(B, T, H * d)


def rope_1d(x, pos):
    half = x.shape[-1] // 2
    freqs = ROPE_BASE ** (-jnp.arange(half, dtype=jnp.float32) / half)
    ang = pos[:, None] * freqs[None, :]
    cos, sin = jnp.cos(ang).astype(x.dtype), jnp.sin(ang).astype(x.dtype)
    x1, x2 = x[..., :half], x[..., half:]
    return jnp.concatenate([x1 * cos - x2 * sin, x1 * sin + x2 * cos], axis=-1)


def axial_rope(x, rows, cols):
    half = x.shape[-1] // 2
    return jnp.concatenate([rope_1d(x[..., :half], rows), rope_1d(x[..., half:], cols)], axis=-1)


def to_chunks(a):
    B, H, T = a.shape[:3]
    a = a.reshape((B, H, T // CHUNK, CHUNK) + a.shape[3:])
    return jnp.moveaxis(a, 2, 0)


def from_chunks(a):
    a = jnp.moveaxis(a, 0, 2)
    B, H, N, L = a.shape[:4]
    return a.reshape((B, H, N * L) + a.shape[4:])


def retention_scan(q, k, v, state0, log_gamma):
    q, k, v = (a.astype(jnp.float32) for a in (q, k, v))
    idx = jnp.arange(CHUNK, dtype=jnp.float32)
    lg = log_gamma.astype(jnp.float32)[:, None, None]
    rel = idx[:, None] - idx[None, :]
    intra = jnp.where(rel >= 0, jnp.exp(jnp.maximum(rel, 0.0) * lg), 0.0)
    q_dec = jnp.exp((idx + 1.0)[:, None] * lg)
    k_dec = jnp.exp((CHUNK - 1.0 - idx)[:, None] * lg)
    chunk_dec = jnp.exp(CHUNK * lg)

    def step(S, inp):
        qc, kc, vc = inp
        s = jnp.einsum('bhid,bhjd->bhij', qc, kc) * intra
        y = jnp.einsum('bhij,bhjv->bhiv', s, vc) + jnp.einsum('bhid,bhdv->bhiv', qc * q_dec, S)
        S = chunk_dec * S + jnp.einsum('bhjd,bhjv->bhdv', kc * k_dec, vc)
        return S, y

    S, ys = lax.scan(step, state0, (to_chunks(q), to_chunks(k), to_chunks(v)))
    return from_chunks(ys), S


def mlstm_scan(q, k, v, ig, lf, state0):
    q, k, v = (a.astype(jnp.float32) for a in (q, k, v))
    causal = jnp.tril(jnp.ones((CHUNK, CHUNK), dtype=bool))

    def step(carry, inp):
        C, n, m = carry
        qc, kc, vc, ic, fc = inp
        b = jnp.cumsum(fc, axis=-1)
        d = jnp.where(causal, b[..., :, None] - b[..., None, :] + ic[..., None, :], -jnp.inf)
        inter = b + m[..., None]
        m_t = jnp.maximum(d.max(axis=-1), inter)
        s = jnp.einsum('bhid,bhjd->bhij', qc, kc) * jnp.exp(d - m_t[..., None])
        a = jnp.exp(inter - m_t)
        num = jnp.einsum('bhij,bhjv->bhiv', s, vc) + a[..., None] * jnp.einsum('bhid,bhdv->bhiv', qc, C)
        den = s.sum(axis=-1) + a * jnp.einsum('bhid,bhd->bhi', qc, n)
        h = num / jnp.maximum(jnp.abs(den), jnp.exp(-m_t))[..., None]
        b_end = b[..., -1]
        loc = b_end[..., None] - b + ic
        m_new = jnp.maximum(b_end + m, loc.max(axis=-1))
        w = jnp.exp(loc - m_new[..., None])
        decay = jnp.exp(b_end + m - m_new)
        C = decay[..., None, None] * C + jnp.einsum('bhj,bhjd,bhjv->bhdv', w, kc, vc)
        n = decay[..., None] * n + jnp.einsum('bhj,bhjd->bhd', w, kc)
        return (C, n, m_new), h

    state, hs = lax.scan(step, state0, tuple(to_chunks(a) for a in (q, k, v, ig, lf)))
    return from_chunks(hs), state


def run_bidirectional(scan_f, scan_b, init, ctx_f, lat_f, ctx_b, lat_b):
    rev = lambda xs: tuple(jnp.flip(a, axis=2) for a in xs)
    yc_f, st_f = scan_f(*ctx_f, init)
    yl_f, _ = scan_f(*lat_f, st_f)
    yc_b, st_b = scan_b(*rev(ctx_b), init)
    yl_b, _ = scan_b(*rev(lat_b), st_b)
    return yc_f + jnp.flip(yc_b, axis=2), yl_f + jnp.flip(yl_b, axis=2)


def project_stream(h, w_in, conv_w, conv_b, gate_b, rope_pos):
    B, T, _ = h.shape
    rq, rk, rv, rg, mq, mk, mv, mo, mg, merge = split_cols(h @ w_in, IN_SIZES)
    mqk = jax.nn.silu(dwconv(jnp.concatenate([mq, mk], axis=-1), conv_w, conv_b))
    mq, mk = mqk[..., :M_QK], mqk[..., M_QK:]
    rq = split_heads(rq, H_R) * (R_DK ** -0.5)
    rk = split_heads(rk, H_R)
    if rope_pos is not None:
        rq = axial_rope(rq, *rope_pos)
        rk = axial_rope(rk, *rope_pos)
    ret = (rq, rk, split_heads(rv, H_R))
    gates = (mg.astype(jnp.float32) + gate_b.astype(jnp.float32).reshape(-1))
    gates = gates.reshape(B, T, 4, H_M).transpose(2, 0, 3, 1)
    mq_h = split_heads(mq, H_M) * (M_DK ** -0.5)
    mk_h = split_heads(mk, H_M)
    mv_h = split_heads(mv, H_M)
    ml_f = (mq_h, mk_h, mv_h, gates[0], jax.nn.log_sigmoid(gates[1]))
    ml_b = (mq_h, mk_h, mv_h, gates[2], jax.nn.log_sigmoid(gates[3]))
    return ret, ml_f, ml_b, (rg, mo, merge)


def branch_merge(yr, ym, gates, head_norm_w, w_ret_out, w_mlstm_out, w_o, dtype):
    rg, mo, merge = gates
    yr = merge_heads(head_rms(yr, head_norm_w[0])).astype(dtype) * jax.nn.silu(rg)
    ym = merge_heads(head_rms(ym, head_norm_w[1])).astype(dtype) * jax.nn.sigmoid(mo)
    gr, gm = jnp.split(merge, 2, axis=-1)
    y = jax.nn.sigmoid(gr) * (yr @ w_ret_out) + jax.nn.sigmoid(gm) * (ym @ w_mlstm_out)
    return y @ w_o


def token_mixer(hc, hl, w_in, conv_w, conv_b, gate_b, decay_exp, head_norm_w,
                w_ret_out, w_mlstm_out, w_o, rope_pos, with_ctx_out):
    ret_c, mf_c, mb_c, g_c = project_stream(hc, w_in, conv_w, conv_b, gate_b, None)
    ret_l, mf_l, mb_l, g_l = project_stream(hl, w_in, conv_w, conv_b, gate_b, rope_pos)
    B = hl.shape[0]
    log_gamma = jnp.log1p(-jnp.exp2(-decay_exp.astype(jnp.float32)))
    r_init = jnp.zeros((B, H_R, R_DK, R_DV), jnp.float32)
    yr_c, yr_l = run_bidirectional(functools.partial(retention_scan, log_gamma=log_gamma[0]),
                                   functools.partial(retention_scan, log_gamma=log_gamma[1]),
                                   r_init, ret_c, ret_l, ret_c, ret_l)
    m_init = (jnp.zeros((B, H_M, M_DK, M_DV), jnp.float32),
              jnp.zeros((B, H_M, M_DK), jnp.float32),
              jnp.zeros((B, H_M), jnp.float32))
    ym_c, ym_l = run_bidirectional(mlstm_scan, mlstm_scan, m_init, mf_c, mf_l, mb_c, mb_l)
    out_l = branch_merge(yr_l, ym_l, g_l, head_norm_w, w_ret_out, w_mlstm_out, w_o, hl.dtype)
    out_c = None
    if with_ctx_out:
        out_c = branch_merge(yr_c, ym_c, g_c, head_norm_w, w_ret_out, w_mlstm_out, w_o, hc.dtype)
    return out_c, out_l


def conv_ffn(h, w_up, conv_w, conv_b, w_down):
    u = dwconv(h @ w_up, conv_w, conv_b)
    a, g = jnp.split(u, 2, axis=-1)
    return (jax.nn.silu(a) * g) @ w_down


def setup_inputs(seed: int = 0) -> dict:
    key = jax.random.key(seed)
    ks = jax.random.split(key, 20)
    f32 = jnp.float32
    nrm = lambda k, shape, s: jax.random.normal(k, shape, f32) * s
    gate_base = jnp.stack([jnp.zeros((H_M,), f32), jnp.linspace(3.0, 6.0, H_M, dtype=f32),
                           jnp.zeros((H_M,), f32), jnp.linspace(3.0, 6.0, H_M, dtype=f32)])
    decay_base = 5.0 + jnp.arange(H_R, dtype=f32)
    return {
        'x': nrm(ks[0], (BATCH, SEQ, D_MODEL), 1.0),
        'c': nrm(ks[1], (BATCH, D_MODEL), 1.0),
        'ctx': nrm(ks[2], (BATCH, CTX_LEN, D_MODEL), 1.0),
        'c_ctx': nrm(ks[3], (D_MODEL,), 1.0),
        'w_ada': nrm(ks[4], (DEPTH, D_MODEL, N_MOD * D_MODEL), 0.5 * D_MODEL ** -0.5),
        'b_ada': nrm(ks[5], (DEPTH, N_MOD * D_MODEL), 0.02),
        'norm_w': 1.0 + nrm(ks[6], (DEPTH, 4, D_MODEL), 0.02),
        'w_in': nrm(ks[7], (DEPTH, D_MODEL, IN_COLS), D_MODEL ** -0.5),
        'mlstm_conv_w': nrm(ks[8], (DEPTH, CONV_W, 2 * M_QK), CONV_W ** -0.5),
        'mlstm_conv_b': nrm(ks[9], (DEPTH, 2 * M_QK), 0.02),
        'mlstm_gate_b': gate_base[None] + nrm(ks[10], (DEPTH, 4, H_M), 0.1),
        'ret_decay_exp': decay_base[None, None] + nrm(ks[11], (DEPTH, 2, H_R), 0.1),
        'head_norm_w': 1.0 + nrm(ks[12], (DEPTH, 2, VW), 0.02),
        'w_ret_out': nrm(ks[13], (DEPTH, VW, D_MODEL), VW ** -0.5),
        'w_mlstm_out': nrm(ks[14], (DEPTH, VW, D_MODEL), VW ** -0.5),
        'w_o': nrm(ks[15], (DEPTH, D_MODEL, D_MODEL), D_MODEL ** -0.5),
        'w_up': nrm(ks[16], (DEPTH, D_MODEL, 2 * D_FF), D_MODEL ** -0.5),
        'ffn_conv_w': nrm(ks[17], (DEPTH, CONV_W, 2 * D_FF), CONV_W ** -0.5),
        'ffn_conv_b': nrm(ks[18], (DEPTH, 2 * D_FF), 0.02),
        'w_down': nrm(ks[19], (DEPTH, D_FF, D_MODEL), D_FF ** -0.5),
    }


def reference(x, c, ctx, c_ctx, w_ada, b_ada, norm_w, w_in, mlstm_conv_w, mlstm_conv_b,
              mlstm_gate_b, ret_decay_exp, head_norm_w, w_ret_out, w_mlstm_out, w_o,
              w_up, ffn_conv_w, ffn_conv_b, w_down):
    T = x.shape[1]
    ROWS = T // GRID_W
    rows = jnp.repeat(jnp.arange(ROWS, dtype=jnp.float32), GRID_W)
    cols = jnp.tile(jnp.arange(GRID_W, dtype=jnp.float32), ROWS)
    s_c = jax.nn.silu(c)
    s_cc = jax.nn.silu(c_ctx)
    xl, xc = x, ctx
    for l in range(DEPTH):
        last = l == DEPTH - 1
        sh1, sc1, g1, sh2, sc2, g2 = jnp.split((s_c @ w_ada[l] + b_ada[l])[:, None, :], N_MOD, axis=-1)
        csh1, csc1, cg1, csh2, csc2, cg2 = jnp.split(s_cc @ w_ada[l] + b_ada[l], N_MOD, axis=-1)
        hl = modulate(rms_norm(xl, norm_w[l, 0]), sh1, sc1)
        hc = modulate(rms_norm(xc, norm_w[l, 0]), csh1, csc1)
        out_c, out_l = token_mixer(hc, hl, w_in[l], mlstm_conv_w[l], mlstm_conv_b[l], mlstm_gate_b[l],
                                   ret_decay_exp[l], head_norm_w[l], w_ret_out[l], w_mlstm_out[l], w_o[l],
                                   (rows, cols), not last)
        xl = xl + g1 * rms_norm(out_l, norm_w[l, 1])
        hl = modulate(rms_norm(xl, norm_w[l, 2]), sh2, sc2)
        xl = xl + g2 * rms_norm(conv_ffn(hl, w_up[l], ffn_conv_w[l], ffn_conv_b[l], w_down[l]), norm_w[l, 3])
        if not last:
            xc = xc + cg1 * rms_norm(out_c, norm_w[l, 1])
            hc = modulate(rms_norm(xc, norm_w[l, 2]), csh2, csc2)
            xc = xc + cg2 * rms_norm(conv_ffn(hc, w_up[l], ffn_conv_w[l], ffn_conv_b[l], w_down[l]), norm_w[l, 3])
    return xl
```

```cpp
#include <hip/hip_runtime.h>
#include <cstdio>
#include <cstdint>

namespace pg8 {
#define PG8_LAS __attribute__((address_space(3)))
typedef unsigned short bf16_t;
typedef short bf16x8 __attribute__((ext_vector_type(8)));
typedef float f32x4 __attribute__((ext_vector_type(4)));
typedef unsigned u32x4 __attribute__((ext_vector_type(4)));
constexpr int BM = 256, BK = 64, HALF = 128, HTB = HALF * BK * 2  , STAGE_BYTES = 8 * HTB, NXCD = 8, WGM = 4;

__host__ __device__ __forceinline__ int lds_byte(int r, int c) { const int st = (r >> 4) * 2 + (c >> 5), rr = r & 15, cc = c & 31, ob = rr * 64 + cc * 2; return st * 1024 + (ob ^ (((ob >> 9) & 1) << 5)); }
__host__ __device__ __forceinline__ void stage_rc(int b, int& R, int& C) { const int st = b / 1024, sb = b % 1024, swz = sb ^ (((sb >> 9) & 1) << 5); R = (st >> 1) * 16 + swz / 64; C = (st & 1) * 32 + (swz % 64) / 2; }
__host__ __device__ __forceinline__ int perm32(int rho) { const int n = rho >> 4, i = rho & 15; return 8 * (i >> 2) + 4 * n + (i & 3); }

struct Unit { int pm, pn, flag; };
struct Gemm { const bf16_t* A; const bf16_t* Bt; int M, N, K; };

struct StaticOrder {
    int nM, nN, nwg, G, c, skip, wgm;
    int sig, xpm, xpn;
    __host__ __device__ void init(int M, int N, int G_, int c_, int skip_ = 0, int wgm_ = WGM) { nM = M / BM; nN = N / BM; nwg = nM * nN; G = G_; c = c_; skip = skip_; wgm = wgm_; sig = 0; xpm = 0; xpn = -1; }
    __host__ __device__ bool next(int i, Unit& u) const {
        const long L = (long)i * G + c; u.flag = (sig && L + G >= nwg) ? 1 : 0;
        if (L >= nwg) { if (xpn >= 0 && L < nwg + G) { u.pm = xpm; u.pn = xpn; u.flag = 2; return true; } return false; }
        int wgid = (int)L; { const int q = nwg / NXCD, r = nwg % NXCD, xcd = wgid % NXCD, off = wgid / NXCD; wgid = (xcd < r ? xcd * (q + 1) : r * (q + 1) + (xcd - r) * q) + off; }
        const int nig = wgm * nN, gid = wgid / nig, fm = gid * wgm, gsz = (nM - fm) < wgm ? (nM - fm) : wgm;
        u.pm = fm + ((wgid % nig) % gsz); u.pn = (wgid % nig) / gsz; if (skip) u.pm += (u.pm >> 4) + 1; return true;
    }
    __device__ __forceinline__ void a_ready(const Unit&) const {}
    __device__ __forceinline__ void done(const Unit&) const {}
};
__device__ __forceinline__ unsigned pk2(float lo, float hi) {
    typedef __bf16 b2_t __attribute__((ext_vector_type(2))); typedef float f2_t __attribute__((ext_vector_type(2)));
    f2_t f = {lo, hi}; b2_t b = __builtin_convertvector(f, b2_t); return __builtin_bit_cast(unsigned, b); }
__device__ __forceinline__ float bflo(unsigned w) { return __uint_as_float(w << 16); }
__device__ __forceinline__ float bfhi(unsigned w) { return __uint_as_float(w & 0xffff0000u); }
typedef float f32x2_t __attribute__((ext_vector_type(2)));
__device__ __forceinline__ f32x2_t sigmoid2(f32x2_t x) { const f32x2_t t = x * -1.4426950408889634f; const f32x2_t d = (f32x2_t){__builtin_amdgcn_exp2f(t.x), __builtin_amdgcn_exp2f(t.y)} + 1.0f;
    return (f32x2_t){__builtin_amdgcn_rcpf(d.x), __builtin_amdgcn_rcpf(d.y)}; }
__device__ __forceinline__ unsigned pk2v(f32x2_t f) { typedef __bf16 b2_t __attribute__((ext_vector_type(2))); return __builtin_bit_cast(unsigned, __builtin_convertvector(f, b2_t)); }

#define PG8_DPP(old, src, ctrl) __builtin_bit_cast(float, __builtin_amdgcn_update_dpp(__builtin_bit_cast(int, (float)(old)), __builtin_bit_cast(int, (float)(src)), (ctrl), 0xf, 0xf, false))
struct EpiPlain {
    static constexpr bool PERM = true, AFTER_DRAIN = false, PERMA = false;
    bf16_t* O; int ldc; unsigned* cnt_lat; unsigned* cnt_ctx;
    __device__ __forceinline__ void operator()(const f32x4 (&acc)[2][2][4][2], const Unit& u, int wr, int wc, int fr, int fq) const {
        const int row0 = u.pm * BM + wr * 64 + fr, col0 = u.pn * BM + wc * 32 + 8 * fq;
#pragma unroll
        for (int ai = 0; ai < 2; ++ai)
#pragma unroll
            for (int m = 0; m < 4; ++m) { bf16_t* rowp = O + (size_t)(row0 + ai * HALF + m * 16) * ldc + col0;
#pragma unroll
                for (int bj = 0; bj < 2; ++bj) { const f32x4 v0 = acc[ai][bj][m][0], v1 = acc[ai][bj][m][1];
                    u32x4 w; w.x = pk2(v0[0], v0[1]); w.y = pk2(v0[2], v0[3]); w.z = pk2(v1[0], v1[1]); w.w = pk2(v1[2], v1[3]);
                    *(u32x4*)(rowp + bj * HALF) = w; } }
        if (u.flag) { asm volatile("s_waitcnt vmcnt(0)" ::: "memory"); __builtin_amdgcn_s_barrier();
            if (wr == 0 && wc == 0 && fr == 0 && fq == 0) { __builtin_amdgcn_fence(__ATOMIC_RELEASE, "agent"); asm volatile("s_waitcnt vmcnt(0)" ::: "memory");
                (void)__hip_atomic_fetch_add(u.flag == 1 ? cnt_lat : cnt_ctx, 1u, __ATOMIC_RELAXED, __HIP_MEMORY_SCOPE_AGENT); } }
    }
};
struct EpiProj1 {
    static constexpr bool PERM = true, AFTER_DRAIN = false, PERMA = false;
    bf16_t* O; float* gates; const float* gate_b; const float* ropeC; const float* ropeS;
    bf16_t* MQK; bf16_t* RAWQ; const float* cw; const float* cb; PG8_LAS float* EX;
    __device__ __forceinline__ void operator()(const f32x4 (&acc)[2][2][4][2], const Unit& u, int wr, int wc, int fr, int fq) const {
        const int row0 = u.pm * BM + wr * 64 + fr;
        if (u.pn >= 16 && u.pn < 24) {
            const int chb = (u.pn - 16) * BM + wc * 32 + 8 * fq;
            const float scl = u.pn < 20 ? 0.08838834764831845f : 1.0f;
#pragma unroll
            for (int ai = 0; ai < 2; ++ai) { const int blk = 2 * ai + wr;
                if (fr == 0) {
#pragma unroll
                    for (int bj = 0; bj < 2; ++bj)
#pragma unroll
                        for (int n = 0; n < 2; ++n) *(PG8_LAS f32x4*)(EX + (((wc * 8 + 2 * blk) * 4 + fq) * 16 + bj * 8 + n * 4)) = acc[ai][bj][0][n]; }
                if (fr == 15) {
#pragma unroll
                    for (int bj = 0; bj < 2; ++bj)
#pragma unroll
                        for (int n = 0; n < 2; ++n) *(PG8_LAS f32x4*)(EX + (((wc * 8 + 2 * blk + 1) * 4 + fq) * 16 + bj * 8 + n * 4)) = acc[ai][bj][3][n]; } }
            if (wr == 0 && fr < 2) {
#pragma unroll
                for (int bj = 0; bj < 2; ++bj) { const f32x4 v0 = acc[0][bj][0][0], v1 = acc[0][bj][0][1];
                    u32x4 w; w.x = pk2(v0[0], v0[1]); w.y = pk2(v0[2], v0[3]); w.z = pk2(v1[0], v1[1]); w.w = pk2(v1[2], v1[3]);
                    *(u32x4*)(RAWQ + ((size_t)u.pm * 4 + fr) * 2048 + bj * HALF + chb) = w; } }
            if (wr == 1 && fr >= 14) {
#pragma unroll
                for (int bj = 0; bj < 2; ++bj) { const f32x4 v0 = acc[1][bj][3][0], v1 = acc[1][bj][3][1];
                    u32x4 w; w.x = pk2(v0[0], v0[1]); w.y = pk2(v0[2], v0[3]); w.z = pk2(v1[0], v1[1]); w.w = pk2(v1[2], v1[3]);
                    *(u32x4*)(RAWQ + ((size_t)u.pm * 4 + 2 + (fr - 14)) * 2048 + bj * HALF + chb) = w; } }
            asm volatile("s_waitcnt lgkmcnt(0)" ::: "memory"); __builtin_amdgcn_s_barrier(); asm volatile("" ::: "memory");
#pragma unroll
            for (int bj = 0; bj < 2; ++bj)
#pragma unroll
                for (int n = 0; n < 2; ++n) {
                    const int c4 = chb + bj * HALF + 4 * n;
                    const f32x4 w0 = *(const f32x4*)(cw + c4), w1 = *(const f32x4*)(cw + 2048 + c4), w2 = *(const f32x4*)(cw + 4096 + c4), bb = *(const f32x4*)(cb + c4);
#pragma unroll
                    for (int ai = 0; ai < 2; ++ai) { const int blk = 2 * ai + wr;
                        const f32x4 pe = (blk == 0) ? (f32x4){0.f, 0.f, 0.f, 0.f} : *(const PG8_LAS f32x4*)(EX + (((wc * 8 + 2 * blk - 1) * 4 + fq) * 16 + bj * 8 + n * 4));
                        const f32x4 ne = (blk == 3) ? (f32x4){0.f, 0.f, 0.f, 0.f} : *(const PG8_LAS f32x4*)(EX + (((wc * 8 + 2 * blk + 2) * 4 + fq) * 16 + bj * 8 + n * 4));
#pragma unroll
                        for (int m = 0; m < 4; ++m) { float o[4];
#pragma unroll
                            for (int e = 0; e < 4; ++e) { const float cur = acc[ai][bj][m][n][e];
                                const float oldp = (m == 0) ? pe[e] : PG8_DPP(0.f, acc[ai][bj][m == 0 ? 0 : m - 1][n][e], 0x121);
                                const float prev = PG8_DPP(oldp, cur, 0x111);
                                const float oldn = (m == 3) ? ne[e] : PG8_DPP(0.f, acc[ai][bj][m == 3 ? 3 : m + 1][n][e], 0x12f);
                                const float next = PG8_DPP(oldn, cur, 0x101);
                                const float cv = bb[e] + w0[e] * prev + w1[e] * cur + w2[e] * next;
                                o[e] = (cv * __builtin_amdgcn_rcpf(1.0f + __expf(-cv))) * scl; }
                            typedef unsigned u32x2_t __attribute__((ext_vector_type(2)));
                            u32x2_t w; w.x = pk2(o[0], o[1]); w.y = pk2(o[2], o[3]);
                            *(u32x2_t*)(MQK + (size_t)(row0 + ai * HALF + m * 16) * 2048 + c4) = w; } } }
            return;
        }
        if (u.pn == 32) {
            if (wc == 0) { const f32x4 g0 = *(const f32x4*)(gate_b + 8 * fq), g1 = *(const f32x4*)(gate_b + 8 * fq + 4);
#pragma unroll
                for (int ai = 0; ai < 2; ++ai)
#pragma unroll
                    for (int m = 0; m < 4; ++m) { float* gp = gates + (size_t)(row0 + ai * HALF + m * 16) * 32 + 8 * fq;
                        *(f32x4*)gp = acc[ai][0][m][0] + g0; *(f32x4*)(gp + 4) = acc[ai][0][m][1] + g1; } }
            return;
        }
        const int col0 = u.pn * BM + wc * 32 + 8 * fq;
        const bool roped = (u.pn < 8) && ((u.pm % 17) != 0);
        const float sc = (u.pn < 4) ? 0.08838834764831845f : 1.0f;
        const int tbase = (u.pm % 17) * 256 - 256 + wr * 64 + fr;
        const int p0 = (wc & 1) * 16 + 4 * fq, blk = wc >> 1;
#pragma unroll
        for (int ai = 0; ai < 2; ++ai) {
#pragma unroll
          for (int mh = 0; mh < 2; ++mh) {
            f32x4 c4v[4], s4v[4];
#pragma unroll
            for (int m = 2 * mh; m < 2 * mh + 2; ++m) { c4v[m] = (f32x4){1.f, 1.f, 1.f, 1.f}; s4v[m] = (f32x4){0.f, 0.f, 0.f, 0.f};
                if (roped) { const int t = tbase + ai * HALF + m * 16; const int pos = blk ? (t & 63) : (t >> 6);
                    c4v[m] = *(const f32x4*)(ropeC + pos * 32 + p0); s4v[m] = *(const f32x4*)(ropeS + pos * 32 + p0); } }
#pragma unroll
            for (int m = 2 * mh; m < 2 * mh + 2; ++m) { bf16_t* rowp = O + (size_t)(row0 + ai * HALF + m * 16) * 8192 + col0;
                const f32x4 c4 = c4v[m], s4 = s4v[m];
#pragma unroll
                for (int bj = 0; bj < 2; ++bj) { f32x4 v0 = acc[ai][bj][m][0] * sc, v1 = acc[ai][bj][m][1] * sc;
                    const f32x4 r0 = (f32x4){v0[0] * c4[0] - v0[1] * s4[0], v0[0] * s4[0] + v0[1] * c4[0], v0[2] * c4[1] - v0[3] * s4[1], v0[2] * s4[1] + v0[3] * c4[1]};
                    const f32x4 r1 = (f32x4){v1[0] * c4[2] - v1[1] * s4[2], v1[0] * s4[2] + v1[1] * c4[2], v1[2] * c4[3] - v1[3] * s4[3], v1[2] * s4[3] + v1[3] * c4[3]};
                    u32x4 w; w.x = pk2(r0[0], r0[1]); w.y = pk2(r0[2], r0[3]); w.z = pk2(r1[0], r1[1]); w.w = pk2(r1[2], r1[3]);
                    *(u32x4*)(rowp + bj * HALF) = w; } }
          }
        }
    }
};
template <bool ACCUM> struct EpiGate {
    static constexpr bool PERM = true, AFTER_DRAIN = false, PERMA = false;
    bf16_t* Y; int ldc; const bf16_t* Gt; int ldg;
    __device__ __forceinline__ void operator()(const f32x4 (&acc)[2][2][4][2], const Unit& u, int wr, int wc, int fr, int fq) const {
        const int row0 = u.pm * BM + wr * 64 + fr, col0 = u.pn * BM + wc * 32 + 8 * fq;
        u32x4 gall[2][4][2];
        if (!ACCUM) {
#pragma unroll
            for (int ai = 0; ai < 2; ++ai)
#pragma unroll
                for (int m = 0; m < 4; ++m)
#pragma unroll
                    for (int bj = 0; bj < 2; ++bj) gall[ai][m][bj] = *(const u32x4*)(Gt + (size_t)(row0 + ai * HALF + m * 16) * ldg + col0 + bj * HALF); }
#pragma unroll
        for (int ai = 0; ai < 2; ++ai) {
            u32x4 gwv[4][2], ywv[4][2];
#pragma unroll
            for (int m = 0; m < 4; ++m)
#pragma unroll
                for (int bj = 0; bj < 2; ++bj) { const size_t row = (size_t)(row0 + ai * HALF + m * 16);
                    if (ACCUM) { gwv[m][bj] = *(const u32x4*)(Gt + row * ldg + col0 + bj * HALF); ywv[m][bj] = *(const u32x4*)(Y + row * ldc + col0 + bj * HALF); }
                    else gwv[m][bj] = gall[ai][m][bj]; }
#pragma unroll
            for (int m = 0; m < 4; ++m) { const size_t row = (size_t)(row0 + ai * HALF + m * 16);
#pragma unroll
                for (int bj = 0; bj < 2; ++bj) { const f32x4 v0 = acc[ai][bj][m][0], v1 = acc[ai][bj][m][1];
                    const u32x4 gw = gwv[m][bj];
                    float o[8] = {v0[0], v0[1], v0[2], v0[3], v1[0], v1[1], v1[2], v1[3]};
                    const float g[8] = {bflo(gw.x), bfhi(gw.x), bflo(gw.y), bfhi(gw.y), bflo(gw.z), bfhi(gw.z), bflo(gw.w), bfhi(gw.w)};
#pragma unroll
                    for (int e = 0; e < 8; ++e) o[e] = o[e] * g[e];
                    bf16_t* yp = Y + row * ldc + col0 + bj * HALF;
                    if (ACCUM) { const u32x4 yw = ywv[m][bj];
                        o[0] += bflo(yw.x); o[1] += bfhi(yw.x); o[2] += bflo(yw.y); o[3] += bfhi(yw.y); o[4] += bflo(yw.z); o[5] += bfhi(yw.z); o[6] += bflo(yw.w); o[7] += bfhi(yw.w); }
                    u32x4 w; w.x = pk2(o[0], o[1]); w.y = pk2(o[2], o[3]); w.z = pk2(o[4], o[5]); w.w = pk2(o[6], o[7]);
                    *(u32x4*)yp = w; } }
        }
    }
};

struct EpiMerge {
    static constexpr bool PERM = true, AFTER_DRAIN = false, PERMA = false;
    bf16_t* Y4; size_t slot; const float* hnw; bf16_t* G; int ldg; const float* SS; int mrows; float eps;
    __device__ __forceinline__ void operator()(const f32x4 (&acc)[2][2][4][2], const Unit& u, int wr, int wc, int fr, int fq) const {
        const int row0 = u.pm * BM + wr * 64 + fr;
        if (u.pn >= 16) {
            const int col0 = u.pn * BM + wc * 32 + 8 * fq;
#pragma unroll
            for (int ai = 0; ai < 2; ++ai)
#pragma unroll
                for (int m = 0; m < 4; ++m) { bf16_t* rowp = G + (size_t)(row0 + ai * HALF + m * 16) * ldg + col0;
#pragma unroll
                    for (int bj = 0; bj < 2; ++bj) { const f32x4 v0 = acc[ai][bj][m][0], v1 = acc[ai][bj][m][1];
                        u32x4 w; w.x = pk2v(sigmoid2(__builtin_shufflevector(v0, v0, 0, 1))); w.y = pk2v(sigmoid2(__builtin_shufflevector(v0, v0, 2, 3)));
                        w.z = pk2v(sigmoid2(__builtin_shufflevector(v1, v1, 0, 1))); w.w = pk2v(sigmoid2(__builtin_shufflevector(v1, v1, 2, 3)));
                        *(u32x4*)(rowp + bj * HALF) = w; } }
            return;
        }
        const int br = u.pn >> 3, hh = u.pn & 7, col0 = hh * BM + wc * 32 + 8 * fq;
        bf16_t* Yn = Y4 + (size_t)(2 * br) * slot;
        f32x4 hw[2][2];
#pragma unroll
        for (int bj = 0; bj < 2; ++bj) { hw[bj][0] = *(const f32x4*)(hnw + br * 2048 + col0 + bj * HALF); hw[bj][1] = *(const f32x4*)(hnw + br * 2048 + col0 + bj * HALF + 4); }
        auto half_tile = [&](auto BR) {
#pragma unroll
        for (int am = 0; am < 4; ++am) { const int ai = am >> 1;
            u32x4 yv[2][2]; float ssv[2];
#pragma unroll
            for (int mm = 0; mm < 2; ++mm) { const int m = 2 * (am & 1) + mm; ssv[mm] = SS[(size_t)(br * 8 + hh) * mrows + row0 + ai * HALF + m * 16];
#pragma unroll
                for (int bj = 0; bj < 2; ++bj) yv[mm][bj] = *(const u32x4*)(Yn + (size_t)(row0 + ai * HALF + m * 16) * 2048 + col0 + bj * HALF); }
#pragma unroll
            for (int mm = 0; mm < 2; ++mm) { const int m = 2 * (am & 1) + mm; const size_t ro = (size_t)(row0 + ai * HALF + m * 16) * 2048 + col0;
                const float rstd = __builtin_amdgcn_rsqf(ssv[mm] * (1.0f / 256.0f) + eps);
#pragma unroll
                for (int bj = 0; bj < 2; ++bj) { const u32x4 a = yv[mm][bj]; const unsigned aw[4] = {a.x, a.y, a.z, a.w};
                    const f32x4 g0 = acc[ai][bj][m][0], g1 = acc[ai][bj][m][1];
                    const f32x2_t gp[4] = {__builtin_shufflevector(g0, g0, 0, 1), __builtin_shufflevector(g0, g0, 2, 3), __builtin_shufflevector(g1, g1, 0, 1), __builtin_shufflevector(g1, g1, 2, 3)};
                    const f32x2_t wp[4] = {__builtin_shufflevector(hw[bj][0], hw[bj][0], 0, 1), __builtin_shufflevector(hw[bj][0], hw[bj][0], 2, 3), __builtin_shufflevector(hw[bj][1], hw[bj][1], 0, 1), __builtin_shufflevector(hw[bj][1], hw[bj][1], 2, 3)};
                    unsigned ow[4];
#pragma unroll
                    for (int q = 0; q < 4; ++q) { const f32x2_t y2 = (f32x2_t){bflo(aw[q]), bfhi(aw[q])}; f32x2_t s2 = sigmoid2(gp[q]);
                        if (!decltype(BR)::value) s2 = s2 * gp[q];
                        ow[q] = pk2v((y2 * rstd) * (wp[q] * s2)); }
                    u32x4 w; w.x = ow[0]; w.y = ow[1]; w.z = ow[2]; w.w = ow[3];
                    *(u32x4*)(Yn + ro + bj * HALF) = w; } }
            asm volatile("" ::: "memory");
        }
        };
        if (br) half_tile(std::integral_constant<bool, true>{}); else half_tile(std::integral_constant<bool, false>{});
    }
};

struct EpiConvAct {
    static constexpr bool PERM = true, AFTER_DRAIN = false, PERMA = true;
    bf16_t* ACT; bf16_t* RAW; const float* fw; const float* fb; PG8_LAS float* EX; int FFn, UPNn;
    __device__ __forceinline__ void operator()(const f32x4 (&acc)[2][2][4][2], const Unit& u, int wr, int wc, int fr, int fq) const {
        const int chb = 128 * u.pn + 32 * wc + 8 * fq;
#pragma unroll
        for (int ai = 0; ai < 2; ++ai) { const int blk = 2 * ai + wr;
            if (fr == 0) {
#pragma unroll
                for (int bj = 0; bj < 2; ++bj)
#pragma unroll
                    for (int n = 0; n < 2; ++n) *(PG8_LAS f32x4*)(EX + (((wc * 8 + 2 * blk) * 4 + fq) * 16 + bj * 8 + n * 4)) = acc[ai][bj][0][n]; }
            if (fr == 15) {
#pragma unroll
                for (int bj = 0; bj < 2; ++bj)
#pragma unroll
                    for (int n = 0; n < 2; ++n) *(PG8_LAS f32x4*)(EX + (((wc * 8 + 2 * blk + 1) * 4 + fq) * 16 + bj * 8 + n * 4)) = acc[ai][bj][3][n]; } }
        if (wr == 0 && fr == 0) {
#pragma unroll
            for (int k = 0; k < 2; ++k)
#pragma unroll
                for (int bj = 0; bj < 2; ++bj) { const f32x4 v0 = acc[0][bj][k][0], v1 = acc[0][bj][k][1];
                    u32x4 w; w.x = pk2(v0[0], v0[1]); w.y = pk2(v0[2], v0[3]); w.z = pk2(v1[0], v1[1]); w.w = pk2(v1[2], v1[3]);
                    *(u32x4*)(RAW + ((size_t)u.pm * 4 + k) * UPNn + bj * FFn + chb) = w; } }
        if (wr == 1 && fr == 15) {
#pragma unroll
            for (int k = 0; k < 2; ++k)
#pragma unroll
                for (int bj = 0; bj < 2; ++bj) { const f32x4 v0 = acc[1][bj][2 + k][0], v1 = acc[1][bj][2 + k][1];
                    u32x4 w; w.x = pk2(v0[0], v0[1]); w.y = pk2(v0[2], v0[3]); w.z = pk2(v1[0], v1[1]); w.w = pk2(v1[2], v1[3]);
                    *(u32x4*)(RAW + ((size_t)u.pm * 4 + 2 + k) * UPNn + bj * FFn + chb) = w; } }
        asm volatile("s_waitcnt lgkmcnt(0)" ::: "memory"); __builtin_amdgcn_s_barrier(); asm volatile("" ::: "memory");
        const int row0 = u.pm * BM + wr * 64 + 4 * fr;
#pragma unroll
        for (int n = 0; n < 2; ++n) {
            const int c4 = chb + 4 * n;
            f32x4 w0[2], w1[2], w2[2], bb[2];
#pragma unroll
            for (int bj = 0; bj < 2; ++bj) { w0[bj] = *(const f32x4*)(fw + bj * FFn + c4); w1[bj] = *(const f32x4*)(fw + UPNn + bj * FFn + c4); w2[bj] = *(const f32x4*)(fw + 2 * UPNn + bj * FFn + c4); bb[bj] = *(const f32x4*)(fb + bj * FFn + c4); }
#pragma unroll
            for (int ai = 0; ai < 2; ++ai) { const int blk = 2 * ai + wr;
                f32x4 pe[2], ne[2];
#pragma unroll
                for (int bj = 0; bj < 2; ++bj) {
                    pe[bj] = (blk == 0) ? (f32x4){0.f, 0.f, 0.f, 0.f} : *(const PG8_LAS f32x4*)(EX + (((wc * 8 + 2 * blk - 1) * 4 + fq) * 16 + bj * 8 + n * 4));
                    ne[bj] = (blk == 3) ? (f32x4){0.f, 0.f, 0.f, 0.f} : *(const PG8_LAS f32x4*)(EX + (((wc * 8 + 2 * blk + 2) * 4 + fq) * 16 + bj * 8 + n * 4)); }
#pragma unroll
                for (int m = 0; m < 4; ++m) {
                    f32x4 cv[2];
#pragma unroll
                    for (int bj = 0; bj < 2; ++bj)
#pragma unroll
                        for (int e = 0; e < 4; ++e) { const float cur = acc[ai][bj][m][n][e];
                            const float prev = (m == 0) ? PG8_DPP(pe[bj][e], acc[ai][bj][3][n][e], 0x111) : acc[ai][bj][m == 0 ? 0 : m - 1][n][e];
                            const float next = (m == 3) ? PG8_DPP(ne[bj][e], acc[ai][bj][0][n][e], 0x101) : acc[ai][bj][m == 3 ? 3 : m + 1][n][e];
                            cv[bj][e] = bb[bj][e] + w0[bj][e] * prev + w1[bj][e] * cur + w2[bj][e] * next; }
                    float o[4];
#pragma unroll
                    for (int e = 0; e < 4; ++e) o[e] = (cv[0][e] * __builtin_amdgcn_rcpf(1.0f + __expf(-cv[0][e]))) * cv[1][e];
                    typedef unsigned u32x2_t __attribute__((ext_vector_type(2)));
                    u32x2_t w; w.x = pk2(o[0], o[1]); w.y = pk2(o[2], o[3]);
                    *(u32x2_t*)(ACT + (size_t)(row0 + ai * HALF + m) * FFn + c4) = w;
                }
            }
        }
    }
};
template <class Epi, class Sched, bool ALIGN_EPI = false, bool SP2 = false>
__device__ __forceinline__ void gemm_phase(PG8_LAS unsigned char* lds, const Gemm g, const Sched& S, const Epi& E, const int tid_) {
    const int tid = tid_, wid = __builtin_amdgcn_readfirstlane(tid >> 6), lane = tid & 63, wr = wid >> 2, wc = wid & 3, fr = lane & 15, fq = lane >> 4;
    const int K = g.K, nt = K / BK;
    unsigned voffA[2], voffB[2];
#pragma unroll
    for (int i = 0; i < 2; ++i) { int R, C; stage_rc(tid * 16 + i * 8192, R, C); const int Rb = Epi::PERM ? ((R & ~31) + perm32(R & 31)) : R;
        const int Ra = Epi::PERMA ? ((R & 64) + 4 * (R & 15) + ((R >> 4) & 3)) : R;
        voffA[i] = (unsigned)(Ra * K + C) * 2u; voffB[i] = (unsigned)(Rb * K + C) * 2u; }
    const size_t kstep = (size_t)(BK * 2);
    const size_t hstep = (size_t)HALF * K * 2;
    const size_t tstep = 2 * hstep;
    const unsigned ldsw = (unsigned)wid * 1024u;
    const int aoff = lds_byte(wr * 64 + fr, fq * 8), boff = lds_byte(wc * 32 + fr, fq * 8);
#define PG8_SA(b, h) (((b) * 2 + (h)) * HTB)
#define PG8_SB(b, h) ((4 + (b) * 2 + (h)) * HTB)
#define PG8_STAGE(bufoff, gbase, voff) do { _Pragma("unroll") for (int _i = 0; _i < 2; ++_i) \
        __builtin_amdgcn_global_load_lds((const unsigned*)((const char*)(gbase) + (voff)[_i]), (PG8_LAS unsigned*)(lds + (bufoff) + ldsw + _i * 8192), 16, 0, 0); } while (0)
#define PG8_LDA(dst, b, h) do { _Pragma("unroll") for (int m = 0; m < 4; ++m) _Pragma("unroll") for (int k = 0; k < 2; ++k) dst[m][k] = *(const PG8_LAS bf16x8*)(lds + PG8_SA(b, h) + aoff + m * 2048 + k * 1024); } while (0)
#define PG8_LDB(dst, b, h) do { _Pragma("unroll") for (int n = 0; n < 2; ++n) _Pragma("unroll") for (int k = 0; k < 2; ++k) dst[n][k] = *(const PG8_LAS bf16x8*)(lds + PG8_SB(b, h) + boff + n * 2048 + k * 1024); } while (0)
#define PG8_MMA(ai, bj, At, Bt) do { __builtin_amdgcn_s_setprio(1); _Pragma("unroll") for (int m = 0; m < 4; ++m) _Pragma("unroll") for (int n = 0; n < 2; ++n) _Pragma("unroll") for (int k = 0; k < 2; ++k) \
        acc[ai][bj][m][n] = __builtin_amdgcn_mfma_f32_16x16x32_bf16(Bt[n][k], At[m][k], acc[ai][bj][m][n], 0, 0, 0); __builtin_amdgcn_s_setprio(0); } while (0)
#define PG8_WAIT_V(n) asm volatile("s_waitcnt vmcnt(" #n ")" ::: "memory")
#define PG8_WAIT_L(n) asm volatile("s_waitcnt lgkmcnt(" #n ")" ::: "memory")
#define PG8_BAR __builtin_amdgcn_s_barrier()
#define PG8_SCHED __builtin_amdgcn_sched_barrier(0)
    Unit cur, nxt; int ui = 0;
    if (!S.next(0, cur)) return;
    f32x4 acc[2][2][4][2];
#pragma unroll
    for (int a = 0; a < 2; ++a)
#pragma unroll
        for (int b = 0; b < 2; ++b)
#pragma unroll
            for (int m = 0; m < 4; ++m)
#pragma unroll
                for (int n = 0; n < 2; ++n) acc[a][b][m][n] = (f32x4){0.f, 0.f, 0.f, 0.f};
    bf16x8 At[4][2], B0[2][2], B1[2][2];
    const char* cA = (const char*)g.A + (size_t)cur.pm * tstep; const char* cB = (const char*)g.Bt + (size_t)cur.pn * tstep;
    S.a_ready(cur);
    if constexpr (SP2) {
        PG8_STAGE(PG8_SB(0, 0), cB, voffB); PG8_STAGE(PG8_SB(0, 1), cB + hstep, voffB); PG8_STAGE(PG8_SA(0, 0), cA, voffA); PG8_STAGE(PG8_SA(0, 1), cA + hstep, voffA);
        if (wr == 1) PG8_BAR;
        PG8_WAIT_V(2); PG8_BAR;
        PG8_STAGE(PG8_SB(1, 0), cB + kstep, voffB); PG8_STAGE(PG8_SA(1, 0), cA + kstep, voffA); PG8_STAGE(PG8_SB(1, 1), cB + hstep + kstep, voffB);
        PG8_WAIT_V(6); PG8_BAR;
    } else {
    PG8_STAGE(PG8_SB(0, 0), cB, voffB); PG8_STAGE(PG8_SA(0, 0), cA, voffA); PG8_STAGE(PG8_SB(0, 1), cB + hstep, voffB); PG8_STAGE(PG8_SA(0, 1), cA + hstep, voffA);
    if (wr == 1) PG8_BAR;
    PG8_WAIT_V(4); PG8_BAR;
    PG8_STAGE(PG8_SB(1, 0), cB + kstep, voffB); PG8_STAGE(PG8_SA(1, 0), cA + kstep, voffA); PG8_STAGE(PG8_SB(1, 1), cB + hstep + kstep, voffB);
    PG8_WAIT_V(6); PG8_BAR;
    }
    for (;;) {
        const bool has_next = S.next(ui + 1, nxt);
        const char* nA = has_next ? (const char*)g.A + (size_t)nxt.pm * tstep : cA; const char* nB = has_next ? (const char*)g.Bt + (size_t)nxt.pn * tstep : cB;
        for (int t = 0; t < nt; t += 2) {
            const bool last = (t == nt - 2);
            const char* a1 = cA + (size_t)(t + 1) * kstep;
            const char* a2 = last ? nA : cA + (size_t)(t + 2) * kstep; const char* b2 = last ? nB : cB + (size_t)(t + 2) * kstep;
            const char* a3 = a2 + kstep; const char* b3 = b2 + kstep;
            if (last && has_next) S.a_ready(nxt);
            if constexpr (SP2) {
            PG8_LDB(B0, 0, 0); PG8_LDB(B1, 0, 1); PG8_SCHED; PG8_LDA(At, 0, 0); PG8_STAGE(PG8_SA(1, 1), a1 + hstep, voffA);
            PG8_WAIT_V(8); PG8_WAIT_L(0); PG8_BAR; PG8_MMA(0, 0, At, B0); PG8_MMA(0, 1, At, B1); PG8_BAR; PG8_SCHED;
            PG8_LDA(At, 0, 1); PG8_STAGE(PG8_SB(0, 0), b2, voffB); PG8_STAGE(PG8_SB(0, 1), b2 + hstep, voffB); PG8_STAGE(PG8_SA(0, 0), a2, voffA);
            PG8_WAIT_V(8); PG8_WAIT_L(0); PG8_BAR; PG8_MMA(1, 0, At, B0); PG8_MMA(1, 1, At, B1); PG8_BAR; PG8_SCHED;
            PG8_LDB(B0, 1, 0); PG8_LDB(B1, 1, 1); PG8_SCHED; PG8_LDA(At, 1, 0); PG8_STAGE(PG8_SA(0, 1), a2 + hstep, voffA);
            PG8_WAIT_V(8); PG8_WAIT_L(0); PG8_BAR; PG8_MMA(0, 0, At, B0); PG8_MMA(0, 1, At, B1); PG8_BAR; PG8_SCHED;
            PG8_LDA(At, 1, 1); PG8_STAGE(PG8_SB(1, 0), b3, voffB); PG8_STAGE(PG8_SB(1, 1), b3 + hstep, voffB); PG8_STAGE(PG8_SA(1, 0), a3, voffA);
            PG8_WAIT_V(8); PG8_WAIT_L(0); PG8_BAR; PG8_MMA(1, 0, At, B0); PG8_MMA(1, 1, At, B1); PG8_BAR; PG8_SCHED;
            } else {
            PG8_LDB(B0, 0, 0); PG8_SCHED; PG8_LDA(At, 0, 0); PG8_STAGE(PG8_SA(1, 1), a1 + hstep, voffA);
            PG8_WAIT_L(8); PG8_BAR; PG8_WAIT_L(0); PG8_MMA(0, 0, At, B0); PG8_BAR; PG8_SCHED;
            PG8_LDB(B1, 0, 1); PG8_STAGE(PG8_SB(0, 0), b2, voffB);
            PG8_BAR; PG8_WAIT_L(0); PG8_MMA(0, 1, At, B1); PG8_BAR;
            PG8_LDA(At, 0, 1); PG8_STAGE(PG8_SA(0, 0), a2, voffA);
            PG8_BAR; PG8_WAIT_L(0); PG8_MMA(1, 0, At, B0); PG8_BAR; PG8_SCHED;
            PG8_STAGE(PG8_SB(0, 1), b2 + hstep, voffB);
            PG8_WAIT_V(6); PG8_BAR; PG8_MMA(1, 1, At, B1); PG8_BAR;
            PG8_LDB(B0, 1, 0); PG8_SCHED; PG8_LDA(At, 1, 0); PG8_STAGE(PG8_SA(0, 1), a2 + hstep, voffA);
            PG8_WAIT_L(8); PG8_BAR; PG8_WAIT_L(0); PG8_MMA(0, 0, At, B0); PG8_BAR; PG8_SCHED;
            PG8_LDB(B1, 1, 1); PG8_STAGE(PG8_SB(1, 0), b3, voffB);
            PG8_BAR; PG8_WAIT_L(0); PG8_MMA(0, 1, At, B1); PG8_BAR;
            PG8_LDA(At, 1, 1); PG8_STAGE(PG8_SA(1, 0), a3, voffA);
            PG8_BAR; PG8_WAIT_L(0); PG8_MMA(1, 0, At, B0); PG8_BAR; PG8_SCHED;
            PG8_STAGE(PG8_SB(1, 1), b3 + hstep, voffB);
            PG8_WAIT_V(6); PG8_BAR; PG8_MMA(1, 1, At, B1); PG8_BAR;
            }
        }
        if constexpr (ALIGN_EPI) { if (wr == 0) PG8_BAR; }
        if constexpr (!Epi::AFTER_DRAIN) { E(acc, cur, wr, wc, fr, fq); S.done(cur); }
        if (!has_next) break;
#pragma unroll
        for (int a = 0; a < 2; ++a)
#pragma unroll
            for (int b = 0; b < 2; ++b)
#pragma unroll
                for (int m = 0; m < 4; ++m)
#pragma unroll
                    for (int n = 0; n < 2; ++n) acc[a][b][m][n] = (f32x4){0.f, 0.f, 0.f, 0.f};
        cur = nxt; cA = nA; cB = nB; ++ui;
        if constexpr (ALIGN_EPI) { if (wr == 1) PG8_BAR; }
    }
    PG8_WAIT_V(0);
    if constexpr (!ALIGN_EPI) { if (wr == 0) PG8_BAR; }
    PG8_BAR;
    if constexpr (Epi::AFTER_DRAIN) { E.fused(acc, cur, wr, wc, fr, fq, lds, wid, lane); S.done(cur); }
#undef PG8_SA
#undef PG8_SB
#undef PG8_STAGE
#undef PG8_LDA
#undef PG8_LDB
#undef PG8_MMA
#undef PG8_WAIT_V
#undef PG8_WAIT_L
#undef PG8_BAR
#undef PG8_SCHED
}
}

constexpr int DM = 2048, NB = 8, SEQ = 4096, CTXL = 256, TT = CTXL + SEQ, MROWS = NB * TT, NLAYER = 4;
constexpr int NH = 8, DK = 128, DV = 256, FF = 5632, UPN = 2 * FF, INC = 16416, MODW = 6 * DM;
constexpr int N1 = 8448, N2 = 8192, LDP = 8192;
constexpr int NCH = TT / 128;
constexpr float EPSN = 1e-6f, LOG2E = 1.4426950408889634f, QSCALE = 0.08838834764831845f;
constexpr int NWAVES = 8, NTHR = 512;

constexpr size_t WS_CTL = 0, CTL_ZERO_BYTES = 65536;
constexpr size_t WS_MOD = 1u << 20;
constexpr size_t WS_ROPE = WS_MOD + (size_t)NLAYER * 9 * MODW * 4;
constexpr size_t WS_GATES = WS_ROPE + 64 * 32 * 2 * 4;
constexpr size_t WS_GA = WS_GATES + (size_t)MROWS * 32 * 4;
constexpr size_t WS_GMX = WS_GA + (size_t)2 * MROWS * 8 * 4;
constexpr size_t WS_GCUM = WS_GMX + (size_t)2 * MROWS * 8 * 4;
constexpr size_t WS_XC = WS_GCUM + (size_t)2 * MROWS * 8 * 4;
constexpr size_t WS_W1T = WS_XC + (size_t)NB * CTXL * DM * 4;
constexpr size_t WS_W2T = WS_W1T + (size_t)N1 * DM * 2;
constexpr size_t WS_WRO = WS_W2T + (size_t)N2 * DM * 2;
constexpr size_t WS_WMO = WS_WRO + (size_t)DM * DM * 2;
constexpr size_t WS_WO = WS_WMO + (size_t)DM * DM * 2;
constexpr size_t WS_WUT = WS_WO + (size_t)DM * DM * 2;
constexpr size_t WS_WDT = WS_WUT + (size_t)UPN * DM * 2;
constexpr size_t WS_H = WS_WDT + (size_t)DM * FF * 2;
constexpr size_t SLOT = (size_t)MROWS * DM * 2;
constexpr size_t WS_ARENA = WS_H + SLOT;
constexpr size_t WS_PROJ = WS_ARENA;
constexpr size_t WS_MQK = WS_PROJ + (size_t)MROWS * LDP * 2;
constexpr size_t WS_Y4 = WS_MQK + SLOT;
constexpr size_t WS_U = WS_ARENA;
constexpr size_t WS_ACT = WS_U + (size_t)MROWS * UPN * 2;
constexpr size_t WS_OUTF = WS_ARENA;
constexpr size_t WS_RAW = WS_Y4 + 4 * SLOT;
constexpr size_t WS_RAWQ = WS_RAW + (size_t)(MROWS / 256) * 4 * UPN * 2;
constexpr size_t WS_IMG = WS_RAWQ + (size_t)(MROWS / 256) * 4 * 2048 * 2;
constexpr size_t WS_SS = WS_IMG + (size_t)256 * 18 * 8 * 8192;
constexpr size_t WS_END = WS_SS + (size_t)16 * MROWS * 4;
static_assert(WS_ACT + (size_t)MROWS * FF * 2 <= WS_RAW, "ACT inside the arena");
static_assert(WS_W1T % 256 == 0 && WS_H % 256 == 0 && WS_ARENA % 256 == 0 && WS_ACT % 256 == 0, "alignment");

constexpr int NP2_OFF = 156160;
constexpr int PSUM2_OFF = 160256;
constexpr int LDS_BYTES = 162304, AUX_OFF = 131072, MISC_OFF = 139264, PBUF_OFF = 139776;

#define LAS __attribute__((address_space(3)))
typedef unsigned short bf16;
typedef short bf16x8 __attribute__((ext_vector_type(8)));
typedef short s16x4 __attribute__((ext_vector_type(4)));
typedef float f32x4 __attribute__((ext_vector_type(4)));
typedef float f32x16 __attribute__((ext_vector_type(16)));
typedef unsigned u32x4 __attribute__((ext_vector_type(4)));
typedef unsigned u32x2 __attribute__((ext_vector_type(2)));
using pg8::pk2; using pg8::bflo; using pg8::bfhi;
#define LDS_WAIT() asm volatile("s_waitcnt lgkmcnt(0)" ::: "memory")
#define VM_WAIT() asm volatile("s_waitcnt vmcnt(0)" ::: "memory")

#define XB_TMO      128
#define XB_XCNT(j)  (256  + 64 * (j))
#define XB_XSUB(j)  (1280 + 64 * (j))
#define XB_XGEN(j)  (2304 + 64 * (j))
#define XB_TOP      3328
#define XB_TOPGEN   3392
#define XCD_BAR_WORDS 3456
#define XB_SPIN_CAP (1u << 18)

__device__ __forceinline__ unsigned xb_ld(unsigned* p)              { return __hip_atomic_load(p, __ATOMIC_RELAXED, __HIP_MEMORY_SCOPE_AGENT); }
__device__ __forceinline__ unsigned xb_add(unsigned* p, unsigned v) { return __hip_atomic_fetch_add(p, v, __ATOMIC_RELAXED, __HIP_MEMORY_SCOPE_AGENT); }
__device__ __forceinline__ unsigned xb_xcc_id() { return (unsigned)__builtin_amdgcn_s_getreg((3 << 11) | 20) & 0xFu; }
#define XB_SPIN(cond, bar) do { unsigned _sp = 0; while (cond) { __builtin_amdgcn_s_sleep(1); \
    if ((++_sp & 255u) == 0u) { if (xb_ld(&(bar)[XB_TMO])) break; if (_sp > XB_SPIN_CAP) { atomicAdd(&(bar)[XB_TMO], 1u); break; } } } } while (0)

struct XcdBarrier {
    unsigned* bar; unsigned x;
    volatile LAS unsigned* st;
};

__device__ __forceinline__ XcdBarrier xcd_barrier_post(unsigned* bar, volatile LAS unsigned* st) {
    XcdBarrier b; b.bar = bar; b.x = xb_xcc_id(); b.st = st;
    if (threadIdx.x == 0) (void)xb_add(&bar[XB_XCNT(b.x)], 1u);
    return b;
}
__device__ __forceinline__ void xcd_barrier_complete(unsigned* bar, unsigned x, unsigned& nloc, unsigned& nx) {
    const unsigned G = gridDim.x * gridDim.y * gridDim.z;
    unsigned sum, cnt, mine, sp = 0u;
    for (;;) {
        sum = 0u; cnt = 0u; mine = 0u;
#pragma unroll
        for (unsigned j = 0; j < 16; ++j) { const unsigned c = xb_ld(&bar[XB_XCNT(j)]); sum += c; cnt += (c > 0u) ? 1u : 0u; mine = (j == x) ? c : mine; }
        if (sum == G) break;
        __builtin_amdgcn_s_sleep(1);
        if ((++sp & 255u) == 0u) { if (xb_ld(&bar[XB_TMO])) break; if (sp > XB_SPIN_CAP) { atomicAdd(&bar[XB_TMO], 1u); break; } }
    }
    nloc = mine > 0u ? mine : 1u; nx = cnt > 0u ? cnt : 1u;
}

__device__ __forceinline__ void xcd_barrier(const XcdBarrier& b) {
    asm volatile("s_waitcnt vmcnt(0)" ::: "memory");
    __syncthreads();
    if (threadIdx.x == 0) {
        unsigned* bar = b.bar;
        __builtin_amdgcn_s_waitcnt(0);
        unsigned nloc = b.st[0], nx = b.st[1];
        if (nloc == 0u) { xcd_barrier_complete(bar, b.x, nloc, nx); b.st[0] = nloc; b.st[1] = nx; }
        const unsigned old = xb_add(&bar[XB_XSUB(b.x)], 1u);
        const unsigned gen = old / nloc;
        if (old + 1u == (gen + 1u) * nloc) {
            __builtin_amdgcn_fence(__ATOMIC_RELEASE, "agent");
            asm volatile("s_waitcnt vmcnt(0)" ::: "memory");
            const unsigned og = xb_add(&bar[XB_TOP], 1u);
            const unsigned tg = og / nx;
            if (og + 1u == (tg + 1u) * nx) xb_add(&bar[XB_TOPGEN], 1u);
            else XB_SPIN(xb_ld(&bar[XB_TOPGEN]) == tg, bar);
            __builtin_amdgcn_fence(__ATOMIC_ACQUIRE, "agent");
            xb_add(&bar[XB_XGEN(b.x)], 1u);
            asm volatile("s_waitcnt vmcnt(0)" ::: "memory");
        } else {
            XB_SPIN(xb_ld(&bar[XB_XGEN(b.x)]) == gen, bar);
            __builtin_amdgcn_fence(__ATOMIC_ACQUIRE, "agent");
            asm volatile("s_waitcnt vmcnt(0)" ::: "memory");
        }
    }
    __syncthreads();
}

struct Ctx {
    LAS unsigned char* lds;
    int tid, lane, wave, vcu, G;
    float* out; unsigned char* ws;
    __device__ __forceinline__ const float* inp(int i) const { const float* const* ka = (const float* const*)__builtin_amdgcn_kernarg_segment_ptr(); return ka[i]; }
};
#define GAS __attribute__((address_space(1)))
template <class T> __device__ __forceinline__ const GAS T* gptr(const T* p) { return (const GAS T*)p; }
template <class T> __device__ __forceinline__ GAS T* gptr(T* p) { return (GAS T*)p; }
#define WV_DPP(old, x, ctrl) __builtin_bit_cast(float, __builtin_amdgcn_update_dpp(__builtin_bit_cast(int, (float)(old)), __builtin_bit_cast(int, (float)(x)), (ctrl), 0xf, 0xf, false))
__device__ __forceinline__ float swz_xor16(float v) { return __builtin_bit_cast(float, __builtin_amdgcn_ds_swizzle(__builtin_bit_cast(int, v), 0x401F)); }
__device__ __forceinline__ float bperm_f(float v, int src_lane) { return __builtin_bit_cast(float, __builtin_amdgcn_ds_bpermute(src_lane << 2, __builtin_bit_cast(int, v))); }
__device__ __forceinline__ float quad_sum(float v) { v += WV_DPP(0.f, v, 0xB1); v += WV_DPP(0.f, v, 0x4E); return v; }
__device__ __forceinline__ float wave_sum(float v) {
    v = quad_sum(v); v += WV_DPP(0.f, v, 0x141); v += WV_DPP(0.f, v, 0x140);
    v += swz_xor16(v);
    return __builtin_bit_cast(float, __builtin_amdgcn_readlane(__builtin_bit_cast(int, v), 0)) + __builtin_bit_cast(float, __builtin_amdgcn_readlane(__builtin_bit_cast(int, v), 32));
}
__device__ __forceinline__ float silu_f(float x) { return x * __builtin_amdgcn_rcpf(1.0f + __expf(-x)); }
__device__ __forceinline__ float sigmoid_f(float x) { return __builtin_amdgcn_rcpf(1.0f + __expf(-x)); }

__device__ __forceinline__ void mod_phase(const Ctx& C, int l0, int nl, int start, int stride) {
    LAS float* SC = (LAS float*)C.lds;
    LAS float* RED = (LAS float*)(C.lds + 73728);
    const float* cin = C.inp(1); const float* cctx = C.inp(3); const float* w_ada = C.inp(4); const float* b_ada = C.inp(5);
    float* MOD = (float*)(C.ws + WS_MOD);
    for (int e = C.tid; e < 9 * DM; e += NTHR) { const float v = e < 8 * DM ? cin[e] : cctx[e - 8 * DM]; SC[e] = silu_f(v); }
    __syncthreads();
    for (int it = start; it < nl * 192; it += stride) {
        const int l = l0 + it / 192, cg = it % 192, col = cg * 64 + C.lane;
        const float* wp = w_ada + ((size_t)l * DM + C.wave * 256) * MODW + col;
        float acc[9];
#pragma unroll
        for (int b = 0; b < 9; ++b) acc[b] = 0.f;
        for (int k0 = 0; k0 < 256; k0 += 16) {
            float wv[16];
#pragma unroll
            for (int j = 0; j < 16; ++j) wv[j] = __builtin_nontemporal_load(wp + (size_t)(k0 + j) * MODW);
#pragma unroll
            for (int j = 0; j < 16; ++j) { const int k = C.wave * 256 + k0 + j;
#pragma unroll
                for (int b = 0; b < 9; ++b) acc[b] += SC[b * DM + k] * wv[j]; }
        }
#pragma unroll
        for (int b = 0; b < 9; ++b) RED[(C.wave * 9 + b) * 64 + C.lane] = acc[b];
        __syncthreads();
        for (int e = C.tid; e < 576; e += NTHR) { const int b = e >> 6, ln = e & 63; float s = 0.f;
#pragma unroll
            for (int w = 0; w < 8; ++w) s += RED[(w * 9 + b) * 64 + ln];
            MOD[((size_t)l * 9 + b) * MODW + cg * 64 + ln] = s + b_ada[(size_t)l * MODW + cg * 64 + ln]; }
        __syncthreads();
    }
}
__device__ __forceinline__ void rope_table(const Ctx& C) {
    const int gt = C.vcu * NTHR + C.tid;
    if (gt < 2048) {
        const int pos = gt >> 5, p = gt & 31;
        double f = 1.0; const double f1 = 0.74989420933245582;
        for (int i = 0; i < p; ++i) f *= f1;
        const double x = (double)pos * f;
        const double kq = __builtin_rint(x * 0.63661977236758134308);
        const double rr = (x - kq * 1.57079632679489655800) - kq * 6.12323399573676603587e-17;
        const double r2 = rr * rr;
        double sn = rr * (1.0 + r2 * (-1.0 / 6 + r2 * (1.0 / 120 + r2 * (-1.0 / 5040 + r2 * (1.0 / 362880 + r2 * (-1.0 / 39916800 + r2 * (1.0 / 6227020800.0)))))));
        double cs = 1.0 + r2 * (-0.5 + r2 * (1.0 / 24 + r2 * (-1.0 / 720 + r2 * (1.0 / 40320 + r2 * (-1.0 / 3628800 + r2 * (1.0 / 479001600.0 + r2 * (-1.0 / 87178291200.0)))))));
        const int q = ((int)kq) & 3;
        const double s_out = (q == 0) ? sn : (q == 1) ? cs : (q == 2) ? -sn : -cs;
        const double c_out = (q == 0) ? cs : (q == 1) ? -sn : (q == 2) ? -cs : sn;
        float* T = (float*)(C.ws + WS_ROPE);
        T[gt] = (float)c_out; T[2048 + gt] = (float)s_out;
    }
}
__device__ __forceinline__ int w1_src(int n) {
    if (n < 2048) { const int base = n < 1024 ? 0 : 1024, nn = n & 1023, head = nn >> 7, j = nn & 127, blk = j >> 6, jj = j & 63; return base + head * 128 + blk * 64 + (jj & 1) * 32 + (jj >> 1); }
    if (n < 4096) return 2048 + (n - 2048);
    if (n < 5120) return 6144 + (n - 4096);
    if (n < 6144) return 7168 + (n - 5120);
    if (n < 8192) return 8192 + (n - 6144);
    if (n < 8224) return 12288 + (n - 8192);
    return -1;
}
__device__ __forceinline__ int w2_src(int n) {
    if (n < 2048) return 4096 + n;
    if (n < 4096) return 10240 + (n - 2048);
    return 12320 + (n - 4096);
}
__device__ __forceinline__ void tr_item(const float* W, int K, int N, bf16* WT, int mode, LAS float* scr, int item, int nblk, int lane) {
    const int kb = item / nblk, nb = item % nblk, k0 = 128 * kb, n0 = 32 * nb;
    const int nd = n0 + (lane & 31);
    const int sc = mode == 1 ? w1_src(nd) : (mode == 2 ? w2_src(nd) : (mode == 3 ? ((nd & 128) ? FF + 128 * (nd >> 8) + (nd & 127) : 128 * (nd >> 8) + (nd & 127)) : nd));
    float wv[64];
    { const float* wp = W + (size_t)(k0 + (lane >> 5)) * N + (sc >= 0 ? sc : 0);
#pragma unroll
      for (int i = 0; i < 64; ++i) wv[i] = __builtin_nontemporal_load(gptr(wp + (size_t)(2 * i) * N)); }
#pragma unroll
    for (int i = 0; i < 64; ++i) { const int kk = 2 * i + (lane >> 5); scr[kk * 33 + (lane & 31)] = sc >= 0 ? wv[i] : 0.f; }
    LDS_WAIT(); asm volatile("" ::: "memory");
    const int c = lane & 15;
#pragma unroll
    for (int j = 0; j < 8; ++j) { const int n = (lane >> 4) + 4 * j; const LAS float* s = scr + (8 * c) * 33 + n;
        u32x4 o; o.x = pk2(s[0 * 33], s[1 * 33]); o.y = pk2(s[2 * 33], s[3 * 33]); o.z = pk2(s[4 * 33], s[5 * 33]); o.w = pk2(s[6 * 33], s[7 * 33]);
        *(u32x4*)(WT + (size_t)(n0 + n) * K + k0 + 8 * c) = o; }
    LDS_WAIT(); asm volatile("" ::: "memory");
}
constexpr int CV_I0 = 16 * 264, CV_I1 = CV_I0 + 16 * 256, CV_I2 = CV_I1 + 1024, CV_I3 = CV_I2 + 1024, CV_I4 = CV_I3 + 1024, CV_I5 = CV_I4 + 16 * 352, CV_I6 = CV_I5 + 44 * 64;
__device__ __forceinline__ void convert_weights(const Ctx& C, int l, int lo, int hi, int iw, int nw) {
    LAS float* scr = (LAS float*)(C.lds + C.wave * 17408);
    if (iw < 0) return;
    const float* w_in = C.inp(7) + (size_t)l * DM * INC;
    const float* w_ro = C.inp(13) + (size_t)l * DM * DM; const float* w_mo = C.inp(14) + (size_t)l * DM * DM; const float* w_o = C.inp(15) + (size_t)l * DM * DM;
    const float* w_up = C.inp(16) + (size_t)l * DM * UPN; const float* w_dn = C.inp(19) + (size_t)l * FF * DM;
    constexpr int I0 = CV_I0, I1 = CV_I1, I2 = CV_I2, I3 = CV_I3, I4 = CV_I4, I5 = CV_I5;
    for (int it = lo + iw; it < hi; it += nw) {
        if (it < I0) tr_item(w_in, DM, INC, (bf16*)(C.ws + WS_W1T), 1, scr, it, 264, C.lane);
        else if (it < I1) tr_item(w_in, DM, INC, (bf16*)(C.ws + WS_W2T), 2, scr, it - I0, 256, C.lane);
        else if (it < I2) tr_item(w_ro, DM, DM, (bf16*)(C.ws + WS_WRO), 0, scr, it - I1, 64, C.lane);
        else if (it < I3) tr_item(w_mo, DM, DM, (bf16*)(C.ws + WS_WMO), 0, scr, it - I2, 64, C.lane);
        else if (it < I4) tr_item(w_o, DM, DM, (bf16*)(C.ws + WS_WO), 0, scr, it - I3, 64, C.lane);
        else if (it < I5) tr_item(w_up, DM, UPN, (bf16*)(C.ws + WS_WUT), 3, scr, it - I4, 352, C.lane);
        else tr_item(w_dn, FF, DM, (bf16*)(C.ws + WS_WDT), 0, scr, it - I5, 64, C.lane);
    }
}
template <bool UPD, bool MKH>
__device__ __forceinline__ void rn_phase(const Ctx& C, int skip_ctx, const float* xin_lat, const float* xin_ctx, float* xout_lat, float* xout_ctx, const bf16* OUT,
                                         const float* modu, int g_idx, const float* nw_post, const float* modh, int sh_idx, int sc_idx, const float* nw_pre, bf16* Hout,
                                         unsigned* cnt_lat = nullptr, unsigned tgt_lat = 0, unsigned* cnt_ctx = nullptr, unsigned tgt_ctx = 0) {
    LAS float* TAB = (LAS float*)C.lds;
    const int b = C.vcu >> 5, cl = C.vcu & 31;
    __syncthreads();
#pragma unroll
    for (int k = 0; k < 2; ++k) { const int idx = C.tid + NTHR * k, set = idx >> 9, col = (idx & 511) * 4, mi = set ? NB : b;
        if (UPD) { const f32x4 g = *(const f32x4*)(modu + (size_t)mi * MODW + g_idx * DM + col), nw = *(const f32x4*)(nw_post + col); *(LAS f32x4*)(TAB + (set * 3 + 0) * DM + col) = g * nw; }
        if (MKH) { const f32x4 nw = *(const f32x4*)(nw_pre + col), sh = *(const f32x4*)(modh + (size_t)mi * MODW + sh_idx * DM + col), sc = *(const f32x4*)(modh + (size_t)mi * MODW + sc_idx * DM + col);
            *(LAS f32x4*)(TAB + (set * 3 + 1) * DM + col) = nw * (sc + 1.0f); *(LAS f32x4*)(TAB + (set * 3 + 2) * DM + col) = sh; } }
    __syncthreads();
    auto run = [&](const bool isctx, const int t0, const int ts, const int n) {
        auto row_of = [&](int i, size_t& xoff) { const int t = t0 + i * ts; xoff = isctx ? ((size_t)b * CTXL + t) * DM : ((size_t)b * SEQ + t) * DM; return b * TT + (isctx ? t : CTXL + t); };
        auto load_row = [&](int i, f32x4 (&xv)[8], u32x2 (&ow)[8]) { size_t xo_; const int r = row_of(i, xo_); const float* xi = (isctx ? xin_ctx : xin_lat) + xo_;
#pragma unroll
            for (int j = 0; j < 8; ++j) { xv[j] = __builtin_nontemporal_load(gptr((const f32x4*)(xi + 4 * C.lane + 256 * j))); if (UPD) ow[j] = __builtin_nontemporal_load(gptr((const u32x2*)(OUT + (size_t)r * DM + 4 * C.lane + 256 * j))); } };
        auto process = [&](int i, f32x4 (&xv)[8], u32x2 (&ow)[8]) {
            size_t xoff; const int r = row_of(i, xoff);
            LAS const float* tb = TAB + (isctx ? 3 * DM : 0) + 4 * C.lane;
            if (UPD) {
                f32x4 ov[8]; float ss = 0.f;
#pragma unroll
                for (int j = 0; j < 8; ++j) { const u32x2 w = ow[j];
                    ov[j] = (f32x4){bflo(w.x), bfhi(w.x), bflo(w.y), bfhi(w.y)}; ss += (ov[j][0] * ov[j][0] + ov[j][1] * ov[j][1]) + (ov[j][2] * ov[j][2] + ov[j][3] * ov[j][3]); }
                const float r1 = __builtin_amdgcn_rsqf(wave_sum(ss) * (1.0f / DM) + EPSN);
                float* xo = (isctx ? xout_ctx : xout_lat) + xoff;
#pragma unroll
                for (int j = 0; j < 8; ++j) { const int col = 4 * C.lane + 256 * j; const f32x4 gn = *(LAS const f32x4*)(tb + 256 * j);
                    xv[j] = xv[j] + gn * (ov[j] * r1); __builtin_nontemporal_store(xv[j], gptr((f32x4*)(xo + col))); }
            }
            if (MKH) {
                float ss = 0.f;
#pragma unroll
                for (int j = 0; j < 8; ++j) ss += (xv[j][0] * xv[j][0] + xv[j][1] * xv[j][1]) + (xv[j][2] * xv[j][2] + xv[j][3] * xv[j][3]);
                const float r2 = __builtin_amdgcn_rsqf(wave_sum(ss) * (1.0f / DM) + EPSN);
#pragma unroll
                for (int j = 0; j < 8; ++j) { const int col = 4 * C.lane + 256 * j; const f32x4 aw = *(LAS const f32x4*)(tb + DM + 256 * j), sh = *(LAS const f32x4*)(tb + 2 * DM + 256 * j);
                    const f32x4 hv = (xv[j] * r2) * aw + sh;
                    u32x2 w; w.x = pk2(hv[0], hv[1]); w.y = pk2(hv[2], hv[3]); *gptr((u32x2*)(Hout + (size_t)r * DM + col)) = w; }
            } };
        f32x4 xa[8], xb[8]; u32x2 oa[8], ob[8];
        load_row(0, xa, oa);
#pragma unroll 1
        for (int i = 0; i + 1 < n; i += 2) {
            load_row(i + 1, xb, ob); __builtin_amdgcn_sched_barrier(0); process(i, xa, oa); __builtin_amdgcn_sched_barrier(0);
            load_row(i + 2 < n ? i + 2 : n - 1, xa, oa); __builtin_amdgcn_sched_barrier(0); process(i + 1, xb, ob); __builtin_amdgcn_sched_barrier(0);
        }
        if (n & 1) process(n - 1, xa, oa);
    };
    if (cnt_lat == nullptr) {
        run(false, cl * 8 + C.wave, 256, 16);
        if (!skip_ctx) run(true, cl * 8 + C.wave, 0, 1);
    } else {
        unsigned* const wp = cl < 8 ? cnt_ctx : cnt_lat; const unsigned tgt = cl < 8 ? tgt_ctx : tgt_lat;
        if (C.tid == 0) { unsigned sp = 0u; while (xb_ld(wp) < tgt) { __builtin_amdgcn_s_sleep(2); if (++sp > (1u << 22)) break; }
            __builtin_amdgcn_fence(__ATOMIC_ACQUIRE, "agent"); asm volatile("s_waitcnt vmcnt(0)" ::: "memory"); }
        __syncthreads();
        if (cl < 8) run(true, cl * 8 + C.wave, 64, 4);
        else { const int t0 = (cl - 8) * 8 + C.wave; run(false, t0, 192, t0 < 64 ? 22 : 21); }
    }
}
__device__ __forceinline__ float wave_scan_add(float v, int lane) {
#pragma unroll
    for (int o = 1; o < 64; o <<= 1) { const float t = bperm_f(v, lane - o); if (lane >= o) v += t; }
    return v;
}
__device__ __forceinline__ float wave_scan_max(float v, int lane) {
#pragma unroll
    for (int o = 1; o < 64; o <<= 1) { const float t = bperm_f(v, lane - o); if (lane >= o) v = fmaxf(v, t); }
    return v;
}
__device__ __forceinline__ void conv_gate_phase(const Ctx& C, int l) {
    bf16* MQK = (bf16*)(C.ws + WS_MQK);
    const float* cw = C.inp(8) + (size_t)l * 3 * 2048; const float* cb = C.inp(9) + (size_t)l * 2048;
    {
        const bf16* RAWQ = (const bf16*)(C.ws + WS_RAWQ);
        const int gt = C.vcu * NTHR + C.tid, NT = C.G * NTHR;
        for (int idx = gt; idx < (MROWS / 256) * 2 * 256; idx += NT) {
            const int pm = idx >> 9, k = (idx >> 8) & 1, cg = idx & 255, j = pm % 17;
            if (j == 0 || (k == 0 && j == 1) || (k == 1 && j == 16)) continue;
            const bf16* P = k == 0 ? RAWQ + ((size_t)(pm - 1) * 4 + 3) * 2048 : RAWQ + ((size_t)pm * 4 + 2) * 2048;
            const bf16* Cc = k == 0 ? RAWQ + ((size_t)pm * 4 + 0) * 2048 : RAWQ + ((size_t)pm * 4 + 3) * 2048;
            const bf16* Nn = k == 0 ? RAWQ + ((size_t)pm * 4 + 1) * 2048 : RAWQ + ((size_t)(pm + 1) * 4 + 0) * 2048;
            const u32x4 xp = *(const u32x4*)(P + cg * 8), xc = *(const u32x4*)(Cc + cg * 8), xn = *(const u32x4*)(Nn + cg * 8);
            const unsigned pw[4] = {xp.x, xp.y, xp.z, xp.w}, cwd[4] = {xc.x, xc.y, xc.z, xc.w}, nwd[4] = {xn.x, xn.y, xn.z, xn.w};
            const float scl = cg < 128 ? QSCALE : 1.0f; float o[8];
#pragma unroll
            for (int q = 0; q < 4; ++q) { const int c0 = cg * 8 + 2 * q, c1 = c0 + 1;
                o[2 * q] = silu_f(cb[c0] + cw[c0] * bflo(pw[q]) + cw[2048 + c0] * bflo(cwd[q]) + cw[4096 + c0] * bflo(nwd[q])) * scl;
                o[2 * q + 1] = silu_f(cb[c1] + cw[c1] * bfhi(pw[q]) + cw[2048 + c1] * bfhi(cwd[q]) + cw[4096 + c1] * bfhi(nwd[q])) * scl; }
            u32x4 w; w.x = pk2(o[0], o[1]); w.y = pk2(o[2], o[3]); w.z = pk2(o[4], o[5]); w.w = pk2(o[6], o[7]);
            *(u32x4*)(MQK + ((size_t)pm * 256 + (k ? 255 : 0)) * DM + cg * 8) = w;
        }
    }
    {
        const float* GATES = (const float*)(C.ws + WS_GATES);
        float* GA = (float*)(C.ws + WS_GA); float* GMX = (float*)(C.ws + WS_GMX); float* GCUM = (float*)(C.ws + WS_GCUM);
        const int gw = C.vcu * NWAVES + C.wave, NGW = C.G * NWAVES;
        for (int it = gw; it < NB * 2 * NH * NCH; it += NGW) {
            const int ch = it % NCH, hh = (it / NCH) % NH, dir = (it / (NCH * NH)) & 1, b = it / (NCH * NH * 2);
            const int s0 = 2 * C.lane, s1 = s0 + 1, i0 = dir ? 127 - s0 : s0, i1 = dir ? 127 - s1 : s1;
            const size_t r0 = (size_t)b * TT + ch * 128 + i0, r1 = (size_t)b * TT + ch * 128 + i1;
            const float ig0 = GATES[r0 * 32 + dir * 16 + hh], fg0 = GATES[r0 * 32 + dir * 16 + 8 + hh];
            const float ig1 = GATES[r1 * 32 + dir * 16 + hh], fg1 = GATES[r1 * 32 + dir * 16 + 8 + hh];
            const float lf0 = fminf(fg0, 0.f) - __logf(1.0f + __expf(-fabsf(fg0))), lf1 = fminf(fg1, 0.f) - __logf(1.0f + __expf(-fabsf(fg1)));
            const float c1 = lf0 + lf1; const float incl = wave_scan_add(c1, C.lane); const float off = incl - c1;
            const float cum0 = off + lf0, cum1 = off + c1;
            const float a0 = ig0 - cum0, a1 = ig1 - cum1;
            const float m1 = fmaxf(a0, a1); const float mincl = wave_scan_max(m1, C.lane);
            float mprev = bperm_f(mincl, C.lane - 1); const float mx0 = C.lane == 0 ? a0 : fmaxf(mprev, a0); const float mx1 = mincl;
            const size_t o0 = ((size_t)dir * MROWS + r0) * 8 + hh, o1 = ((size_t)dir * MROWS + r1) * 8 + hh;
            GA[o0] = a0; GA[o1] = a1; GMX[o0] = mx0; GMX[o1] = mx1; GCUM[o0] = cum0; GCUM[o1] = cum1;
        }
    }
}
__device__ __forceinline__ unsigned off_b(unsigned row, unsigned ch) { return 256u * row + 16u * (ch ^ (((row & 3u) << 2) | ((row >> 2) & 3u))); }
__device__ __forceinline__ unsigned tr_addr(unsigned lane, unsigned c, unsigned ks, unsigned t) {
    const unsigned h = lane >> 5, blk = (lane >> 4) & 1u, q = (lane & 15u) >> 2, p = lane & 3u;
    return off_b(16u * ks + 8u * h + 4u * t + q, 4u * c + 2u * blk + (p >> 1)) + 8u * (p & 1u);
}
__device__ __forceinline__ bf16x8 tr_frag(LAS unsigned char* tile, unsigned lane, unsigned c, unsigned ks) {
    const s16x4 lo = __builtin_amdgcn_ds_read_tr16_b64_v4i16((LAS s16x4*)(tile + tr_addr(lane, c, ks, 0)));
    const s16x4 hi = __builtin_amdgcn_ds_read_tr16_b64_v4i16((LAS s16x4*)(tile + tr_addr(lane, c, ks, 1)));
    return __builtin_shufflevector(lo, hi, 0, 1, 2, 3, 4, 5, 6, 7);
}
__device__ __forceinline__ bf16x8 tr_frag2(LAS unsigned char* a0, LAS unsigned char* a1) {
    const s16x4 lo = __builtin_amdgcn_ds_read_tr16_b64_v4i16((LAS s16x4*)a0);
    const s16x4 hi = __builtin_amdgcn_ds_read_tr16_b64_v4i16((LAS s16x4*)a1);
    return __builtin_shufflevector(lo, hi, 0, 1, 2, 3, 4, 5, 6, 7);
}
__device__ __forceinline__ void stage_tile(LAS unsigned char* tile, const bf16* g, int ld, int wave, int lane) {
    const char* gb = (const char*)g;
#pragma unroll
    for (int i = 0; i < 4; ++i) {
        const unsigned o = (unsigned)(wave * 4 + i) * 1024u + (unsigned)lane * 16u;
        const unsigned row = o >> 8, chs = (o >> 4) & 15u, ch = chs ^ (((row & 3u) << 2) | ((row >> 2) & 3u));
        const unsigned voff = (row * (unsigned)ld + ch * 8u) * 2u;
        __builtin_amdgcn_global_load_lds((const unsigned*)(gb + voff), (LAS unsigned*)(tile + (wave * 4 + i) * 1024), 16, 0, 0);
    }
}
#define SC_DPP(v, ctrl) __builtin_bit_cast(float, __builtin_amdgcn_update_dpp(0, __builtin_bit_cast(int, (float)(v)), (ctrl), 0xf, 0xf, false))
__device__ __forceinline__ void emit_q(const f32x16& Yq, int q, LAS float* PSUMh, LAS float* PSUMh2, int wave, int lane, int r, int h, char* YNrow, int hf) {
#pragma unroll
    for (int g = 0; g < 4; ++g) { f32x4 s4;
#pragma unroll
        for (int e = 0; e < 4; ++e) { const float y = Yq[4 * g + e];
            const unsigned voff = (unsigned)(64 * hf + 32 * q + 8 * g + 4 * h + e) * (unsigned)(DM * 2) + (unsigned)r * 2u;
            const unsigned yb = pk2(y, 0.f) & 0xffffu; *(bf16*)(YNrow + voff) = (bf16)yb;
            float v = y * y;
            v += SC_DPP(v, 0xB1); v += SC_DPP(v, 0x4E); v += SC_DPP(v, 0x141); v += SC_DPP(v, 0x140);
            s4[e] = v; }
        if ((lane & 15) == 0) *(LAS f32x4*)(((lane & 16) ? PSUMh2 : PSUMh) + wave * 64 + 32 * q + 8 * g + 4 * h) = s4; }
}
__device__ __forceinline__ void reduce_ss(const LAS float* PSUMh, const LAS float* PSUMh2, int tid, float* SSrow) {
    if (tid < 64) { float s = 0.f;
#pragma unroll
        for (int w = 0; w < 8; ++w) s += PSUMh[w * 64 + tid] + PSUMh2[w * 64 + tid];
        SSrow[tid] = s; }
}
__device__ __forceinline__ void add_image(f32x16& y, const u32x4 a, const u32x4 b) {
    y[0] += bflo(a.x); y[1] += bfhi(a.x); y[2] += bflo(a.y); y[3] += bfhi(a.y); y[4] += bflo(a.z); y[5] += bfhi(a.z); y[6] += bflo(a.w); y[7] += bfhi(a.w);
    y[8] += bflo(b.x); y[9] += bfhi(b.x); y[10] += bflo(b.y); y[11] += bfhi(b.y); y[12] += bflo(b.z); y[13] += bfhi(b.z); y[14] += bflo(b.w); y[15] += bfhi(b.w);
}
constexpr int NSPLIT = NCH / 2 + 1;
#define MFMA32(a, b, c) __builtin_amdgcn_mfma_f32_32x32x16_bf16((a), (b), (c), 0, 0, 0)
__device__ __forceinline__ void scan_phase(const Ctx& C, int l, const XcdBarrier& bar) {
    LAS unsigned char* LQ = C.lds; LAS unsigned char* LK = C.lds + 32768; LAS unsigned char* LV = C.lds + 65536; LAS unsigned char* LP = C.lds + PBUF_OFF;
    LAS float* AUX = (LAS float*)(C.lds + AUX_OFF);
    LAS float* CJ = AUX; LAS float* RI = AUX + 128; LAS float* RS = AUX + 256; LAS float* WW = AUX + 384; LAS float* EMT = AUX + 512; LAS float* INV = AUX + 640;
    LAS float* QN = AUX + 768; LAS float* NV = AUX + 896; LAS float* RSUM = AUX + 1024; LAS float* NP2 = (LAS float*)(C.lds + NP2_OFF);
    const int tid_ = C.tid, lane_ = C.lane, wave = C.wave, r_ = lane_ & 31, h_ = lane_ >> 5;
    const bf16* PROJ = (const bf16*)(C.ws + WS_PROJ); const bf16* MQK = (const bf16*)(C.ws + WS_MQK);
    const float* GA = (const float*)(C.ws + WS_GA); const float* GMX = (const float*)(C.ws + WS_GMX); const float* GCUM = (const float*)(C.ws + WS_GCUM);
    const float* decay_exp = C.inp(11) + (size_t)l * 16;
    for (int u = C.vcu; u < 256; u += C.G) {
        const int dir = u & 1, br = (u >> 1) & 1, hh = (u >> 2) & 7, b = u >> 5;
        const bf16* Qg = br ? MQK + hh * 128 : PROJ + hh * 128;
        const bf16* Kg = br ? MQK + 1024 + hh * 128 : PROJ + 1024 + hh * 128;
        const bf16* Vg = br ? PROJ + 6144 + hh * 256 : PROJ + 2048 + hh * 256;
        const int ldq = br ? DM : LDP;
        char* const Yob = (char*)(C.ws + WS_Y4 + (size_t)(br * 2) * SLOT) + (hh * 256 + wave * 32) * 2;
        LAS float* PSUMh = AUX + 1536; LAS float* PSUMh2 = (LAS float*)(C.lds + PSUM2_OFF);
        float* const SSh = (float*)(C.ws + WS_SS) + (size_t)(br * 8 + hh) * MROWS;
        f32x16 S[4];
#pragma unroll
        for (int t = 0; t < 4; ++t)
#pragma unroll
            for (int e = 0; e < 16; ++e) S[t][e] = 0.f;
        float dec = 1.f, m = 0.f, m_next = 0.f;
        __syncthreads();
        int tidp = tid_; asm volatile("" : "+v"(tidp));
        if (br == 0) {
            const float lg2 = __log2f(1.0f - exp2f(-decay_exp[dir * 8 + hh]));
            dec = exp2f(128.f * lg2);
            if (tidp < 128) { const float i = (float)tidp;
                if (dir == 0) { CJ[tidp] = -i * lg2; RI[tidp] = -i * lg2; RS[tidp] = exp2f((i + 1.f) * lg2); WW[tidp] = exp2f((127.f - i) * lg2); }
                else { CJ[tidp] = i * lg2; RI[tidp] = i * lg2; RS[tidp] = exp2f((128.f - i) * lg2); WW[tidp] = exp2f(i * lg2); } }
        } else if (tidp < 128) NV[tidp] = 0.f;
        float pf_a = 0.f, pf_mx = 0.f, pf_cum = 0.f, pf_mxl = 0.f, pf_total = 0.f;
        if (br == 1) { const int ch0 = dir == 0 ? 0 : 1; const size_t rown = (size_t)b * TT + ch0 * 128;
            const size_t gl = ((size_t)dir * MROWS + rown + (dir == 0 ? 127 : 0)) * 8 + hh; pf_mxl = GMX[gl]; pf_total = GCUM[gl];
            if (tidp < 128) { const size_t gi = ((size_t)dir * MROWS + rown + tidp) * 8 + hh; pf_a = GA[gi]; pf_mx = GMX[gi]; pf_cum = GCUM[gi]; } }
        for (int n = 0; n < NCH; ++n) {
            int tid = tid_;
            asm volatile("" : "+v"(tid));
            const int lane = tid & 63, r = tid & 31, h = (tid >> 5) & 1;
            if (n == NSPLIT) { XcdBarrier b2_ = bar; asm volatile("" : "+s"(b2_.bar), "+s"(b2_.x)); xcd_barrier(b2_); }
            const int ch = dir == 0 ? n : (n < 2 ? 1 - n : NCH + 1 - n);
            const unsigned sw16 = (unsigned)((((r & 3) << 2) | ((r >> 2) & 3)) << 4), rb = 256u * (unsigned)r, rb8h = rb + 8u * (unsigned)h, swh16 = sw16 ^ (16u * (unsigned)h);
            const unsigned tq = ((unsigned)lane & 15u) >> 2, tp = (unsigned)lane & 3u, tblk = ((unsigned)lane >> 4) & 1u, tx = 2u * tblk + (tp >> 1);
            const unsigned tb0 = 256u * (8u * h + tq) + 8u * (tp & 1u), tb1 = tb0 + 1024u;
            const unsigned txs0 = 16u * (tx ^ (4u * tq + 2u * h)), txs1 = 16u * (tx ^ (4u * tq + 2u * h + 1u));
            const size_t row0 = (size_t)b * TT + ch * 128;
            char* const IMGs = (char*)(C.ws + WS_IMG) + ((size_t)u * NSPLIT * 8 + wave) * 8192 + lane * 128; const char* const IMGq = (const char*)(C.ws + WS_IMG) + ((size_t)(u ^ 1) * NSPLIT * 8 + wave) * 8192 + lane * 128;
            char* const Yrow = Yob + row0 * (size_t)(DM * 2);
            if (br == 1) {
                const float mml = fmaxf(m, pf_mxl); dec = __expf(m - mml); m_next = pf_total + mml;
                if (tid < 128) { const float mm = fmaxf(m, pf_mx);
                    CJ[tid] = pf_a * LOG2E; RI[tid] = mm * LOG2E; RS[tid] = __expf(m - mm); WW[tid] = __expf(pf_a - mml); EMT[tid] = __expf(-(pf_cum + mm)); }
            }
            stage_tile(LQ, Qg + row0 * ldq, ldq, wave, lane); stage_tile(LK, Kg + row0 * ldq, ldq, wave, lane);
            stage_tile(LV, Vg + row0 * LDP, LDP, wave, lane); stage_tile(LV + 32768, Vg + row0 * LDP + 128, LDP, wave, lane);
            asm volatile("s_waitcnt vmcnt(8)" ::: "memory"); LDS_WAIT(); __builtin_amdgcn_s_barrier(); asm volatile("" ::: "memory");
            if (br == 1 && n + 1 < NCH) {
                const int chn = dir == 0 ? n + 1 : (n + 1 < 2 ? 1 - (n + 1) : NCH + 1 - (n + 1)); const size_t rown = (size_t)b * TT + chn * 128;
                const size_t gl = ((size_t)dir * MROWS + rown + (dir == 0 ? 127 : 0)) * 8 + hh; pf_mxl = GMX[gl]; pf_total = GCUM[gl];
                if (tid < 128) { const size_t gi = ((size_t)dir * MROWS + rown + tid) * 8 + hh; pf_a = GA[gi]; pf_mx = GMX[gi]; pf_cum = GCUM[gi]; } }
            if (br == 1) {
                const int i = tid >> 2, part = tid & 3; float s = 0.f;
#pragma unroll
                for (int c = 0; c < 4; ++c) { const u32x4 qw = *(const LAS u32x4*)(LQ + off_b(i, 4 * part + c)); const LAS float* nv = NV + 32 * part + 8 * c;
                    s += bflo(qw.x) * nv[0] + bfhi(qw.x) * nv[1] + bflo(qw.y) * nv[2] + bfhi(qw.y) * nv[3] + bflo(qw.z) * nv[4] + bfhi(qw.z) * nv[5] + bflo(qw.w) * nv[6] + bfhi(qw.w) * nv[7]; }
                s = quad_sum(s);
                if (part == 0) QN[i] = s;
            }
            LAS unsigned char* const vb0 = LV + (wave >> 2) * 32768 + tb0 + ((unsigned)(64 * (wave & 3)) ^ txs0); LAS unsigned char* const vb1 = LV + (wave >> 2) * 32768 + tb1 + ((unsigned)(64 * (wave & 3)) ^ txs1);
#pragma unroll
            for (int hf = 0; hf < 2; ++hf) {
                const int jb = wave >> 1, ibp = 2 * hf + (wave & 1);
                f32x16 PT;
#pragma unroll
                for (int e = 0; e < 16; ++e) PT[e] = 0.f;
#pragma unroll
                for (int s = 0; s < 8; ++s) {
                    const bf16x8 ka = *(const LAS bf16x8*)(LK + 8192 * jb + rb + ((unsigned)(32 * s) ^ swh16));
                    const bf16x8 qb = *(const LAS bf16x8*)(LQ + 8192 * ibp + rb + ((unsigned)(32 * s) ^ swh16));
                    PT = MFMA32(ka, qb, PT);
                }
                { const int i = 32 * ibp + r; const float ri = RI[i]; float rsum = 0.f;
#pragma unroll
                  for (int g = 0; g < 4; ++g) { const f32x4 cj4 = *(const LAS f32x4*)(CJ + 32 * jb + 8 * g + 4 * h);
#pragma unroll
                      for (int e = 0; e < 4; ++e) { const int j = 32 * jb + 8 * g + 4 * h + e; const bool ok = dir == 0 ? (j <= i) : (j >= i);
                          const float f = ok ? __builtin_amdgcn_exp2f(cj4[e] - ri) : 0.f; const float pv = PT[4 * g + e] * f; PT[4 * g + e] = pv; rsum += pv; } }
                  if (br == 1) { rsum += bperm_f(rsum, lane ^ 32); if (h == 0) RSUM[jb * 128 + i] = rsum; } }
                if (hf == 0) VM_WAIT();
                __syncthreads();
                if (hf == 1 && n >= NSPLIT) reduce_ss(PSUMh, PSUMh2, tid, SSh + row0 + 0);
#pragma unroll
                for (int g = 0; g < 4; ++g) { u32x2 w; w.x = pk2(PT[4 * g], PT[4 * g + 1]); w.y = pk2(PT[4 * g + 2], PT[4 * g + 3]);
                    *(LAS u32x2*)(LP + 8192 * (wave & 1) + rb8h + ((unsigned)(64 * jb + 16 * g) ^ sw16)) = w; }
                if (br == 1 && tid < 64) { const int i = 64 * hf + tid; const float den = (RSUM[i] + RSUM[128 + i]) + (RSUM[256 + i] + RSUM[384 + i]) + RS[i] * QN[i]; INV[i] = 1.0f / fmaxf(fabsf(den), EMT[i]); }
                __syncthreads();
                {
                    u32x4 pw[2][2];
                    if (n >= NSPLIT) { const char* pp = IMGq + (size_t)(NCH + 1 - n) * 8 * 8192 + (2 * hf) * 32;
                        pw[0][0] = *(const u32x4*)pp; pw[0][1] = *(const u32x4*)(pp + 16); pw[1][0] = *(const u32x4*)(pp + 32); pw[1][1] = *(const u32x4*)(pp + 48); }
#pragma unroll
                    for (int q = 0; q < 2; ++q) {
                        const int ib = 2 * hf + q;
                        f32x16 Y;
#pragma unroll
                        for (int e = 0; e < 16; ++e) Y[e] = 0.f;
#pragma unroll
                        for (int t = 0; t < 4; ++t)
#pragma unroll
                            for (int s = 0; s < 2; ++s) {
                                u32x4 sw_; sw_.x = pk2(S[t][8 * s], S[t][8 * s + 1]); sw_.y = pk2(S[t][8 * s + 2], S[t][8 * s + 3]); sw_.z = pk2(S[t][8 * s + 4], S[t][8 * s + 5]); sw_.w = pk2(S[t][8 * s + 6], S[t][8 * s + 7]);
                                const bf16x8 bs = __builtin_bit_cast(bf16x8, sw_);
                                const s16x4 a0 = *(const LAS s16x4*)(LQ + 8192 * ib + rb8h + ((unsigned)((4 * t + 2 * s) * 16) ^ sw16));
                                const s16x4 a1 = *(const LAS s16x4*)(LQ + 8192 * ib + rb8h + ((unsigned)((4 * t + 2 * s + 1) * 16) ^ sw16));
                                const bf16x8 av = __builtin_shufflevector(a0, a1, 0, 1, 2, 3, 4, 5, 6, 7);
                                Y = MFMA32(av, bs, Y);
                            }
#pragma unroll
                        for (int g = 0; g < 4; ++g) { const f32x4 rs4 = *(const LAS f32x4*)(RS + 32 * ib + 8 * g + 4 * h);
#pragma unroll
                            for (int e = 0; e < 4; ++e) Y[4 * g + e] *= rs4[e]; }
#pragma unroll
                        for (int ks = 0; ks < 8; ++ks) { const bf16x8 bvk = tr_frag2(vb0 + 4096 * ks, vb1 + 4096 * ks);
                            const bf16x8 pa = *(const LAS bf16x8*)(LP + 8192 * q + rb + ((unsigned)(32 * ks) ^ swh16)); Y = MFMA32(pa, bvk, Y); }
                        if (br == 1) {
#pragma unroll
                            for (int g = 0; g < 4; ++g) { const f32x4 sc4 = *(const LAS f32x4*)(INV + 32 * ib + 8 * g + 4 * h);
#pragma unroll
                                for (int e = 0; e < 4; ++e) Y[4 * g + e] *= sc4[e]; } }
                        if (n < NSPLIT) { char* op = IMGs + (size_t)n * 8 * 8192 + (2 * hf + q) * 32;
                            u32x4 w0, w1; w0.x = pk2(Y[0], Y[1]); w0.y = pk2(Y[2], Y[3]); w0.z = pk2(Y[4], Y[5]); w0.w = pk2(Y[6], Y[7]);
                            w1.x = pk2(Y[8], Y[9]); w1.y = pk2(Y[10], Y[11]); w1.z = pk2(Y[12], Y[13]); w1.w = pk2(Y[14], Y[15]);
                            *(u32x4*)op = w0; *(u32x4*)(op + 16) = w1;
                        } else { add_image(Y, pw[q][0], pw[q][1]); emit_q(Y, q, PSUMh, PSUMh2, wave, lane, r, h, Yrow, hf); }
                    }
                }
            }
#pragma unroll
            for (int t = 0; t < 4; ++t)
#pragma unroll
                for (int e = 0; e < 16; ++e) S[t][e] *= dec;
#pragma unroll
            for (int ks = 0; ks < 8; ++ks) {
                const f32x4 w0 = *(const LAS f32x4*)(WW + 16 * ks + 8 * h), w1 = *(const LAS f32x4*)(WW + 16 * ks + 8 * h + 4);
                const bf16x8 bvk = tr_frag2(vb0 + 4096 * ks, vb1 + 4096 * ks);
                const u32x4 vw = __builtin_bit_cast(u32x4, bvk);
                u32x4 sw; sw.x = pk2(bflo(vw.x) * w0[0], bfhi(vw.x) * w0[1]); sw.y = pk2(bflo(vw.y) * w0[2], bfhi(vw.y) * w0[3]); sw.z = pk2(bflo(vw.z) * w1[0], bfhi(vw.z) * w1[1]); sw.w = pk2(bflo(vw.w) * w1[2], bfhi(vw.w) * w1[3]);
                const bf16x8 bw = __builtin_bit_cast(bf16x8, sw);
                bf16x8 ka[4];
#pragma unroll
                for (int t = 0; t < 4; ++t) ka[t] = tr_frag2(LK + 4096 * ks + tb0 + ((unsigned)(64 * t) ^ txs0), LK + 4096 * ks + tb1 + ((unsigned)(64 * t) ^ txs1));
                __builtin_amdgcn_sched_barrier(0);
#pragma unroll
                for (int t = 0; t < 4; ++t) S[t] = MFMA32(ka[t], bw, S[t]);
            }
            if (br == 1) {
                const int dg = tid & 15, jp = tid >> 4; float s8[8];
#pragma unroll
                for (int e = 0; e < 8; ++e) s8[e] = 0.f;
#pragma unroll
                for (int jj = 0; jj < 4; ++jj) { const int j = 4 * jp + jj; const u32x4 kw = *(const LAS u32x4*)(LK + off_b(j, dg)); const float wj = WW[j];
                    s8[0] += wj * bflo(kw.x); s8[1] += wj * bfhi(kw.x); s8[2] += wj * bflo(kw.y); s8[3] += wj * bfhi(kw.y); s8[4] += wj * bflo(kw.z); s8[5] += wj * bfhi(kw.z); s8[6] += wj * bflo(kw.w); s8[7] += wj * bfhi(kw.w); }
#pragma unroll
                for (int e = 0; e < 8; ++e) { s8[e] += swz_xor16(s8[e]); s8[e] += bperm_f(s8[e], lane ^ 32); }
                if ((tid & 63) < 16) {
#pragma unroll
                    for (int e = 0; e < 8; ++e) NP2[wave * 128 + 8 * dg + e] = s8[e]; }
            }
            __syncthreads();
            if (n >= NSPLIT) reduce_ss(PSUMh, PSUMh2, tid, SSh + row0 + 64);
            if (br == 1) { if (tid < 128) NV[tid] = dec * NV[tid] + ((NP2[tid] + NP2[128 + tid]) + (NP2[256 + tid] + NP2[384 + tid])) + ((NP2[512 + tid] + NP2[640 + tid]) + (NP2[768 + tid] + NP2[896 + tid])); m = m_next; }
        }
        { __syncthreads();
          int tidc = tid_; asm volatile("" : "+v"(tidc));
          const int lanec = tidc & 63, rc = tidc & 31, hc = (tidc >> 5) & 1;
          char* const IMGoc = (char*)(C.ws + WS_IMG) + ((size_t)u * NSPLIT * 8 + wave) * 8192 + lanec * 128; const char* const IMGpc = (const char*)(C.ws + WS_IMG) + ((size_t)(u ^ 1) * NSPLIT * 8 + wave) * 8192 + lanec * 128;
          char* const YNc = Yob + ((size_t)b * TT + (dir == 0 ? 0 : 128)) * (size_t)(DM * 2);
#pragma unroll
          for (int hf = 0; hf < 2; ++hf) {
#pragma unroll
              for (int q = 0; q < 2; ++q) { f32x16 Yc;
#pragma unroll
                  for (int e = 0; e < 16; ++e) Yc[e] = 0.f;
                  const u32x4 o0 = *(const u32x4*)(IMGoc + (2 * hf + q) * 32), o1 = *(const u32x4*)(IMGoc + (2 * hf + q) * 32 + 16);
                  const u32x4 p0 = *(const u32x4*)(IMGpc + (size_t)8 * 8192 + (2 * hf + q) * 32), p1 = *(const u32x4*)(IMGpc + (size_t)8 * 8192 + (2 * hf + q) * 32 + 16);
                  add_image(Yc, o0, o1); add_image(Yc, p0, p1); emit_q(Yc, q, PSUMh, PSUMh2, wave, lanec, rc, hc, YNc, hf); }
              __syncthreads(); reduce_ss(PSUMh, PSUMh2, tidc, SSh + (size_t)b * TT + (dir == 0 ? 0 : 128) + 64 * hf); __syncthreads(); } }
    }
}
__device__ __forceinline__ void unpack8(const u32x4 w, float (&f)[8]) { f[0] = bflo(w.x); f[1] = bfhi(w.x); f[2] = bflo(w.y); f[3] = bfhi(w.y); f[4] = bflo(w.z); f[5] = bfhi(w.z); f[6] = bflo(w.w); f[7] = bfhi(w.w); }
__device__ __forceinline__ void conv_fix_phase(const Ctx& C, int l) {
    const bf16* RAW = (const bf16*)(C.ws + WS_RAW); bf16* ACT = (bf16*)(C.ws + WS_ACT);
    const float* fw = C.inp(17) + (size_t)l * 3 * UPN; const float* fb = C.inp(18) + (size_t)l * UPN;
    const int gt = C.vcu * NTHR + C.tid, NT = C.G * NTHR;
    for (int idx = gt; idx < (MROWS / 256) * 2 * 704; idx += NT) {
        const int pm = idx / 1408, rem = idx - pm * 1408, k = rem / 704, cg = rem - k * 704, j = pm % 17;
        if (j == 0 || (k == 0 && j == 1) || (k == 1 && j == 16)) continue;
        const bf16* P = k == 0 ? RAW + ((size_t)(pm - 1) * 4 + 3) * UPN : RAW + ((size_t)pm * 4 + 2) * UPN;
        const bf16* Cc = k == 0 ? RAW + ((size_t)pm * 4 + 0) * UPN : RAW + ((size_t)pm * 4 + 3) * UPN;
        const bf16* Nn = k == 0 ? RAW + ((size_t)pm * 4 + 1) * UPN : RAW + ((size_t)(pm + 1) * 4 + 0) * UPN;
        const size_t row = (size_t)pm * 256 + (k ? 255 : 0);
        float pa[8], ca[8], na[8], pg[8], cgv[8], ng[8];
        unpack8(*(const u32x4*)(P + cg * 8), pa); unpack8(*(const u32x4*)(Cc + cg * 8), ca); unpack8(*(const u32x4*)(Nn + cg * 8), na);
        unpack8(*(const u32x4*)(P + FF + cg * 8), pg); unpack8(*(const u32x4*)(Cc + FF + cg * 8), cgv); unpack8(*(const u32x4*)(Nn + FF + cg * 8), ng);
        float o[8];
#pragma unroll
        for (int e = 0; e < 8; ++e) { const int ca_ = cg * 8 + e, cgc = FF + cg * 8 + e;
            const float a = fb[ca_] + fw[ca_] * pa[e] + fw[UPN + ca_] * ca[e] + fw[2 * UPN + ca_] * na[e];
            const float g = fb[cgc] + fw[cgc] * pg[e] + fw[UPN + cgc] * cgv[e] + fw[2 * UPN + cgc] * ng[e];
            o[e] = silu_f(a) * g; }
        u32x4 w; w.x = pk2(o[0], o[1]); w.y = pk2(o[2], o[3]); w.z = pk2(o[4], o[5]); w.w = pk2(o[6], o[7]);
        *(u32x4*)(ACT + row * FF + cg * 8) = w;
    }
}
#ifndef PHASE_MASK
#define PHASE_MASK 0xFFFFFFFFu
#endif
#ifndef DOUBLE_MASK
#define DOUBLE_MASK 0u
#endif
constexpr int CV_TF0 = 0, CV_TF1 = 4500, CV_TG1 = CV_I3, CV_TK = CV_I5;
#define TAILCV(lo, hi) if (l + 1 < NLAYER && C.G == 256) { __syncthreads(); refresh(C); const int ci_ = BX - 64; convert_weights(C, l + 1, (lo), (hi), ci_ >= 0 ? ci_ * NWAVES + C.wave : -1, 192 * NWAVES); } \
                       else if (l + 1 < NLAYER) { __syncthreads(); refresh(C); convert_weights(C, l + 1, (lo), (hi), C.vcu * NWAVES + C.wave, C.G * NWAVES); }
#define BX ((C.vcu & 31) * 8 + (C.vcu >> 5))
#define RUN(n) refresh(C); if ((PHASE_MASK >> (n)) & 1u)
#define DUP(n, ...) if ((DOUBLE_MASK >> (n)) & 1u) { __syncthreads(); refresh(C); __VA_ARGS__; }
__device__ __forceinline__ void refresh(Ctx& C) {
    asm volatile("" : "+v"(C.tid)); asm volatile("" : "+s"(C.vcu)); C.lane = C.tid & 63;
}
#define GRID_BAR() do { XcdBarrier b2_ = bar; asm volatile("" : "+s"(b2_.bar), "+s"(b2_.x)); xcd_barrier(b2_); } while (0)
constexpr int WGM_NARROW = 4;
constexpr bool GEMM_SP2 = true, GEMM_ALIGN = true;
struct Params { const float* in[20]; float* out; unsigned char* ws; };
__global__ void __launch_bounds__(NTHR, 2) fwd_kernel(Params prm) {
    extern __shared__ __attribute__((aligned(16))) unsigned char lds_raw[];
    Ctx C;
    C.lds = (LAS unsigned char*)lds_raw;
    C.tid = threadIdx.x; C.lane = C.tid & 63; C.wave = __builtin_amdgcn_readfirstlane(C.tid >> 6);
    C.G = 256; { const int bx = blockIdx.x; C.vcu = (bx % 8) * (C.G / 8) + bx / 8; }
    C.out = prm.out; C.ws = prm.ws;
    volatile LAS unsigned* MISC = (volatile LAS unsigned*)(C.lds + MISC_OFF);
    if (C.tid < 16) MISC[C.tid] = 0u;
    __syncthreads();
    XcdBarrier bar = xcd_barrier_post((unsigned*)(C.ws + WS_CTL), MISC + 8);
    unsigned char* ws = C.ws;
    const float* MOD = (const float*)(ws + WS_MOD);
    bf16* Hb = (bf16*)(ws + WS_H);
    float* XC = (float*)(ws + WS_XC);

    RUN(0) mod_phase(C, 0, 1, C.vcu, C.G); RUN(1) rope_table(C); __syncthreads(); RUN(2) convert_weights(C, 0, 0, CV_I4, C.vcu * NWAVES + C.wave, C.G * NWAVES);
    DUP(2, convert_weights(C, 0, 0, CV_I4, C.vcu * NWAVES + C.wave, C.G * NWAVES))
    DUP(0, mod_phase(C, 0, 1, C.vcu, C.G))
    GRID_BAR();
    RUN(3) rn_phase<false, true>(C, 0, C.inp(0), C.inp(2), nullptr, nullptr, nullptr, nullptr, 0, nullptr, MOD, 0, 1, C.inp(6), Hb);
    DUP(3, rn_phase<false, true>(C, 0, C.inp(0), C.inp(2), nullptr, nullptr, nullptr, nullptr, 0, nullptr, MOD, 0, 1, C.inp(6), Hb))
    GRID_BAR();

    for (int l = 0; l < NLAYER; ++l) {
        const float* MODl = MOD + (size_t)l * 9 * MODW;
        const int lastl = (l == NLAYER - 1) ? 1 : 0;
        const int MG = lastl ? NB * SEQ : MROWS;
        RUN(4) { pg8::Gemm g{Hb, (const bf16*)(ws + WS_W1T), MROWS, N1, DM}; pg8::StaticOrder S; S.init(MROWS, N1, C.G, BX);
          pg8::EpiProj1 E{(bf16*)(ws + WS_PROJ), (float*)(ws + WS_GATES), C.inp(10) + (size_t)l * 32, (const float*)(ws + WS_ROPE), (const float*)(ws + WS_ROPE) + 2048,
                           (bf16*)(ws + WS_MQK), (bf16*)(ws + WS_RAWQ), C.inp(8) + (size_t)l * 3 * 2048, C.inp(9) + (size_t)l * 2048, (LAS float*)(C.lds + PBUF_OFF)};
          pg8::gemm_phase<pg8::EpiProj1, pg8::StaticOrder, GEMM_ALIGN, GEMM_SP2>(C.lds, g, S, E, C.tid); }
        DUP(4, { pg8::Gemm g{Hb, (const bf16*)(ws + WS_W1T), MROWS, N1, DM}; pg8::StaticOrder S; S.init(MROWS, N1, C.G, BX);
          pg8::EpiProj1 E{(bf16*)(ws + WS_PROJ), (float*)(ws + WS_GATES), C.inp(10) + (size_t)l * 32, (const float*)(ws + WS_ROPE), (const float*)(ws + WS_ROPE) + 2048,
                           (bf16*)(ws + WS_MQK), (bf16*)(ws + WS_RAWQ), C.inp(8) + (size_t)l * 3 * 2048, C.inp(9) + (size_t)l * 2048, (LAS float*)(C.lds + PBUF_OFF)};
          pg8::gemm_phase<pg8::EpiProj1, pg8::StaticOrder, GEMM_ALIGN, GEMM_SP2>(C.lds, g, S, E, C.tid); })
        { __syncthreads(); refresh(C); const int ci_ = BX - 136; const int iw_ = ci_ >= 0 ? ci_ * NWAVES + C.wave : -1;
          convert_weights(C, l, CV_I5, CV_I6, iw_, 120 * NWAVES);
          if (l > 0) convert_weights(C, l, CV_I3, CV_I4, iw_, 120 * NWAVES); }
        GRID_BAR();
        RUN(5) conv_gate_phase(C, l);
        DUP(5, conv_gate_phase(C, l))
        GRID_BAR();
        RUN(6) scan_phase(C, l, bar);
        DUP(6, scan_phase(C, l, bar))
        GRID_BAR();
        RUN(7) { pg8::Gemm g{Hb, (const bf16*)(ws + WS_W2T), MROWS, N2, DM}; pg8::StaticOrder S; S.init(MG, N2, C.G, BX, lastl);
          pg8::EpiMerge E{(bf16*)(ws + WS_Y4), (size_t)MROWS * DM, C.inp(12) + (size_t)l * 2 * DM, (bf16*)(ws + WS_PROJ), LDP, (const float*)(ws + WS_SS), MROWS, EPSN};
          pg8::gemm_phase<pg8::EpiMerge, pg8::StaticOrder, true, GEMM_SP2>(C.lds, g, S, E, C.tid); }
        GRID_BAR();
        RUN(9) { pg8::Gemm g{(const bf16*)(ws + WS_Y4), (const bf16*)(ws + WS_WRO), MROWS, DM, DM}; pg8::StaticOrder S; S.init(MG, DM, C.G, BX, lastl, WGM_NARROW);
          pg8::EpiGate<false> E{(bf16*)(ws + WS_Y4 + SLOT), DM, (const bf16*)(ws + WS_PROJ) + 4096, LDP};
          pg8::gemm_phase<pg8::EpiGate<false>, pg8::StaticOrder, GEMM_ALIGN, GEMM_SP2>(C.lds, g, S, E, C.tid); }
        RUN(10) { pg8::Gemm g{(const bf16*)(ws + WS_Y4 + 2 * SLOT), (const bf16*)(ws + WS_WMO), MROWS, DM, DM}; pg8::StaticOrder S; S.init(MG, DM, C.G, BX, lastl, WGM_NARROW);
          pg8::EpiGate<true> E{(bf16*)(ws + WS_Y4 + SLOT), DM, (const bf16*)(ws + WS_PROJ) + 6144, LDP};
          pg8::gemm_phase<pg8::EpiGate<true>, pg8::StaticOrder, GEMM_ALIGN, GEMM_SP2>(C.lds, g, S, E, C.tid); }
        DUP(9, { pg8::Gemm g{(const bf16*)(ws + WS_Y4), (const bf16*)(ws + WS_WRO), MROWS, DM, DM}; pg8::StaticOrder S; S.init(MG, DM, C.G, BX, lastl, WGM_NARROW);
          pg8::EpiGate<false> E{(bf16*)(ws + WS_Y4 + SLOT), DM, (const bf16*)(ws + WS_PROJ) + 4096, LDP};
          pg8::gemm_phase<pg8::EpiGate<false>, pg8::StaticOrder, GEMM_ALIGN, GEMM_SP2>(C.lds, g, S, E, C.tid); }; __syncthreads(); refresh(C); { pg8::Gemm g{(const bf16*)(ws + WS_Y4 + 2 * SLOT), (const bf16*)(ws + WS_WMO), MROWS, DM, DM}; pg8::StaticOrder S; S.init(MG, DM, C.G, BX, lastl, WGM_NARROW);
          pg8::EpiGate<true> E{(bf16*)(ws + WS_Y4 + SLOT), DM, (const bf16*)(ws + WS_PROJ) + 6144, LDP};
          pg8::gemm_phase<pg8::EpiGate<true>, pg8::StaticOrder, GEMM_ALIGN, GEMM_SP2>(C.lds, g, S, E, C.tid); })
        { __syncthreads(); refresh(C); const int ci_ = BX - 64;
          if (l + 1 < NLAYER && ci_ >= 0) { mod_phase(C, l + 1, 1, ci_, 192); __syncthreads(); refresh(C); }
          const int iw_ = ci_ >= 0 ? ci_ * NWAVES + C.wave : -1;
          convert_weights(C, l, CV_I4, CV_I5, iw_, 192 * NWAVES);
          if (l + 1 < NLAYER) convert_weights(C, l + 1, CV_TF0, CV_TF1, iw_, 192 * NWAVES); }
        GRID_BAR();
        RUN(11) { pg8::Gemm g{(const bf16*)(ws + WS_Y4 + SLOT), (const bf16*)(ws + WS_WO), MROWS, DM, DM}; pg8::StaticOrder S; S.init(MG, DM, C.G, BX, lastl, WGM_NARROW);
          pg8::EpiPlain E{(bf16*)(ws + WS_Y4 + 3 * SLOT), DM, nullptr, nullptr};
          pg8::gemm_phase<pg8::EpiPlain, pg8::StaticOrder, GEMM_ALIGN, GEMM_SP2>(C.lds, g, S, E, C.tid); }
        DUP(11, { pg8::Gemm g{(const bf16*)(ws + WS_Y4 + SLOT), (const bf16*)(ws + WS_WO), MROWS, DM, DM}; pg8::StaticOrder S; S.init(MG, DM, C.G, BX, lastl, WGM_NARROW);
          pg8::EpiPlain E{(bf16*)(ws + WS_Y4 + 3 * SLOT), DM, nullptr, nullptr};
          pg8::gemm_phase<pg8::EpiPlain, pg8::StaticOrder, GEMM_ALIGN, GEMM_SP2>(C.lds, g, S, E, C.tid); })
        TAILCV(CV_TF1, CV_TG1)
        GRID_BAR();
        RUN(12) rn_phase<true, true>(C, lastl, l == 0 ? C.inp(0) : C.out, l == 0 ? C.inp(2) : XC, C.out, XC, (const bf16*)(ws + WS_Y4 + 3 * SLOT),
                             MODl, 2, C.inp(6) + ((size_t)l * 4 + 1) * DM, MODl, 3, 4, C.inp(6) + ((size_t)l * 4 + 2) * DM, Hb);
        GRID_BAR();
        RUN(13) { pg8::Gemm g{Hb, (const bf16*)(ws + WS_WUT), MROWS, UPN, DM}; pg8::StaticOrder S; S.init(MG, UPN, C.G, BX, lastl);
          pg8::EpiConvAct E{(bf16*)(ws + WS_ACT), (bf16*)(ws + WS_RAW), C.inp(17) + (size_t)l * 3 * UPN, C.inp(18) + (size_t)l * UPN, (LAS float*)(C.lds + PBUF_OFF), FF, UPN};
          pg8::gemm_phase<pg8::EpiConvAct, pg8::StaticOrder, true, GEMM_SP2>(C.lds, g, S, E, C.tid); }
        DUP(13, { pg8::Gemm g{Hb, (const bf16*)(ws + WS_WUT), MROWS, UPN, DM}; pg8::StaticOrder S; S.init(MG, UPN, C.G, BX, lastl);
          pg8::EpiConvAct E{(bf16*)(ws + WS_ACT), (bf16*)(ws + WS_RAW), C.inp(17) + (size_t)l * 3 * UPN, C.inp(18) + (size_t)l * UPN, (LAS float*)(C.lds + PBUF_OFF), FF, UPN};
          pg8::gemm_phase<pg8::EpiConvAct, pg8::StaticOrder, true, GEMM_SP2>(C.lds, g, S, E, C.tid); })
        GRID_BAR();
        RUN(14) conv_fix_phase(C, l);
        GRID_BAR();
        unsigned* const ctl = (unsigned*)(ws + WS_CTL);
        RUN(15) { pg8::Gemm g{(const bf16*)(ws + WS_ACT), (const bf16*)(ws + WS_WDT), MROWS, DM, FF}; pg8::StaticOrder S; S.init(NB * SEQ, DM, C.G, BX, 1, WGM_NARROW);
          if (!lastl) { S.sig = 1; if ((C.vcu & 31) < 8) { S.xpm = 17 * (C.vcu >> 5); S.xpn = C.vcu & 31; } }
          pg8::EpiPlain E{(bf16*)(ws + WS_OUTF), DM, ctl + 4096, ctl + 4352 + 64 * (C.vcu >> 5)};
          pg8::gemm_phase<pg8::EpiPlain, pg8::StaticOrder, GEMM_ALIGN, GEMM_SP2>(C.lds, g, S, E, C.tid); }
        if (lastl) GRID_BAR();
        if (l + 1 < NLAYER) {
            RUN(16) rn_phase<true, true>(C, 0, C.out, XC, C.out, XC, (const bf16*)(ws + WS_OUTF), MODl, 5, C.inp(6) + ((size_t)l * 4 + 3) * DM,
                                 MODl + 9 * MODW, 0, 1, C.inp(6) + ((size_t)(l + 1) * 4) * DM, Hb, ctl + 4096, 256u * (unsigned)(l + 1), ctl + 4352 + 64 * (C.vcu >> 5), 8u * (unsigned)(l + 1));
            GRID_BAR();
        } else {
            RUN(16) rn_phase<true, false>(C, 1, C.out, XC, C.out, XC, (const bf16*)(ws + WS_OUTF), MODl, 5, C.inp(6) + ((size_t)l * 4 + 3) * DM, nullptr, 0, 0, nullptr, nullptr);
        }
    }
}

extern "C" void kernel_launch(void* const* d_in, const int* in_sizes, int n_in, void* d_out, int out_size, void* d_ws, size_t ws_size, hipStream_t stream) {
    static int grid = 0;
    if (grid == 0) {
        if (n_in != 20 || ws_size < WS_END) { fprintf(stderr, "kernel_launch: need 20 inputs and >= %zu bytes of workspace (got %d, %zu)\n", (size_t)WS_END, n_in, ws_size); grid = -1; return; }
        int dev = 0, cus = 0, per_cu = 0;
        if (hipGetDevice(&dev) != hipSuccess || hipDeviceGetAttribute(&cus, hipDeviceAttributeMultiprocessorCount, dev) != hipSuccess) { grid = -1; return; }
        if (hipFuncSetAttribute((const void*)fwd_kernel, hipFuncAttributeMaxDynamicSharedMemorySize, LDS_BYTES) != hipSuccess) { fprintf(stderr, "kernel_launch: hipFuncSetAttribute failed\n"); grid = -1; return; }
        if (hipOccupancyMaxActiveBlocksPerMultiprocessor(&per_cu, (const void*)fwd_kernel, NTHR, LDS_BYTES) != hipSuccess || per_cu < 1) { fprintf(stderr, "kernel_launch: occupancy query says %d blocks per CU\n", per_cu); (void)hipGetLastError(); grid = -1; return; }
        grid = cus;
        if (grid != 256) { fprintf(stderr, "kernel_launch: built for 256 CUs (one scan unit per workgroup, mid-phase grid barrier); this device has %d\n", cus); grid = -1; return; }
    }
    if (grid < 0) return;
    (void)in_sizes; (void)out_size;
    if (hipMemsetAsync((char*)d_ws + WS_CTL, 0, CTL_ZERO_BYTES, stream) != hipSuccess) return;
    Params p{};
    for (int i = 0; i < 20; ++i) p.in[i] = (const float*)d_in[i];
    p.out = (float*)d_out; p.ws = (unsigned char*)d_ws;
    hipLaunchKernelGGL(fwd_kernel, dim3(grid), dim3(NTHR), LDS_BYTES, stream, p);
}
```

```cpp
#include <hip/hip_runtime.h>
#include <cstdio>
#include <cstdint>

namespace pg8 {
#define PG8_LAS __attribute__((address_space(3)))
typedef unsigned short bf16_t;
typedef short bf16x8 __attribute__((ext_vector_type(8)));
typedef float f32x4 __attribute__((ext_vector_type(4)));
typedef unsigned u32x4 __attribute__((ext_vector_type(4)));
constexpr int BM = 256, BK = 64, HALF = 128, HTB = HALF * BK * 2  , STAGE_BYTES = 8 * HTB, NXCD = 8, WGM = 4;

__host__ __device__ __forceinline__ int lds_byte(int r, int c) { const int st = (r >> 4) * 2 + (c >> 5), rr = r & 15, cc = c & 31, ob = rr * 64 + cc * 2; return st * 1024 + (ob ^ (((ob >> 9) & 1) << 5)); }
__host__ __device__ __forceinline__ void stage_rc(int b, int& R, int& C) { const int st = b / 1024, sb = b % 1024, swz = sb ^ (((sb >> 9) & 1) << 5); R = (st >> 1) * 16 + swz / 64; C = (st & 1) * 32 + (swz % 64) / 2; }
__host__ __device__ __forceinline__ int perm32(int rho) { const int n = rho >> 4, i = rho & 15; return 8 * (i >> 2) + 4 * n + (i & 3); }

struct Unit { int pm, pn, flag; };
struct Gemm { const bf16_t* A; const bf16_t* Bt; int M, N, K; };

struct StaticOrder {
    int nM, nN, nwg, G, c, skip, wgm;
    int base, lim;
    int sig, xpm, xpn;
    __host__ __device__ void init(int M, int N, int G_, int c_, int skip_ = 0, int wgm_ = WGM) { nM = M / BM; nN = N / BM; nwg = nM * nN; G = G_; c = c_; skip = skip_; wgm = wgm_; sig = 0; xpm = 0; xpn = -1; base = 0; lim = 0x7fffffff; }
    __host__ __device__ bool next(int i, Unit& u) const {
        const long L = (long)base + (long)i * G + c; u.flag = (sig && L + G >= nwg) ? 1 : 0;
        if (L >= nwg || L >= lim) { if (xpn >= 0 && L >= nwg && L < nwg + G) { u.pm = xpm; u.pn = xpn; u.flag = sig ? 2 : 0; return true; } return false; }
        int wgid = (int)L; { const int q = nwg / NXCD, r = nwg % NXCD, xcd = wgid % NXCD, off = wgid / NXCD; wgid = (xcd < r ? xcd * (q + 1) : r * (q + 1) + (xcd - r) * q) + off; }
        const int nig = wgm * nN, gid = wgid / nig, fm = gid * wgm, gsz = (nM - fm) < wgm ? (nM - fm) : wgm;
        u.pm = fm + ((wgid % nig) % gsz); u.pn = (wgid % nig) / gsz; if (skip) u.pm += (u.pm >> 4) + 1; return true;
    }
    __device__ __forceinline__ void a_ready(const Unit&) const {}
    __device__ __forceinline__ void done(const Unit&) const {}
};
__device__ __forceinline__ unsigned pk2(float lo, float hi) {
    typedef __bf16 b2_t __attribute__((ext_vector_type(2))); typedef float f2_t __attribute__((ext_vector_type(2)));
    f2_t f = {lo, hi}; b2_t b = __builtin_convertvector(f, b2_t); return __builtin_bit_cast(unsigned, b); }
__device__ __forceinline__ float bflo(unsigned w) { return __uint_as_float(w << 16); }
__device__ __forceinline__ float bfhi(unsigned w) { return __uint_as_float(w & 0xffff0000u); }
typedef float f32x2_t __attribute__((ext_vector_type(2)));
__device__ __forceinline__ f32x2_t sigmoid2(f32x2_t x) { const f32x2_t t = x * -1.4426950408889634f; const f32x2_t d = (f32x2_t){__builtin_amdgcn_exp2f(t.x), __builtin_amdgcn_exp2f(t.y)} + 1.0f;
    return (f32x2_t){__builtin_amdgcn_rcpf(d.x), __builtin_amdgcn_rcpf(d.y)}; }
__device__ __forceinline__ unsigned pk2v(f32x2_t f) { typedef __bf16 b2_t __attribute__((ext_vector_type(2))); return __builtin_bit_cast(unsigned, __builtin_convertvector(f, b2_t)); }

#define PG8_DPP(old, src, ctrl) __builtin_bit_cast(float, __builtin_amdgcn_update_dpp(__builtin_bit_cast(int, (float)(old)), __builtin_bit_cast(int, (float)(src)), (ctrl), 0xf, 0xf, false))
struct EpiPlain {
    static constexpr bool PERM = true, AFTER_DRAIN = false, PERMA = false;
    bf16_t* O; int ldc; unsigned* cnt_lat; unsigned* cnt_ctx;
    __device__ __forceinline__ void operator()(const f32x4 (&acc)[2][2][4][2], const Unit& u, int wr, int wc, int fr, int fq) const {
        const int row0 = u.pm * BM + wr * 64 + fr, col0 = u.pn * BM + wc * 32 + 8 * fq;
#pragma unroll
        for (int ai = 0; ai < 2; ++ai)
#pragma unroll
            for (int m = 0; m < 4; ++m) { bf16_t* rowp = O + (size_t)(row0 + ai * HALF + m * 16) * ldc + col0;
#pragma unroll
                for (int bj = 0; bj < 2; ++bj) { const f32x4 v0 = acc[ai][bj][m][0], v1 = acc[ai][bj][m][1];
                    u32x4 w; w.x = pk2(v0[0], v0[1]); w.y = pk2(v0[2], v0[3]); w.z = pk2(v1[0], v1[1]); w.w = pk2(v1[2], v1[3]);
                    *(u32x4*)(rowp + bj * HALF) = w; } }
        if (u.flag) { asm volatile("s_waitcnt vmcnt(0)" ::: "memory"); __builtin_amdgcn_s_barrier();
            if (wr == 0 && wc == 0 && fr == 0 && fq == 0) { __builtin_amdgcn_fence(__ATOMIC_RELEASE, "agent"); asm volatile("s_waitcnt vmcnt(0)" ::: "memory");
                (void)__hip_atomic_fetch_add(u.flag == 1 ? cnt_lat : cnt_ctx, 1u, __ATOMIC_RELAXED, __HIP_MEMORY_SCOPE_AGENT); } }
    }
};
struct EpiProj1 {
    static constexpr bool PERM = true, AFTER_DRAIN = false, PERMA = false;
    bf16_t* O; float* gates; const float* gate_b; const float* ropeC; const float* ropeS;
    bf16_t* MQK; bf16_t* RAWQ; const float* cw; const float* cb; PG8_LAS float* EX;
    __device__ __forceinline__ void operator()(const f32x4 (&acc)[2][2][4][2], const Unit& u, int wr, int wc, int fr, int fq) const {
        const int row0 = u.pm * BM + wr * 64 + fr;
        if (u.pn >= 16 && u.pn < 24) {
            const int chb = (u.pn - 16) * BM + wc * 32 + 8 * fq;
            const float scl = u.pn < 20 ? 0.08838834764831845f : 1.0f;
#pragma unroll
            for (int ai = 0; ai < 2; ++ai) { const int blk = 2 * ai + wr;
                if (fr == 0) {
#pragma unroll
                    for (int bj = 0; bj < 2; ++bj)
#pragma unroll
                        for (int n = 0; n < 2; ++n) *(PG8_LAS f32x4*)(EX + (((wc * 8 + 2 * blk) * 4 + fq) * 16 + bj * 8 + n * 4)) = acc[ai][bj][0][n]; }
                if (fr == 15) {
#pragma unroll
                    for (int bj = 0; bj < 2; ++bj)
#pragma unroll
                        for (int n = 0; n < 2; ++n) *(PG8_LAS f32x4*)(EX + (((wc * 8 + 2 * blk + 1) * 4 + fq) * 16 + bj * 8 + n * 4)) = acc[ai][bj][3][n]; } }
            if (wr == 0 && fr < 2) {
#pragma unroll
                for (int bj = 0; bj < 2; ++bj) { const f32x4 v0 = acc[0][bj][0][0], v1 = acc[0][bj][0][1];
                    u32x4 w; w.x = pk2(v0[0], v0[1]); w.y = pk2(v0[2], v0[3]); w.z = pk2(v1[0], v1[1]); w.w = pk2(v1[2], v1[3]);
                    *(u32x4*)(RAWQ + ((size_t)u.pm * 4 + fr) * 2048 + bj * HALF + chb) = w; } }
            if (wr == 1 && fr >= 14) {
#pragma unroll
                for (int bj = 0; bj < 2; ++bj) { const f32x4 v0 = acc[1][bj][3][0], v1 = acc[1][bj][3][1];
                    u32x4 w; w.x = pk2(v0[0], v0[1]); w.y = pk2(v0[2], v0[3]); w.z = pk2(v1[0], v1[1]); w.w = pk2(v1[2], v1[3]);
                    *(u32x4*)(RAWQ + ((size_t)u.pm * 4 + 2 + (fr - 14)) * 2048 + bj * HALF + chb) = w; } }
            asm volatile("s_waitcnt lgkmcnt(0)" ::: "memory"); __builtin_amdgcn_s_barrier(); asm volatile("" ::: "memory");
#pragma unroll
            for (int bj = 0; bj < 2; ++bj)
#pragma unroll
                for (int n = 0; n < 2; ++n) {
                    const int c4 = chb + bj * HALF + 4 * n;
                    const f32x4 w0 = *(const f32x4*)(cw + c4), w1 = *(const f32x4*)(cw + 2048 + c4), w2 = *(const f32x4*)(cw + 4096 + c4), bb = *(const f32x4*)(cb + c4);
#pragma unroll
                    for (int ai = 0; ai < 2; ++ai) { const int blk = 2 * ai + wr;
                        const f32x4 pe = (blk == 0) ? (f32x4){0.f, 0.f, 0.f, 0.f} : *(const PG8_LAS f32x4*)(EX + (((wc * 8 + 2 * blk - 1) * 4 + fq) * 16 + bj * 8 + n * 4));
                        const f32x4 ne = (blk == 3) ? (f32x4){0.f, 0.f, 0.f, 0.f} : *(const PG8_LAS f32x4*)(EX + (((wc * 8 + 2 * blk + 2) * 4 + fq) * 16 + bj * 8 + n * 4));
#pragma unroll
                        for (int m = 0; m < 4; ++m) { float o[4];
#pragma unroll
                            for (int e = 0; e < 4; ++e) { const float cur = acc[ai][bj][m][n][e];
                                const float oldp = (m == 0) ? pe[e] : PG8_DPP(0.f, acc[ai][bj][m == 0 ? 0 : m - 1][n][e], 0x121);
                                const float prev = PG8_DPP(oldp, cur, 0x111);
                                const float oldn = (m == 3) ? ne[e] : PG8_DPP(0.f, acc[ai][bj][m == 3 ? 3 : m + 1][n][e], 0x12f);
                                const float next = PG8_DPP(oldn, cur, 0x101);
                                const float cv = bb[e] + w0[e] * prev + w1[e] * cur + w2[e] * next;
                                o[e] = (cv * __builtin_amdgcn_rcpf(1.0f + __expf(-cv))) * scl; }
                            typedef unsigned u32x2_t __attribute__((ext_vector_type(2)));
                            u32x2_t w; w.x = pk2(o[0], o[1]); w.y = pk2(o[2], o[3]);
                            *(u32x2_t*)(MQK + (size_t)(row0 + ai * HALF + m * 16) * 2048 + c4) = w; } } }
            return;
        }
        if (u.pn == 32) {
            if (wc == 0) { const f32x4 g0 = *(const f32x4*)(gate_b + 8 * fq), g1 = *(const f32x4*)(gate_b + 8 * fq + 4);
#pragma unroll
                for (int ai = 0; ai < 2; ++ai)
#pragma unroll
                    for (int m = 0; m < 4; ++m) { float* gp = gates + (size_t)(row0 + ai * HALF + m * 16) * 32 + 8 * fq;
                        *(f32x4*)gp = acc[ai][0][m][0] + g0; *(f32x4*)(gp + 4) = acc[ai][0][m][1] + g1; } }
            return;
        }
        const int col0 = u.pn * BM + wc * 32 + 8 * fq;
        const bool roped = (u.pn < 8) && ((u.pm % 17) != 0);
        const float sc = (u.pn < 4) ? 0.08838834764831845f : 1.0f;
        const int tbase = (u.pm % 17) * 256 - 256 + wr * 64 + fr;
        const int p0 = (wc & 1) * 16 + 4 * fq, blk = wc >> 1;
#pragma unroll
        for (int ai = 0; ai < 2; ++ai) {
#pragma unroll
          for (int mh = 0; mh < 2; ++mh) {
            f32x4 c4v[4], s4v[4];
#pragma unroll
            for (int m = 2 * mh; m < 2 * mh + 2; ++m) { c4v[m] = (f32x4){1.f, 1.f, 1.f, 1.f}; s4v[m] = (f32x4){0.f, 0.f, 0.f, 0.f};
                if (roped) { const int t = tbase + ai * HALF + m * 16; const int pos = blk ? (t & 63) : (t >> 6);
                    c4v[m] = *(const f32x4*)(ropeC + pos * 32 + p0); s4v[m] = *(const f32x4*)(ropeS + pos * 32 + p0); } }
#pragma unroll
            for (int m = 2 * mh; m < 2 * mh + 2; ++m) { bf16_t* rowp = O + (size_t)(row0 + ai * HALF + m * 16) * 8192 + col0;
                const f32x4 c4 = c4v[m], s4 = s4v[m];
#pragma unroll
                for (int bj = 0; bj < 2; ++bj) { f32x4 v0 = acc[ai][bj][m][0] * sc, v1 = acc[ai][bj][m][1] * sc;
                    const f32x4 r0 = (f32x4){v0[0] * c4[0] - v0[1] * s4[0], v0[0] * s4[0] + v0[1] * c4[0], v0[2] * c4[1] - v0[3] * s4[1], v0[2] * s4[1] + v0[3] * c4[1]};
                    const f32x4 r1 = (f32x4){v1[0] * c4[2] - v1[1] * s4[2], v1[0] * s4[2] + v1[1] * c4[2], v1[2] * c4[3] - v1[3] * s4[3], v1[2] * s4[3] + v1[3] * c4[3]};
                    u32x4 w; w.x = pk2(r0[0], r0[1]); w.y = pk2(r0[2], r0[3]); w.z = pk2(r1[0], r1[1]); w.w = pk2(r1[2], r1[3]);
                    *(u32x4*)(rowp + bj * HALF) = w; } }
          }
        }
    }
};
template <bool ACCUM> struct EpiGate {
    static constexpr bool PERM = true, AFTER_DRAIN = false, PERMA = false;
    bf16_t* Y; int ldc; const bf16_t* Gt; int ldg; unsigned* cnt_lat; unsigned* cnt_ctx;
    __device__ __forceinline__ void operator()(const f32x4 (&acc)[2][2][4][2], const Unit& u, int wr, int wc, int fr, int fq) const {
        const int row0 = u.pm * BM + wr * 64 + fr, col0 = u.pn * BM + wc * 32 + 8 * fq;
        u32x4 gall[2][4][2];
        if (!ACCUM) {
#pragma unroll
            for (int ai = 0; ai < 2; ++ai)
#pragma unroll
                for (int m = 0; m < 4; ++m)
#pragma unroll
                    for (int bj = 0; bj < 2; ++bj) gall[ai][m][bj] = *(const u32x4*)(Gt + (size_t)(row0 + ai * HALF + m * 16) * ldg + col0 + bj * HALF); }
#pragma unroll
        for (int ai = 0; ai < 2; ++ai) {
            u32x4 gwv[4][2], ywv[4][2];
#pragma unroll
            for (int m = 0; m < 4; ++m)
#pragma unroll
                for (int bj = 0; bj < 2; ++bj) { const size_t row = (size_t)(row0 + ai * HALF + m * 16);
                    if (ACCUM) { gwv[m][bj] = *(const u32x4*)(Gt + row * ldg + col0 + bj * HALF); ywv[m][bj] = *(const u32x4*)(Y + row * ldc + col0 + bj * HALF); }
                    else gwv[m][bj] = gall[ai][m][bj]; }
#pragma unroll
            for (int m = 0; m < 4; ++m) { const size_t row = (size_t)(row0 + ai * HALF + m * 16);
#pragma unroll
                for (int bj = 0; bj < 2; ++bj) { const f32x4 v0 = acc[ai][bj][m][0], v1 = acc[ai][bj][m][1];
                    const u32x4 gw = gwv[m][bj];
                    float o[8] = {v0[0], v0[1], v0[2], v0[3], v1[0], v1[1], v1[2], v1[3]};
                    const float g[8] = {bflo(gw.x), bfhi(gw.x), bflo(gw.y), bfhi(gw.y), bflo(gw.z), bfhi(gw.z), bflo(gw.w), bfhi(gw.w)};
#pragma unroll
                    for (int e = 0; e < 8; ++e) o[e] = o[e] * g[e];
                    bf16_t* yp = Y + row * ldc + col0 + bj * HALF;
                    if (ACCUM) { const u32x4 yw = ywv[m][bj];
                        o[0] += bflo(yw.x); o[1] += bfhi(yw.x); o[2] += bflo(yw.y); o[3] += bfhi(yw.y); o[4] += bflo(yw.z); o[5] += bfhi(yw.z); o[6] += bflo(yw.w); o[7] += bfhi(yw.w); }
                    u32x4 w; w.x = pk2(o[0], o[1]); w.y = pk2(o[2], o[3]); w.z = pk2(o[4], o[5]); w.w = pk2(o[6], o[7]);
                    *(u32x4*)yp = w; } }
        }
        if (ACCUM && u.flag) { asm volatile("s_waitcnt vmcnt(0)" ::: "memory"); __builtin_amdgcn_s_barrier();
            if (wr == 0 && wc == 0 && fr == 0 && fq == 0) { __builtin_amdgcn_fence(__ATOMIC_RELEASE, "agent"); asm volatile("s_waitcnt vmcnt(0)" ::: "memory");
                (void)__hip_atomic_fetch_add(u.flag == 1 ? cnt_lat : cnt_ctx, 1u, __ATOMIC_RELAXED, __HIP_MEMORY_SCOPE_AGENT); } }
    }
};

struct EpiMerge {
    static constexpr bool PERM = true, AFTER_DRAIN = false, PERMA = false;
    bf16_t* Y4; size_t slot; const float* hnw; bf16_t* G; int ldg; const float* SS; int mrows; float eps;
    __device__ __forceinline__ void operator()(const f32x4 (&acc)[2][2][4][2], const Unit& u, int wr, int wc, int fr, int fq) const {
        const int row0 = u.pm * BM + wr * 64 + fr;
        if (u.pn >= 16) {
            const int col0 = u.pn * BM + wc * 32 + 8 * fq;
#pragma unroll
            for (int ai = 0; ai < 2; ++ai)
#pragma unroll
                for (int m = 0; m < 4; ++m) { bf16_t* rowp = G + (size_t)(row0 + ai * HALF + m * 16) * ldg + col0;
#pragma unroll
                    for (int bj = 0; bj < 2; ++bj) { const f32x4 v0 = acc[ai][bj][m][0], v1 = acc[ai][bj][m][1];
                        u32x4 w; w.x = pk2v(sigmoid2(__builtin_shufflevector(v0, v0, 0, 1))); w.y = pk2v(sigmoid2(__builtin_shufflevector(v0, v0, 2, 3)));
                        w.z = pk2v(sigmoid2(__builtin_shufflevector(v1, v1, 0, 1))); w.w = pk2v(sigmoid2(__builtin_shufflevector(v1, v1, 2, 3)));
                        *(u32x4*)(rowp + bj * HALF) = w; } }
            return;
        }
        const int br = u.pn >> 3, hh = u.pn & 7, col0 = hh * BM + wc * 32 + 8 * fq;
        bf16_t* Yn = Y4 + (size_t)(2 * br) * slot;
        f32x4 hw[2][2];
#pragma unroll
        for (int bj = 0; bj < 2; ++bj) { hw[bj][0] = *(const f32x4*)(hnw + br * 2048 + col0 + bj * HALF); hw[bj][1] = *(const f32x4*)(hnw + br * 2048 + col0 + bj * HALF + 4); }
        auto half_tile = [&](auto BR) {
#pragma unroll
        for (int am = 0; am < 4; ++am) { const int ai = am >> 1;
            u32x4 yv[2][2]; float ssv[2];
#pragma unroll
            for (int mm = 0; mm < 2; ++mm) { const int m = 2 * (am & 1) + mm; ssv[mm] = SS[(size_t)(br * 8 + hh) * mrows + row0 + ai * HALF + m * 16];
#pragma unroll
                for (int bj = 0; bj < 2; ++bj) yv[mm][bj] = *(const u32x4*)(Yn + (size_t)(row0 + ai * HALF + m * 16) * 2048 + col0 + bj * HALF); }
#pragma unroll
            for (int mm = 0; mm < 2; ++mm) { const int m = 2 * (am & 1) + mm; const size_t ro = (size_t)(row0 + ai * HALF + m * 16) * 2048 + col0;
                const float rstd = __builtin_amdgcn_rsqf(ssv[mm] * (1.0f / 256.0f) + eps);
#pragma unroll
                for (int bj = 0; bj < 2; ++bj) { const u32x4 a = yv[mm][bj]; const unsigned aw[4] = {a.x, a.y, a.z, a.w};
                    const f32x4 g0 = acc[ai][bj][m][0], g1 = acc[ai][bj][m][1];
                    const f32x2_t gp[4] = {__builtin_shufflevector(g0, g0, 0, 1), __builtin_shufflevector(g0, g0, 2, 3), __builtin_shufflevector(g1, g1, 0, 1), __builtin_shufflevector(g1, g1, 2, 3)};
                    const f32x2_t wp[4] = {__builtin_shufflevector(hw[bj][0], hw[bj][0], 0, 1), __builtin_shufflevector(hw[bj][0], hw[bj][0], 2, 3), __builtin_shufflevector(hw[bj][1], hw[bj][1], 0, 1), __builtin_shufflevector(hw[bj][1], hw[bj][1], 2, 3)};
                    unsigned ow[4];
#pragma unroll
                    for (int q = 0; q < 4; ++q) { const f32x2_t y2 = (f32x2_t){bflo(aw[q]), bfhi(aw[q])}; f32x2_t s2 = sigmoid2(gp[q]);
                        if (!decltype(BR)::value) s2 = s2 * gp[q];
                        ow[q] = pk2v((y2 * rstd) * (wp[q] * s2)); }
                    u32x4 w; w.x = ow[0]; w.y = ow[1]; w.z = ow[2]; w.w = ow[3];
                    *(u32x4*)(Yn + ro + bj * HALF) = w; } }
            asm volatile("" ::: "memory");
        }
        };
        if (br) half_tile(std::integral_constant<bool, true>{}); else half_tile(std::integral_constant<bool, false>{});
    }
};

struct EpiConvAct {
    static constexpr bool PERM = true, AFTER_DRAIN = false, PERMA = true;
    bf16_t* ACT; bf16_t* RAW; const float* fw; const float* fb; PG8_LAS float* EX; int FFn, UPNn;
    __device__ __forceinline__ void operator()(const f32x4 (&acc)[2][2][4][2], const Unit& u, int wr, int wc, int fr, int fq) const {
        const int chb = 128 * u.pn + 32 * wc + 8 * fq;
#pragma unroll
        for (int ai = 0; ai < 2; ++ai) { const int blk = 2 * ai + wr;
            if (fr == 0) {
#pragma unroll
                for (int bj = 0; bj < 2; ++bj)
#pragma unroll
                    for (int n = 0; n < 2; ++n) *(PG8_LAS f32x4*)(EX + (((wc * 8 + 2 * blk) * 4 + fq) * 16 + bj * 8 + n * 4)) = acc[ai][bj][0][n]; }
            if (fr == 15) {
#pragma unroll
                for (int bj = 0; bj < 2; ++bj)
#pragma unroll
                    for (int n = 0; n < 2; ++n) *(PG8_LAS f32x4*)(EX + (((wc * 8 + 2 * blk + 1) * 4 + fq) * 16 + bj * 8 + n * 4)) = acc[ai][bj][3][n]; } }
        if (wr == 0 && fr == 0) {
#pragma unroll
            for (int k = 0; k < 2; ++k)
#pragma unroll
                for (int bj = 0; bj < 2; ++bj) { const f32x4 v0 = acc[0][bj][k][0], v1 = acc[0][bj][k][1];
                    u32x4 w; w.x = pk2(v0[0], v0[1]); w.y = pk2(v0[2], v0[3]); w.z = pk2(v1[0], v1[1]); w.w = pk2(v1[2], v1[3]);
                    *(u32x4*)(RAW + ((size_t)u.pm * 4 + k) * UPNn + bj * FFn + chb) = w; } }
        if (wr == 1 && fr == 15) {
#pragma unroll
            for (int k = 0; k < 2; ++k)
#pragma unroll
                for (int bj = 0; bj < 2; ++bj) { const f32x4 v0 = acc[1][bj][2 + k][0], v1 = acc[1][bj][2 + k][1];
                    u32x4 w; w.x = pk2(v0[0], v0[1]); w.y = pk2(v0[2], v0[3]); w.z = pk2(v1[0], v1[1]); w.w = pk2(v1[2], v1[3]);
                    *(u32x4*)(RAW + ((size_t)u.pm * 4 + 2 + k) * UPNn + bj * FFn + chb) = w; } }
        asm volatile("s_waitcnt lgkmcnt(0)" ::: "memory"); __builtin_amdgcn_s_barrier(); asm volatile("" ::: "memory");
        const int row0 = u.pm * BM + wr * 64 + 4 * fr;
#pragma unroll
        for (int n = 0; n < 2; ++n) {
            const int c4 = chb + 4 * n;
            f32x4 w0[2], w1[2], w2[2], bb[2];
#pragma unroll
            for (int bj = 0; bj < 2; ++bj) { w0[bj] = *(const f32x4*)(fw + bj * FFn + c4); w1[bj] = *(const f32x4*)(fw + UPNn + bj * FFn + c4); w2[bj] = *(const f32x4*)(fw + 2 * UPNn + bj * FFn + c4); bb[bj] = *(const f32x4*)(fb + bj * FFn + c4); }
#pragma unroll
            for (int ai = 0; ai < 2; ++ai) { const int blk = 2 * ai + wr;
                f32x4 pe[2], ne[2];
#pragma unroll
                for (int bj = 0; bj < 2; ++bj) {
                    pe[bj] = (blk == 0) ? (f32x4){0.f, 0.f, 0.f, 0.f} : *(const PG8_LAS f32x4*)(EX + (((wc * 8 + 2 * blk - 1) * 4 + fq) * 16 + bj * 8 + n * 4));
                    ne[bj] = (blk == 3) ? (f32x4){0.f, 0.f, 0.f, 0.f} : *(const PG8_LAS f32x4*)(EX + (((wc * 8 + 2 * blk + 2) * 4 + fq) * 16 + bj * 8 + n * 4)); }
#pragma unroll
                for (int m = 0; m < 4; ++m) {
                    f32x4 cv[2];
#pragma unroll
                    for (int bj = 0; bj < 2; ++bj)
#pragma unroll
                        for (int e = 0; e < 4; ++e) { const float cur = acc[ai][bj][m][n][e];
                            const float prev = (m == 0) ? PG8_DPP(pe[bj][e], acc[ai][bj][3][n][e], 0x111) : acc[ai][bj][m == 0 ? 0 : m - 1][n][e];
                            const float next = (m == 3) ? PG8_DPP(ne[bj][e], acc[ai][bj][0][n][e], 0x101) : acc[ai][bj][m == 3 ? 3 : m + 1][n][e];
                            cv[bj][e] = bb[bj][e] + w0[bj][e] * prev + w1[bj][e] * cur + w2[bj][e] * next; }
                    float o[4];
#pragma unroll
                    for (int e = 0; e < 4; ++e) o[e] = (cv[0][e] * __builtin_amdgcn_rcpf(1.0f + __expf(-cv[0][e]))) * cv[1][e];
                    typedef unsigned u32x2_t __attribute__((ext_vector_type(2)));
                    u32x2_t w; w.x = pk2(o[0], o[1]); w.y = pk2(o[2], o[3]);
                    *(u32x2_t*)(ACT + (size_t)(row0 + ai * HALF + m) * FFn + c4) = w;
                }
            }
        }
    }
};
template <class Epi, class Sched, bool ALIGN_EPI = false, bool SP2 = false>
__device__ __forceinline__ void gemm_phase(PG8_LAS unsigned char* lds, const Gemm g, const Sched& S, const Epi& E, const int tid_) {
    const int tid = tid_, wid = __builtin_amdgcn_readfirstlane(tid >> 6), lane = tid & 63, wr = wid >> 2, wc = wid & 3, fr = lane & 15, fq = lane >> 4;
    const int K = g.K, nt = K / BK;
    unsigned voffA[2], voffB[2];
#pragma unroll
    for (int i = 0; i < 2; ++i) { int R, C; stage_rc(tid * 16 + i * 8192, R, C); const int Rb = Epi::PERM ? ((R & ~31) + perm32(R & 31)) : R;
        const int Ra = Epi::PERMA ? ((R & 64) + 4 * (R & 15) + ((R >> 4) & 3)) : R;
        voffA[i] = (unsigned)(Ra * K + C) * 2u; voffB[i] = (unsigned)(Rb * K + C) * 2u; }
    const size_t kstep = (size_t)(BK * 2);
    const size_t hstep = (size_t)HALF * K * 2;
    const size_t tstep = 2 * hstep;
    const unsigned ldsw = (unsigned)wid * 1024u;
    const int aoff = lds_byte(wr * 64 + fr, fq * 8), boff = lds_byte(wc * 32 + fr, fq * 8);
#define PG8_SA(b, h) (((b) * 2 + (h)) * HTB)
#define PG8_SB(b, h) ((4 + (b) * 2 + (h)) * HTB)
#define PG8_STAGE(bufoff, gbase, voff) do { _Pragma("unroll") for (int _i = 0; _i < 2; ++_i) \
        __builtin_amdgcn_global_load_lds((const unsigned*)((const char*)(gbase) + (voff)[_i]), (PG8_LAS unsigned*)(lds + (bufoff) + ldsw + _i * 8192), 16, 0, 0); } while (0)
#define PG8_LDA(dst, b, h) do { _Pragma("unroll") for (int m = 0; m < 4; ++m) _Pragma("unroll") for (int k = 0; k < 2; ++k) dst[m][k] = *(const PG8_LAS bf16x8*)(lds + PG8_SA(b, h) + aoff + m * 2048 + k * 1024); } while (0)
#define PG8_LDB(dst, b, h) do { _Pragma("unroll") for (int n = 0; n < 2; ++n) _Pragma("unroll") for (int k = 0; k < 2; ++k) dst[n][k] = *(const PG8_LAS bf16x8*)(lds + PG8_SB(b, h) + boff + n * 2048 + k * 1024); } while (0)
#define PG8_MMA(ai, bj, At, Bt) do { __builtin_amdgcn_s_setprio(1); _Pragma("unroll") for (int m = 0; m < 4; ++m) _Pragma("unroll") for (int n = 0; n < 2; ++n) _Pragma("unroll") for (int k = 0; k < 2; ++k) \
        acc[ai][bj][m][n] = __builtin_amdgcn_mfma_f32_16x16x32_bf16(Bt[n][k], At[m][k], acc[ai][bj][m][n], 0, 0, 0); __builtin_amdgcn_s_setprio(0); } while (0)
#define PG8_WAIT_V(n) asm volatile("s_waitcnt vmcnt(" #n ")" ::: "memory")
#define PG8_WAIT_L(n) asm volatile("s_waitcnt lgkmcnt(" #n ")" ::: "memory")
#define PG8_BAR __builtin_amdgcn_s_barrier()
#define PG8_SCHED __builtin_amdgcn_sched_barrier(0)
    Unit cur, nxt; int ui = 0;
    if (!S.next(0, cur)) return;
    f32x4 acc[2][2][4][2];
#pragma unroll
    for (int a = 0; a < 2; ++a)
#pragma unroll
        for (int b = 0; b < 2; ++b)
#pragma unroll
            for (int m = 0; m < 4; ++m)
#pragma unroll
                for (int n = 0; n < 2; ++n) acc[a][b][m][n] = (f32x4){0.f, 0.f, 0.f, 0.f};
    bf16x8 At[4][2], B0[2][2], B1[2][2];
    const char* cA = (const char*)g.A + (size_t)cur.pm * tstep; const char* cB = (const char*)g.Bt + (size_t)cur.pn * tstep;
    S.a_ready(cur);
    if constexpr (SP2) {
        PG8_STAGE(PG8_SB(0, 0), cB, voffB); PG8_STAGE(PG8_SB(0, 1), cB + hstep, voffB); PG8_STAGE(PG8_SA(0, 0), cA, voffA); PG8_STAGE(PG8_SA(0, 1), cA + hstep, voffA);
        if (wr == 1) PG8_BAR;
        PG8_WAIT_V(2); PG8_BAR;
        PG8_STAGE(PG8_SB(1, 0), cB + kstep, voffB); PG8_STAGE(PG8_SA(1, 0), cA + kstep, voffA); PG8_STAGE(PG8_SB(1, 1), cB + hstep + kstep, voffB);
        PG8_WAIT_V(6); PG8_BAR;
    } else {
    PG8_STAGE(PG8_SB(0, 0), cB, voffB); PG8_STAGE(PG8_SA(0, 0), cA, voffA); PG8_STAGE(PG8_SB(0, 1), cB + hstep, voffB); PG8_STAGE(PG8_SA(0, 1), cA + hstep, voffA);
    if (wr == 1) PG8_BAR;
    PG8_WAIT_V(4); PG8_BAR;
    PG8_STAGE(PG8_SB(1, 0), cB + kstep, voffB); PG8_STAGE(PG8_SA(1, 0), cA + kstep, voffA); PG8_STAGE(PG8_SB(1, 1), cB + hstep + kstep, voffB);
    PG8_WAIT_V(6); PG8_BAR;
    }
    for (;;) {
        const bool has_next = S.next(ui + 1, nxt);
        const char* nA = has_next ? (const char*)g.A + (size_t)nxt.pm * tstep : cA; const char* nB = has_next ? (const char*)g.Bt + (size_t)nxt.pn * tstep : cB;
        for (int t = 0; t < nt; t += 2) {
            const bool last = (t == nt - 2);
            const char* a1 = cA + (size_t)(t + 1) * kstep;
            const char* a2 = last ? nA : cA + (size_t)(t + 2) * kstep; const char* b2 = last ? nB : cB + (size_t)(t + 2) * kstep;
            const char* a3 = a2 + kstep; const char* b3 = b2 + kstep;
            if (last && has_next) S.a_ready(nxt);
            if constexpr (SP2) {
            PG8_LDB(B0, 0, 0); PG8_LDB(B1, 0, 1); PG8_SCHED; PG8_LDA(At, 0, 0); PG8_STAGE(PG8_SA(1, 1), a1 + hstep, voffA);
            PG8_WAIT_V(8); PG8_WAIT_L(0); PG8_BAR; PG8_MMA(0, 0, At, B0); PG8_MMA(0, 1, At, B1); PG8_BAR; PG8_SCHED;
            PG8_LDA(At, 0, 1); PG8_STAGE(PG8_SB(0, 0), b2, voffB); PG8_STAGE(PG8_SB(0, 1), b2 + hstep, voffB); PG8_STAGE(PG8_SA(0, 0), a2, voffA);
            PG8_WAIT_V(8); PG8_WAIT_L(0); PG8_BAR; PG8_MMA(1, 0, At, B0); PG8_MMA(1, 1, At, B1); PG8_BAR; PG8_SCHED;
            PG8_LDB(B0, 1, 0); PG8_LDB(B1, 1, 1); PG8_SCHED; PG8_LDA(At, 1, 0); PG8_STAGE(PG8_SA(0, 1), a2 + hstep, voffA);
            PG8_WAIT_V(8); PG8_WAIT_L(0); PG8_BAR; PG8_MMA(0, 0, At, B0); PG8_MMA(0, 1, At, B1); PG8_BAR; PG8_SCHED;
            PG8_LDA(At, 1, 1); PG8_STAGE(PG8_SB(1, 0), b3, voffB); PG8_STAGE(PG8_SB(1, 1), b3 + hstep, voffB); PG8_STAGE(PG8_SA(1, 0), a3, voffA);
            PG8_WAIT_V(8); PG8_WAIT_L(0); PG8_BAR; PG8_MMA(1, 0, At, B0); PG8_MMA(1, 1, At, B1); PG8_BAR; PG8_SCHED;
            } else {
            PG8_LDB(B0, 0, 0); PG8_SCHED; PG8_LDA(At, 0, 0); PG8_STAGE(PG8_SA(1, 1), a1 + hstep, voffA);
            PG8_WAIT_L(8); PG8_BAR; PG8_WAIT_L(0); PG8_MMA(0, 0, At, B0); PG8_BAR; PG8_SCHED;
            PG8_LDB(B1, 0, 1); PG8_STAGE(PG8_SB(0, 0), b2, voffB);
            PG8_BAR; PG8_WAIT_L(0); PG8_MMA(0, 1, At, B1); PG8_BAR;
            PG8_LDA(At, 0, 1); PG8_STAGE(PG8_SA(0, 0), a2, voffA);
            PG8_BAR; PG8_WAIT_L(0); PG8_MMA(1, 0, At, B0); PG8_BAR; PG8_SCHED;
            PG8_STAGE(PG8_SB(0, 1), b2 + hstep, voffB);
            PG8_WAIT_V(6); PG8_BAR; PG8_MMA(1, 1, At, B1); PG8_BAR;
            PG8_LDB(B0, 1, 0); PG8_SCHED; PG8_LDA(At, 1, 0); PG8_STAGE(PG8_SA(0, 1), a2 + hstep, voffA);
            PG8_WAIT_L(8); PG8_BAR; PG8_WAIT_L(0); PG8_MMA(0, 0, At, B0); PG8_BAR; PG8_SCHED;
            PG8_LDB(B1, 1, 1); PG8_STAGE(PG8_SB(1, 0), b3, voffB);
            PG8_BAR; PG8_WAIT_L(0); PG8_MMA(0, 1, At, B1); PG8_BAR;
            PG8_LDA(At, 1, 1); PG8_STAGE(PG8_SA(1, 0), a3, voffA);
            PG8_BAR; PG8_WAIT_L(0); PG8_MMA(1, 0, At, B0); PG8_BAR; PG8_SCHED;
            PG8_STAGE(PG8_SB(1, 1), b3 + hstep, voffB);
            PG8_WAIT_V(6); PG8_BAR; PG8_MMA(1, 1, At, B1); PG8_BAR;
            }
        }
        if constexpr (ALIGN_EPI) { if (wr == 0) PG8_BAR; }
        if constexpr (!Epi::AFTER_DRAIN) { E(acc, cur, wr, wc, fr, fq); S.done(cur); }
        if (!has_next) break;
#pragma unroll
        for (int a = 0; a < 2; ++a)
#pragma unroll
            for (int b = 0; b < 2; ++b)
#pragma unroll
                for (int m = 0; m < 4; ++m)
#pragma unroll
                    for (int n = 0; n < 2; ++n) acc[a][b][m][n] = (f32x4){0.f, 0.f, 0.f, 0.f};
        cur = nxt; cA = nA; cB = nB; ++ui;
        if constexpr (ALIGN_EPI) { if (wr == 1) PG8_BAR; }
    }
    PG8_WAIT_V(0);
    if constexpr (!ALIGN_EPI) { if (wr == 0) PG8_BAR; }
    PG8_BAR;
    if constexpr (Epi::AFTER_DRAIN) { E.fused(acc, cur, wr, wc, fr, fq, lds, wid, lane); S.done(cur); }
#undef PG8_SA
#undef PG8_SB
#undef PG8_STAGE
#undef PG8_LDA
#undef PG8_LDB
#undef PG8_MMA
#undef PG8_WAIT_V
#undef PG8_WAIT_L
#undef PG8_BAR
#undef PG8_SCHED
}
}

constexpr int DM = 2048, NB = 8, SEQ = 4096, CTXL = 256, TT = CTXL + SEQ, MROWS = NB * TT, NLAYER = 4;
constexpr int NH = 8, DK = 128, DV = 256, FF = 5632, UPN = 2 * FF, INC = 16416, MODW = 6 * DM;
constexpr int N1 = 8448, N2 = 8192, LDP = 8192;
constexpr int NCH = TT / 128;
constexpr float EPSN = 1e-6f, LOG2E = 1.4426950408889634f, QSCALE = 0.08838834764831845f;
constexpr int NWAVES = 8, NTHR = 512;

constexpr size_t WS_CTL = 0, CTL_ZERO_BYTES = 65536;
constexpr size_t WS_MOD = 1u << 20;
constexpr size_t WS_ROPE = WS_MOD + (size_t)NLAYER * 9 * MODW * 4;
constexpr size_t WS_GATES = WS_ROPE + 64 * 32 * 2 * 4;
constexpr size_t WS_GA = WS_GATES + (size_t)MROWS * 32 * 4;
constexpr size_t WS_GMX = WS_GA + (size_t)2 * MROWS * 8 * 4;
constexpr size_t WS_GCUM = WS_GMX + (size_t)2 * MROWS * 8 * 4;
constexpr size_t WS_XC = WS_GCUM + (size_t)2 * MROWS * 8 * 4;
constexpr size_t WS_W1T = WS_XC + (size_t)NB * CTXL * DM * 4;
constexpr size_t WS_W2T = WS_W1T + (size_t)N1 * DM * 2;
constexpr size_t WS_WRO = WS_W2T + (size_t)N2 * DM * 2;
constexpr size_t WS_WMO = WS_WRO + (size_t)DM * DM * 2;
constexpr size_t WS_WO = WS_WMO + (size_t)DM * DM * 2;
constexpr size_t WS_WUT = WS_WO + (size_t)DM * DM * 2;
constexpr size_t WS_WDT = WS_WUT + (size_t)UPN * DM * 2;
constexpr size_t WS_H = WS_WDT + (size_t)DM * FF * 2;
constexpr size_t SLOT = (size_t)MROWS * DM * 2;
constexpr size_t WS_ARENA = WS_H + SLOT;
constexpr size_t WS_PROJ = WS_ARENA;
constexpr size_t WS_MQK = WS_PROJ + (size_t)MROWS * LDP * 2;
constexpr size_t WS_Y4 = WS_MQK + SLOT;
constexpr size_t WS_U = WS_ARENA;
constexpr size_t WS_ACT = WS_U + (size_t)MROWS * UPN * 2;
constexpr size_t WS_OUTF = WS_ARENA;
constexpr size_t WS_RAW = WS_Y4 + 4 * SLOT;
constexpr size_t WS_RAWQ = WS_RAW + (size_t)(MROWS / 256) * 4 * UPN * 2;
constexpr size_t WS_IMG = WS_RAWQ + (size_t)(MROWS / 256) * 4 * 2048 * 2;
constexpr size_t WS_SS = WS_IMG + (size_t)256 * 18 * 8 * 8192;
constexpr size_t WS_END = WS_SS + (size_t)16 * MROWS * 4;
static_assert(WS_ACT + (size_t)MROWS * FF * 2 <= WS_RAW, "ACT inside the arena");
static_assert(WS_W1T % 256 == 0 && WS_H % 256 == 0 && WS_ARENA % 256 == 0 && WS_ACT % 256 == 0, "alignment");

constexpr int NP2_OFF = 156160;
constexpr int PSUM2_OFF = 160256;
constexpr int LDS_BYTES = 162304, AUX_OFF = 131072, MISC_OFF = 139264, PBUF_OFF = 139776;

#define LAS __attribute__((address_space(3)))
typedef unsigned short bf16;
typedef short bf16x8 __attribute__((ext_vector_type(8)));
typedef short s16x4 __attribute__((ext_vector_type(4)));
typedef float f32x4 __attribute__((ext_vector_type(4)));
typedef float f32x16 __attribute__((ext_vector_type(16)));
typedef unsigned u32x4 __attribute__((ext_vector_type(4)));
typedef unsigned u32x2 __attribute__((ext_vector_type(2)));
using pg8::pk2; using pg8::bflo; using pg8::bfhi;
#define LDS_WAIT() asm volatile("s_waitcnt lgkmcnt(0)" ::: "memory")
#define VM_WAIT() asm volatile("s_waitcnt vmcnt(0)" ::: "memory")

#define XB_TMO      128
#define XB_XCNT(j)  (256  + 64 * (j))
#define XB_XSUB(j)  (1280 + 64 * (j))
#define XB_XGEN(j)  (2304 + 64 * (j))
#define XB_TOP      3328
#define XB_TOPGEN   3392
#define XCD_BAR_WORDS 3456
#define XB_SPIN_CAP (1u << 18)

__device__ __forceinline__ unsigned xb_ld(unsigned* p)              { return __hip_atomic_load(p, __ATOMIC_RELAXED, __HIP_MEMORY_SCOPE_AGENT); }
__device__ __forceinline__ unsigned xb_add(unsigned* p, unsigned v) { return __hip_atomic_fetch_add(p, v, __ATOMIC_RELAXED, __HIP_MEMORY_SCOPE_AGENT); }
__device__ __forceinline__ unsigned xb_xcc_id() { return (unsigned)__builtin_amdgcn_s_getreg((3 << 11) | 20) & 0xFu; }
#define XB_SPIN(cond, bar) do { unsigned _sp = 0; while (cond) { __builtin_amdgcn_s_sleep(1); \
    if ((++_sp & 255u) == 0u) { if (xb_ld(&(bar)[XB_TMO])) break; if (_sp > XB_SPIN_CAP) { atomicAdd(&(bar)[XB_TMO], 1u); break; } } } } while (0)

struct XcdBarrier {
    unsigned* bar; unsigned x;
    volatile LAS unsigned* st;
};

__device__ __forceinline__ XcdBarrier xcd_barrier_post(unsigned* bar, volatile LAS unsigned* st) {
    XcdBarrier b; b.bar = bar; b.x = xb_xcc_id(); b.st = st;
    if (threadIdx.x == 0) (void)xb_add(&bar[XB_XCNT(b.x)], 1u);
    return b;
}
__device__ __forceinline__ void xcd_barrier_complete(unsigned* bar, unsigned x, unsigned& nloc, unsigned& nx) {
    const unsigned G = gridDim.x * gridDim.y * gridDim.z;
    unsigned sum, cnt, mine, sp = 0u;
    for (;;) {
        sum = 0u; cnt = 0u; mine = 0u;
#pragma unroll
        for (unsigned j = 0; j < 16; ++j) { const unsigned c = xb_ld(&bar[XB_XCNT(j)]); sum += c; cnt += (c > 0u) ? 1u : 0u; mine = (j == x) ? c : mine; }
        if (sum == G) break;
        __builtin_amdgcn_s_sleep(1);
        if ((++sp & 255u) == 0u) { if (xb_ld(&bar[XB_TMO])) break; if (sp > XB_SPIN_CAP) { atomicAdd(&bar[XB_TMO], 1u); break; } }
    }
    nloc = mine > 0u ? mine : 1u; nx = cnt > 0u ? cnt : 1u;
}

__device__ __forceinline__ void xcd_barrier(const XcdBarrier& b) {
    asm volatile("s_waitcnt vmcnt(0)" ::: "memory");
    __syncthreads();
    if (threadIdx.x == 0) {
        unsigned* bar = b.bar;
        __builtin_amdgcn_s_waitcnt(0);
        unsigned nloc = b.st[0], nx = b.st[1];
        if (nloc == 0u) { xcd_barrier_complete(bar, b.x, nloc, nx); b.st[0] = nloc; b.st[1] = nx; }
        const unsigned old = xb_add(&bar[XB_XSUB(b.x)], 1u);
        const unsigned gen = old / nloc;
        if (old + 1u == (gen + 1u) * nloc) {
            __builtin_amdgcn_fence(__ATOMIC_RELEASE, "agent");
            asm volatile("s_waitcnt vmcnt(0)" ::: "memory");
            const unsigned og = xb_add(&bar[XB_TOP], 1u);
            const unsigned tg = og / nx;
            if (og + 1u == (tg + 1u) * nx) xb_add(&bar[XB_TOPGEN], 1u);
            else XB_SPIN(xb_ld(&bar[XB_TOPGEN]) == tg, bar);
            __builtin_amdgcn_fence(__ATOMIC_ACQUIRE, "agent");
            xb_add(&bar[XB_XGEN(b.x)], 1u);
            asm volatile("s_waitcnt vmcnt(0)" ::: "memory");
        } else {
            XB_SPIN(xb_ld(&bar[XB_XGEN(b.x)]) == gen, bar);
            __builtin_amdgcn_fence(__ATOMIC_ACQUIRE, "agent");
            asm volatile("s_waitcnt vmcnt(0)" ::: "memory");
        }
    }
    __syncthreads();
}

struct Ctx {
    LAS unsigned char* lds;
    int tid, lane, wave, vcu, G;
    float* out; unsigned char* ws;
    __device__ __forceinline__ const float* inp(int i) const { const float* const* ka = (const float* const*)__builtin_amdgcn_kernarg_segment_ptr(); return ka[i]; }
};
#define GAS __attribute__((address_space(1)))
template <class T> __device__ __forceinline__ const GAS T* gptr(const T* p) { return (const GAS T*)p; }
template <class T> __device__ __forceinline__ GAS T* gptr(T* p) { return (GAS T*)p; }
#define WV_DPP(old, x, ctrl) __builtin_bit_cast(float, __builtin_amdgcn_update_dpp(__builtin_bit_cast(int, (float)(old)), __builtin_bit_cast(int, (float)(x)), (ctrl), 0xf, 0xf, false))
__device__ __forceinline__ float swz_xor16(float v) { return __builtin_bit_cast(float, __builtin_amdgcn_ds_swizzle(__builtin_bit_cast(int, v), 0x401F)); }
__device__ __forceinline__ float bperm_f(float v, int src_lane) { return __builtin_bit_cast(float, __builtin_amdgcn_ds_bpermute(src_lane << 2, __builtin_bit_cast(int, v))); }
__device__ __forceinline__ float quad_sum(float v) { v += WV_DPP(0.f, v, 0xB1); v += WV_DPP(0.f, v, 0x4E); return v; }
__device__ __forceinline__ float wave_sum(float v) {
    v = quad_sum(v); v += WV_DPP(0.f, v, 0x141); v += WV_DPP(0.f, v, 0x140);
    v += swz_xor16(v);
    return __builtin_bit_cast(float, __builtin_amdgcn_readlane(__builtin_bit_cast(int, v), 0)) + __builtin_bit_cast(float, __builtin_amdgcn_readlane(__builtin_bit_cast(int, v), 32));
}
__device__ __forceinline__ float silu_f(float x) { return x * __builtin_amdgcn_rcpf(1.0f + __expf(-x)); }
__device__ __forceinline__ float sigmoid_f(float x) { return __builtin_amdgcn_rcpf(1.0f + __expf(-x)); }

__device__ __forceinline__ void mod_phase(const Ctx& C, int l0, int nl, int start, int stride) {
    LAS float* SC = (LAS float*)C.lds;
    LAS float* RED = (LAS float*)(C.lds + 73728);
    const float* cin = C.inp(1); const float* cctx = C.inp(3); const float* w_ada = C.inp(4); const float* b_ada = C.inp(5);
    float* MOD = (float*)(C.ws + WS_MOD);
    for (int e = C.tid; e < 9 * DM; e += NTHR) { const float v = e < 8 * DM ? cin[e] : cctx[e - 8 * DM]; SC[e] = silu_f(v); }
    __syncthreads();
    for (int it = start; it < nl * 192; it += stride) {
        const int l = l0 + it / 192, cg = it % 192, col = cg * 64 + C.lane;
        const float* wp = w_ada + ((size_t)l * DM + C.wave * 256) * MODW + col;
        float acc[9];
#pragma unroll
        for (int b = 0; b < 9; ++b) acc[b] = 0.f;
        for (int k0 = 0; k0 < 256; k0 += 16) {
            float wv[16];
#pragma unroll
            for (int j = 0; j < 16; ++j) wv[j] = __builtin_nontemporal_load(wp + (size_t)(k0 + j) * MODW);
#pragma unroll
            for (int j = 0; j < 16; ++j) { const int k = C.wave * 256 + k0 + j;
#pragma unroll
                for (int b = 0; b < 9; ++b) acc[b] += SC[b * DM + k] * wv[j]; }
        }
#pragma unroll
        for (int b = 0; b < 9; ++b) RED[(C.wave * 9 + b) * 64 + C.lane] = acc[b];
        __syncthreads();
        for (int e = C.tid; e < 576; e += NTHR) { const int b = e >> 6, ln = e & 63; float s = 0.f;
#pragma unroll
            for (int w = 0; w < 8; ++w) s += RED[(w * 9 + b) * 64 + ln];
            MOD[((size_t)l * 9 + b) * MODW + cg * 64 + ln] = s + b_ada[(size_t)l * MODW + cg * 64 + ln]; }
        __syncthreads();
    }
}
__device__ __forceinline__ void rope_table(const Ctx& C) {
    const int gt = C.vcu * NTHR + C.tid;
    if (gt < 2048) {
        const int pos = gt >> 5, p = gt & 31;
        double f = 1.0; const double f1 = 0.74989420933245582;
        for (int i = 0; i < p; ++i) f *= f1;
        const double x = (double)pos * f;
        const double kq = __builtin_rint(x * 0.63661977236758134308);
        const double rr = (x - kq * 1.57079632679489655800) - kq * 6.12323399573676603587e-17;
        const double r2 = rr * rr;
        double sn = rr * (1.0 + r2 * (-1.0 / 6 + r2 * (1.0 / 120 + r2 * (-1.0 / 5040 + r2 * (1.0 / 362880 + r2 * (-1.0 / 39916800 + r2 * (1.0 / 6227020800.0)))))));
        double cs = 1.0 + r2 * (-0.5 + r2 * (1.0 / 24 + r2 * (-1.0 / 720 + r2 * (1.0 / 40320 + r2 * (-1.0 / 3628800 + r2 * (1.0 / 479001600.0 + r2 * (-1.0 / 87178291200.0)))))));
        const int q = ((int)kq) & 3;
        const double s_out = (q == 0) ? sn : (q == 1) ? cs : (q == 2) ? -sn : -cs;
        const double c_out = (q == 0) ? cs : (q == 1) ? -sn : (q == 2) ? -cs : sn;
        float* T = (float*)(C.ws + WS_ROPE);
        T[gt] = (float)c_out; T[2048 + gt] = (float)s_out;
    }
}
__device__ __forceinline__ int w1_src(int n) {
    if (n < 2048) { const int base = n < 1024 ? 0 : 1024, nn = n & 1023, head = nn >> 7, j = nn & 127, blk = j >> 6, jj = j & 63; return base + head * 128 + blk * 64 + (jj & 1) * 32 + (jj >> 1); }
    if (n < 4096) return 2048 + (n - 2048);
    if (n < 5120) return 6144 + (n - 4096);
    if (n < 6144) return 7168 + (n - 5120);
    if (n < 8192) return 8192 + (n - 6144);
    if (n < 8224) return 12288 + (n - 8192);
    return -1;
}
__device__ __forceinline__ int w2_src(int n) {
    if (n < 2048) return 4096 + n;
    if (n < 4096) return 10240 + (n - 2048);
    return 12320 + (n - 4096);
}
__device__ __forceinline__ void tr_item(const float* W, int K, int N, bf16* WT, int mode, LAS float* scr, int item, int nblk, int lane) {
    const int kb = item / nblk, nb = item % nblk, k0 = 128 * kb, n0 = 32 * nb;
    const int nd = n0 + (lane & 31);
    const int sc = mode == 1 ? w1_src(nd) : (mode == 2 ? w2_src(nd) : (mode == 3 ? ((nd & 128) ? FF + 128 * (nd >> 8) + (nd & 127) : 128 * (nd >> 8) + (nd & 127)) : nd));
    float wv[64];
    { const float* wp = W + (size_t)(k0 + (lane >> 5)) * N + (sc >= 0 ? sc : 0);
#pragma unroll
      for (int i = 0; i < 64; ++i) wv[i] = __builtin_nontemporal_load(gptr(wp + (size_t)(2 * i) * N)); }
#pragma unroll
    for (int i = 0; i < 64; ++i) { const int kk = 2 * i + (lane >> 5); scr[kk * 33 + (lane & 31)] = sc >= 0 ? wv[i] : 0.f; }
    LDS_WAIT(); asm volatile("" ::: "memory");
    const int c = lane & 15;
#pragma unroll
    for (int j = 0; j < 8; ++j) { const int n = (lane >> 4) + 4 * j; const LAS float* s = scr + (8 * c) * 33 + n;
        u32x4 o; o.x = pk2(s[0 * 33], s[1 * 33]); o.y = pk2(s[2 * 33], s[3 * 33]); o.z = pk2(s[4 * 33], s[5 * 33]); o.w = pk2(s[6 * 33], s[7 * 33]);
        *(u32x4*)(WT + (size_t)(n0 + n) * K + k0 + 8 * c) = o; }
    LDS_WAIT(); asm volatile("" ::: "memory");
}
constexpr int CV_I0 = 16 * 264, CV_I1 = CV_I0 + 16 * 256, CV_I2 = CV_I1 + 1024, CV_I3 = CV_I2 + 1024, CV_I4 = CV_I3 + 1024, CV_I5 = CV_I4 + 16 * 352, CV_I6 = CV_I5 + 44 * 64;
__device__ __forceinline__ void convert_weights(const Ctx& C, int l, int lo, int hi, int iw, int nw) {
    LAS float* scr = (LAS float*)(C.lds + C.wave * 17408);
    if (iw < 0) return;
    const float* w_in = C.inp(7) + (size_t)l * DM * INC;
    const float* w_ro = C.inp(13) + (size_t)l * DM * DM; const float* w_mo = C.inp(14) + (size_t)l * DM * DM; const float* w_o = C.inp(15) + (size_t)l * DM * DM;
    const float* w_up = C.inp(16) + (size_t)l * DM * UPN; const float* w_dn = C.inp(19) + (size_t)l * FF * DM;
    constexpr int I0 = CV_I0, I1 = CV_I1, I2 = CV_I2, I3 = CV_I3, I4 = CV_I4, I5 = CV_I5;
    for (int it = lo + iw; it < hi; it += nw) {
        if (it < I0) tr_item(w_in, DM, INC, (bf16*)(C.ws + WS_W1T), 1, scr, it, 264, C.lane);
        else if (it < I1) tr_item(w_in, DM, INC, (bf16*)(C.ws + WS_W2T), 2, scr, it - I0, 256, C.lane);
        else if (it < I2) tr_item(w_ro, DM, DM, (bf16*)(C.ws + WS_WRO), 0, scr, it - I1, 64, C.lane);
        else if (it < I3) tr_item(w_mo, DM, DM, (bf16*)(C.ws + WS_WMO), 0, scr, it - I2, 64, C.lane);
        else if (it < I4) tr_item(w_o, DM, DM, (bf16*)(C.ws + WS_WO), 0, scr, it - I3, 64, C.lane);
        else if (it < I5) tr_item(w_up, DM, UPN, (bf16*)(C.ws + WS_WUT), 3, scr, it - I4, 352, C.lane);
        else tr_item(w_dn, FF, DM, (bf16*)(C.ws + WS_WDT), 0, scr, it - I5, 64, C.lane);
    }
}
__device__ __forceinline__ void wait_count(const Ctx& C, unsigned* p, unsigned tgt) {
    if (C.tid == 0) { unsigned sp = 0u; while (xb_ld(p) < tgt) { __builtin_amdgcn_s_sleep(2); if (++sp > (1u << 22)) break; }
        __builtin_amdgcn_fence(__ATOMIC_ACQUIRE, "agent"); asm volatile("s_waitcnt vmcnt(0)" ::: "memory"); }
    __syncthreads();
}
template <bool UPD, bool MKH>
__device__ __forceinline__ void rn_phase(const Ctx& C, int skip_ctx, const float* xin_lat, const float* xin_ctx, float* xout_lat, float* xout_ctx, const bf16* OUT,
                                         const float* modu, int g_idx, const float* nw_post, const float* modh, int sh_idx, int sc_idx, const float* nw_pre, bf16* Hout,
                                         unsigned* cnt_lat = nullptr, unsigned tgt_lat = 0, unsigned* cnt_ctx = nullptr, unsigned tgt_ctx = 0) {
    LAS float* TAB = (LAS float*)C.lds;
    const int b = C.vcu >> 5, cl = C.vcu & 31;
    __syncthreads();
#pragma unroll
    for (int k = 0; k < 2; ++k) { const int idx = C.tid + NTHR * k, set = idx >> 9, col = (idx & 511) * 4, mi = set ? NB : b;
        if (UPD) { const f32x4 g = *(const f32x4*)(modu + (size_t)mi * MODW + g_idx * DM + col), nw = *(const f32x4*)(nw_post + col); *(LAS f32x4*)(TAB + (set * 3 + 0) * DM + col) = g * nw; }
        if (MKH) { const f32x4 nw = *(const f32x4*)(nw_pre + col), sh = *(const f32x4*)(modh + (size_t)mi * MODW + sh_idx * DM + col), sc = *(const f32x4*)(modh + (size_t)mi * MODW + sc_idx * DM + col);
            *(LAS f32x4*)(TAB + (set * 3 + 1) * DM + col) = nw * (sc + 1.0f); *(LAS f32x4*)(TAB + (set * 3 + 2) * DM + col) = sh; } }
    __syncthreads();
    auto run = [&](const bool isctx, const int t0, const int ts, const int n) {
        auto row_of = [&](int i, size_t& xoff) { const int t = t0 + i * ts; xoff = isctx ? ((size_t)b * CTXL + t) * DM : ((size_t)b * SEQ + t) * DM; return b * TT + (isctx ? t : CTXL + t); };
        auto load_row = [&](int i, f32x4 (&xv)[8], u32x2 (&ow)[8]) { size_t xo_; const int r = row_of(i, xo_); const float* xi = (isctx ? xin_ctx : xin_lat) + xo_;
#pragma unroll
            for (int j = 0; j < 8; ++j) { xv[j] = __builtin_nontemporal_load(gptr((const f32x4*)(xi + 4 * C.lane + 256 * j))); if (UPD) ow[j] = __builtin_nontemporal_load(gptr((const u32x2*)(OUT + (size_t)r * DM + 4 * C.lane + 256 * j))); } };
        auto process = [&](int i, f32x4 (&xv)[8], u32x2 (&ow)[8]) {
            size_t xoff; const int r = row_of(i, xoff);
            LAS const float* tb = TAB + (isctx ? 3 * DM : 0) + 4 * C.lane;
            if (UPD) {
                f32x4 ov[8]; float ss = 0.f;
#pragma unroll
                for (int j = 0; j < 8; ++j) { const u32x2 w = ow[j];
                    ov[j] = (f32x4){bflo(w.x), bfhi(w.x), bflo(w.y), bfhi(w.y)}; ss += (ov[j][0] * ov[j][0] + ov[j][1] * ov[j][1]) + (ov[j][2] * ov[j][2] + ov[j][3] * ov[j][3]); }
                const float r1 = __builtin_amdgcn_rsqf(wave_sum(ss) * (1.0f / DM) + EPSN);
                float* xo = (isctx ? xout_ctx : xout_lat) + xoff;
#pragma unroll
                for (int j = 0; j < 8; ++j) { const int col = 4 * C.lane + 256 * j; const f32x4 gn = *(LAS const f32x4*)(tb + 256 * j);
                    xv[j] = xv[j] + gn * (ov[j] * r1); __builtin_nontemporal_store(xv[j], gptr((f32x4*)(xo + col))); }
            }
            if (MKH) {
                float ss = 0.f;
#pragma unroll
                for (int j = 0; j < 8; ++j) ss += (xv[j][0] * xv[j][0] + xv[j][1] * xv[j][1]) + (xv[j][2] * xv[j][2] + xv[j][3] * xv[j][3]);
                const float r2 = __builtin_amdgcn_rsqf(wave_sum(ss) * (1.0f / DM) + EPSN);
#pragma unroll
                for (int j = 0; j < 8; ++j) { const int col = 4 * C.lane + 256 * j; const f32x4 aw = *(LAS const f32x4*)(tb + DM + 256 * j), sh = *(LAS const f32x4*)(tb + 2 * DM + 256 * j);
                    const f32x4 hv = (xv[j] * r2) * aw + sh;
                    u32x2 w; w.x = pk2(hv[0], hv[1]); w.y = pk2(hv[2], hv[3]); *gptr((u32x2*)(Hout + (size_t)r * DM + col)) = w; }
            } };
        f32x4 xa[8], xb[8]; u32x2 oa[8], ob[8];
        load_row(0, xa, oa);
#pragma unroll 1
        for (int i = 0; i + 1 < n; i += 2) {
            load_row(i + 1, xb, ob); __builtin_amdgcn_sched_barrier(0); process(i, xa, oa); __builtin_amdgcn_sched_barrier(0);
            load_row(i + 2 < n ? i + 2 : n - 1, xa, oa); __builtin_amdgcn_sched_barrier(0); process(i + 1, xb, ob); __builtin_amdgcn_sched_barrier(0);
        }
        if (n & 1) process(n - 1, xa, oa);
    };
    if (cnt_lat == nullptr) {
        run(false, cl * 8 + C.wave, 256, 16);
        if (!skip_ctx) run(true, cl * 8 + C.wave, 0, 1);
    } else {
        unsigned* const wp = cl < 8 ? cnt_ctx : cnt_lat; const unsigned tgt = cl < 8 ? tgt_ctx : tgt_lat;
        if (C.tid == 0) { unsigned sp = 0u; while (xb_ld(wp) < tgt) { __builtin_amdgcn_s_sleep(2); if (++sp > (1u << 22)) break; }
            __builtin_amdgcn_fence(__ATOMIC_ACQUIRE, "agent"); asm volatile("s_waitcnt vmcnt(0)" ::: "memory"); }
        __syncthreads();
        if (cl < 8) run(true, cl * 8 + C.wave, 64, 4);
        else { const int t0 = (cl - 8) * 8 + C.wave; run(false, t0, 192, t0 < 64 ? 22 : 21); }
    }
}
__device__ __forceinline__ float wave_scan_add(float v, int lane) {
#pragma unroll
    for (int o = 1; o < 64; o <<= 1) { const float t = bperm_f(v, lane - o); if (lane >= o) v += t; }
    return v;
}
__device__ __forceinline__ float wave_scan_max(float v, int lane) {
#pragma unroll
    for (int o = 1; o < 64; o <<= 1) { const float t = bperm_f(v, lane - o); if (lane >= o) v = fmaxf(v, t); }
    return v;
}
__device__ __forceinline__ void conv_gate_phase(const Ctx& C, int l) {
    bf16* MQK = (bf16*)(C.ws + WS_MQK);
    const float* cw = C.inp(8) + (size_t)l * 3 * 2048; const float* cb = C.inp(9) + (size_t)l * 2048;
    {
        const bf16* RAWQ = (const bf16*)(C.ws + WS_RAWQ);
        const int gt = C.vcu * NTHR + C.tid, NT = C.G * NTHR;
        for (int idx = gt; idx < (MROWS / 256) * 2 * 256; idx += NT) {
            const int pm = idx >> 9, k = (idx >> 8) & 1, cg = idx & 255, j = pm % 17;
            if (j == 0 || (k == 0 && j == 1) || (k == 1 && j == 16)) continue;
            const bf16* P = k == 0 ? RAWQ + ((size_t)(pm - 1) * 4 + 3) * 2048 : RAWQ + ((size_t)pm * 4 + 2) * 2048;
            const bf16* Cc = k == 0 ? RAWQ + ((size_t)pm * 4 + 0) * 2048 : RAWQ + ((size_t)pm * 4 + 3) * 2048;
            const bf16* Nn = k == 0 ? RAWQ + ((size_t)pm * 4 + 1) * 2048 : RAWQ + ((size_t)(pm + 1) * 4 + 0) * 2048;
            const u32x4 xp = *(const u32x4*)(P + cg * 8), xc = *(const u32x4*)(Cc + cg * 8), xn = *(const u32x4*)(Nn + cg * 8);
            const unsigned pw[4] = {xp.x, xp.y, xp.z, xp.w}, cwd[4] = {xc.x, xc.y, xc.z, xc.w}, nwd[4] = {xn.x, xn.y, xn.z, xn.w};
            const float scl = cg < 128 ? QSCALE : 1.0f; float o[8];
#pragma unroll
            for (int q = 0; q < 4; ++q) { const int c0 = cg * 8 + 2 * q, c1 = c0 + 1;
                o[2 * q] = silu_f(cb[c0] + cw[c0] * bflo(pw[q]) + cw[2048 + c0] * bflo(cwd[q]) + cw[4096 + c0] * bflo(nwd[q])) * scl;
                o[2 * q + 1] = silu_f(cb[c1] + cw[c1] * bfhi(pw[q]) + cw[2048 + c1] * bfhi(cwd[q]) + cw[4096 + c1] * bfhi(nwd[q])) * scl; }
            u32x4 w; w.x = pk2(o[0], o[1]); w.y = pk2(o[2], o[3]); w.z = pk2(o[4], o[5]); w.w = pk2(o[6], o[7]);
            *(u32x4*)(MQK + ((size_t)pm * 256 + (k ? 255 : 0)) * DM + cg * 8) = w;
        }
    }
    {
        const float* GATES = (const float*)(C.ws + WS_GATES);
        float* GA = (float*)(C.ws + WS_GA); float* GMX = (float*)(C.ws + WS_GMX); float* GCUM = (float*)(C.ws + WS_GCUM);
        const int gw = C.vcu * NWAVES + C.wave, NGW = C.G * NWAVES;
        for (int it = gw; it < NB * 2 * NH * NCH; it += NGW) {
            const int ch = it % NCH, hh = (it / NCH) % NH, dir = (it / (NCH * NH)) & 1, b = it / (NCH * NH * 2);
            const int s0 = 2 * C.lane, s1 = s0 + 1, i0 = dir ? 127 - s0 : s0, i1 = dir ? 127 - s1 : s1;
            const size_t r0 = (size_t)b * TT + ch * 128 + i0, r1 = (size_t)b * TT + ch * 128 + i1;
            const float ig0 = GATES[r0 * 32 + dir * 16 + hh], fg0 = GATES[r0 * 32 + dir * 16 + 8 + hh];
            const float ig1 = GATES[r1 * 32 + dir * 16 + hh], fg1 = GATES[r1 * 32 + dir * 16 + 8 + hh];
            const float lf0 = fminf(fg0, 0.f) - __logf(1.0f + __expf(-fabsf(fg0))), lf1 = fminf(fg1, 0.f) - __logf(1.0f + __expf(-fabsf(fg1)));
            const float c1 = lf0 + lf1; const float incl = wave_scan_add(c1, C.lane); const float off = incl - c1;
            const float cum0 = off + lf0, cum1 = off + c1;
            const float a0 = ig0 - cum0, a1 = ig1 - cum1;
            const float m1 = fmaxf(a0, a1); const float mincl = wave_scan_max(m1, C.lane);
            float mprev = bperm_f(mincl, C.lane - 1); const float mx0 = C.lane == 0 ? a0 : fmaxf(mprev, a0); const float mx1 = mincl;
            const size_t o0 = ((size_t)dir * MROWS + r0) * 8 + hh, o1 = ((size_t)dir * MROWS + r1) * 8 + hh;
            GA[o0] = a0; GA[o1] = a1; GMX[o0] = mx0; GMX[o1] = mx1; GCUM[o0] = cum0; GCUM[o1] = cum1;
        }
    }
}
__device__ __forceinline__ unsigned off_b(unsigned row, unsigned ch) { return 256u * row + 16u * (ch ^ (((row & 3u) << 2) | ((row >> 2) & 3u))); }
__device__ __forceinline__ unsigned tr_addr(unsigned lane, unsigned c, unsigned ks, unsigned t) {
    const unsigned h = lane >> 5, blk = (lane >> 4) & 1u, q = (lane & 15u) >> 2, p = lane & 3u;
    return off_b(16u * ks + 8u * h + 4u * t + q, 4u * c + 2u * blk + (p >> 1)) + 8u * (p & 1u);
}
__device__ __forceinline__ bf16x8 tr_frag(LAS unsigned char* tile, unsigned lane, unsigned c, unsigned ks) {
    const s16x4 lo = __builtin_amdgcn_ds_read_tr16_b64_v4i16((LAS s16x4*)(tile + tr_addr(lane, c, ks, 0)));
    const s16x4 hi = __builtin_amdgcn_ds_read_tr16_b64_v4i16((LAS s16x4*)(tile + tr_addr(lane, c, ks, 1)));
    return __builtin_shufflevector(lo, hi, 0, 1, 2, 3, 4, 5, 6, 7);
}
__device__ __forceinline__ bf16x8 tr_frag2(LAS unsigned char* a0, LAS unsigned char* a1) {
    const s16x4 lo = __builtin_amdgcn_ds_read_tr16_b64_v4i16((LAS s16x4*)a0);
    const s16x4 hi = __builtin_amdgcn_ds_read_tr16_b64_v4i16((LAS s16x4*)a1);
    return __builtin_shufflevector(lo, hi, 0, 1, 2, 3, 4, 5, 6, 7);
}
__device__ __forceinline__ void stage_tile(LAS unsigned char* tile, const bf16* g, int ld, int wave, int lane) {
    const char* gb = (const char*)g;
#pragma unroll
    for (int i = 0; i < 4; ++i) {
        const unsigned o = (unsigned)(wave * 4 + i) * 1024u + (unsigned)lane * 16u;
        const unsigned row = o >> 8, chs = (o >> 4) & 15u, ch = chs ^ (((row & 3u) << 2) | ((row >> 2) & 3u));
        const unsigned voff = (row * (unsigned)ld + ch * 8u) * 2u;
        __builtin_amdgcn_global_load_lds((const unsigned*)(gb + voff), (LAS unsigned*)(tile + (wave * 4 + i) * 1024), 16, 0, 0);
    }
}
#define SC_DPP(v, ctrl) __builtin_bit_cast(float, __builtin_amdgcn_update_dpp(0, __builtin_bit_cast(int, (float)(v)), (ctrl), 0xf, 0xf, false))
__device__ __forceinline__ void emit_q(const f32x16& Yq, int q, LAS float* PSUMh, LAS float* PSUMh2, int wave, int lane, int r, int h, char* YNrow, int hf) {
#pragma unroll
    for (int g = 0; g < 4; ++g) { f32x4 s4;
#pragma unroll
        for (int e = 0; e < 4; ++e) { const float y = Yq[4 * g + e];
            const unsigned voff = (unsigned)(64 * hf + 32 * q + 8 * g + 4 * h + e) * (unsigned)(DM * 2) + (unsigned)r * 2u;
            const unsigned yb = pk2(y, 0.f) & 0xffffu; *(bf16*)(YNrow + voff) = (bf16)yb;
            float v = y * y;
            v += SC_DPP(v, 0xB1); v += SC_DPP(v, 0x4E); v += SC_DPP(v, 0x141); v += SC_DPP(v, 0x140);
            s4[e] = v; }
        if ((lane & 15) == 0) *(LAS f32x4*)(((lane & 16) ? PSUMh2 : PSUMh) + wave * 64 + 32 * q + 8 * g + 4 * h) = s4; }
}
__device__ __forceinline__ void reduce_ss(const LAS float* PSUMh, const LAS float* PSUMh2, int tid, float* SSrow) {
    if (tid < 64) { float s = 0.f;
#pragma unroll
        for (int w = 0; w < 8; ++w) s += PSUMh[w * 64 + tid] + PSUMh2[w * 64 + tid];
        SSrow[tid] = s; }
}
__device__ __forceinline__ void add_image(f32x16& y, const u32x4 a, const u32x4 b) {
    y[0] += bflo(a.x); y[1] += bfhi(a.x); y[2] += bflo(a.y); y[3] += bfhi(a.y); y[4] += bflo(a.z); y[5] += bfhi(a.z); y[6] += bflo(a.w); y[7] += bfhi(a.w);
    y[8] += bflo(b.x); y[9] += bfhi(b.x); y[10] += bflo(b.y); y[11] += bfhi(b.y); y[12] += bflo(b.z); y[13] += bfhi(b.z); y[14] += bflo(b.w); y[15] += bfhi(b.w);
}
constexpr int NSPLIT = NCH / 2 + 1;
#define MFMA32(a, b, c) __builtin_amdgcn_mfma_f32_32x32x16_bf16((a), (b), (c), 0, 0, 0)
__device__ __forceinline__ void scan_phase(const Ctx& C, int l, const XcdBarrier& bar) {
    LAS unsigned char* LQ = C.lds; LAS unsigned char* LK = C.lds + 32768; LAS unsigned char* LV = C.lds + 65536; LAS unsigned char* LP = C.lds + PBUF_OFF;
    LAS float* AUX = (LAS float*)(C.lds + AUX_OFF);
    LAS float* CJ = AUX; LAS float* RI = AUX + 128; LAS float* RS = AUX + 256; LAS float* WW = AUX + 384; LAS float* EMT = AUX + 512; LAS float* INV = AUX + 640;
    LAS float* QN = AUX + 768; LAS float* NV = AUX + 896; LAS float* RSUM = AUX + 1024; LAS float* NP2 = (LAS float*)(C.lds + NP2_OFF);
    const int tid_ = C.tid, lane_ = C.lane, wave = C.wave, r_ = lane_ & 31, h_ = lane_ >> 5;
    const bf16* PROJ = (const bf16*)(C.ws + WS_PROJ); const bf16* MQK = (const bf16*)(C.ws + WS_MQK);
    const float* GA = (const float*)(C.ws + WS_GA); const float* GMX = (const float*)(C.ws + WS_GMX); const float* GCUM = (const float*)(C.ws + WS_GCUM);
    const float* decay_exp = C.inp(11) + (size_t)l * 16;
    for (int u = C.vcu; u < 256; u += C.G) {
        const int dir = u & 1, br = (u >> 1) & 1, hh = (u >> 2) & 7, b = u >> 5;
        const bf16* Qg = br ? MQK + hh * 128 : PROJ + hh * 128;
        const bf16* Kg = br ? MQK + 1024 + hh * 128 : PROJ + 1024 + hh * 128;
        const bf16* Vg = br ? PROJ + 6144 + hh * 256 : PROJ + 2048 + hh * 256;
        const int ldq = br ? DM : LDP;
        char* const Yob = (char*)(C.ws + WS_Y4 + (size_t)(br * 2) * SLOT) + (hh * 256 + wave * 32) * 2;
        LAS float* PSUMh = AUX + 1536; LAS float* PSUMh2 = (LAS float*)(C.lds + PSUM2_OFF);
        float* const SSh = (float*)(C.ws + WS_SS) + (size_t)(br * 8 + hh) * MROWS;
        f32x16 S[4];
#pragma unroll
        for (int t = 0; t < 4; ++t)
#pragma unroll
            for (int e = 0; e < 16; ++e) S[t][e] = 0.f;
        float dec = 1.f, m = 0.f, m_next = 0.f;
        __syncthreads();
        int tidp = tid_; asm volatile("" : "+v"(tidp));
        if (br == 0) {
            const float lg2 = __log2f(1.0f - exp2f(-decay_exp[dir * 8 + hh]));
            dec = exp2f(128.f * lg2);
            if (tidp < 128) { const float i = (float)tidp;
                if (dir == 0) { CJ[tidp] = -i * lg2; RI[tidp] = -i * lg2; RS[tidp] = exp2f((i + 1.f) * lg2); WW[tidp] = exp2f((127.f - i) * lg2); }
                else { CJ[tidp] = i * lg2; RI[tidp] = i * lg2; RS[tidp] = exp2f((128.f - i) * lg2); WW[tidp] = exp2f(i * lg2); } }
        } else if (tidp < 128) NV[tidp] = 0.f;
        float pf_a = 0.f, pf_mx = 0.f, pf_cum = 0.f, pf_mxl = 0.f, pf_total = 0.f;
        if (br == 1) { const int ch0 = dir == 0 ? 0 : 1; const size_t rown = (size_t)b * TT + ch0 * 128;
            const size_t gl = ((size_t)dir * MROWS + rown + (dir == 0 ? 127 : 0)) * 8 + hh; pf_mxl = GMX[gl]; pf_total = GCUM[gl];
            if (tidp < 128) { const size_t gi = ((size_t)dir * MROWS + rown + tidp) * 8 + hh; pf_a = GA[gi]; pf_mx = GMX[gi]; pf_cum = GCUM[gi]; } }
        for (int n = 0; n < NCH; ++n) {
            int tid = tid_;
            asm volatile("" : "+v"(tid));
            const int lane = tid & 63, r = tid & 31, h = (tid >> 5) & 1;
            if (n == NSPLIT) { XcdBarrier b2_ = bar; asm volatile("" : "+s"(b2_.bar), "+s"(b2_.x)); xcd_barrier(b2_); }
            const int ch = dir == 0 ? n : (n < 2 ? 1 - n : NCH + 1 - n);
            const unsigned sw16 = (unsigned)((((r & 3) << 2) | ((r >> 2) & 3)) << 4), rb = 256u * (unsigned)r, rb8h = rb + 8u * (unsigned)h, swh16 = sw16 ^ (16u * (unsigned)h);
            const unsigned tq = ((unsigned)lane & 15u) >> 2, tp = (unsigned)lane & 3u, tblk = ((unsigned)lane >> 4) & 1u, tx = 2u * tblk + (tp >> 1);
            const unsigned tb0 = 256u * (8u * h + tq) + 8u * (tp & 1u), tb1 = tb0 + 1024u;
            const unsigned txs0 = 16u * (tx ^ (4u * tq + 2u * h)), txs1 = 16u * (tx ^ (4u * tq + 2u * h + 1u));
            const size_t row0 = (size_t)b * TT + ch * 128;
            char* const IMGs = (char*)(C.ws + WS_IMG) + ((size_t)u * NSPLIT * 8 + wave) * 8192 + lane * 128; const char* const IMGq = (const char*)(C.ws + WS_IMG) + ((size_t)(u ^ 1) * NSPLIT * 8 + wave) * 8192 + lane * 128;
            char* const Yrow = Yob + row0 * (size_t)(DM * 2);
            if (br == 1) {
                const float mml = fmaxf(m, pf_mxl); dec = __expf(m - mml); m_next = pf_total + mml;
                if (tid < 128) { const float mm = fmaxf(m, pf_mx);
                    CJ[tid] = pf_a * LOG2E; RI[tid] = mm * LOG2E; RS[tid] = __expf(m - mm); WW[tid] = __expf(pf_a - mml); EMT[tid] = __expf(-(pf_cum + mm)); }
            }
            stage_tile(LQ, Qg + row0 * ldq, ldq, wave, lane); stage_tile(LK, Kg + row0 * ldq, ldq, wave, lane);
            stage_tile(LV, Vg + row0 * LDP, LDP, wave, lane); stage_tile(LV + 32768, Vg + row0 * LDP + 128, LDP, wave, lane);
            asm volatile("s_waitcnt vmcnt(8)" ::: "memory"); LDS_WAIT(); __builtin_amdgcn_s_barrier(); asm volatile("" ::: "memory");
            if (br == 1 && n + 1 < NCH) {
                const int chn = dir == 0 ? n + 1 : (n + 1 < 2 ? 1 - (n + 1) : NCH + 1 - (n + 1)); const size_t rown = (size_t)b * TT + chn * 128;
                const size_t gl = ((size_t)dir * MROWS + rown + (dir == 0 ? 127 : 0)) * 8 + hh; pf_mxl = GMX[gl]; pf_total = GCUM[gl];
                if (tid < 128) { const size_t gi = ((size_t)dir * MROWS + rown + tid) * 8 + hh; pf_a = GA[gi]; pf_mx = GMX[gi]; pf_cum = GCUM[gi]; } }
            if (br == 1) {
                const int i = tid >> 2, part = tid & 3; float s = 0.f;
#pragma unroll
                for (int c = 0; c < 4; ++c) { const u32x4 qw = *(const LAS u32x4*)(LQ + off_b(i, 4 * part + c)); const LAS float* nv = NV + 32 * part + 8 * c;
                    s += bflo(qw.x) * nv[0] + bfhi(qw.x) * nv[1] + bflo(qw.y) * nv[2] + bfhi(qw.y) * nv[3] + bflo(qw.z) * nv[4] + bfhi(qw.z) * nv[5] + bflo(qw.w) * nv[6] + bfhi(qw.w) * nv[7]; }
                s = quad_sum(s);
                if (part == 0) QN[i] = s;
            }
            LAS unsigned char* const vb0 = LV + (wave >> 2) * 32768 + tb0 + ((unsigned)(64 * (wave & 3)) ^ txs0); LAS unsigned char* const vb1 = LV + (wave >> 2) * 32768 + tb1 + ((unsigned)(64 * (wave & 3)) ^ txs1);
#pragma unroll
            for (int hf = 0; hf < 2; ++hf) {
                const int jb = wave >> 1, ibp = 2 * hf + (wave & 1);
                f32x16 PT;
#pragma unroll
                for (int e = 0; e < 16; ++e) PT[e] = 0.f;
#pragma unroll
                for (int s = 0; s < 8; ++s) {
                    const bf16x8 ka = *(const LAS bf16x8*)(LK + 8192 * jb + rb + ((unsigned)(32 * s) ^ swh16));
                    const bf16x8 qb = *(const LAS bf16x8*)(LQ + 8192 * ibp + rb + ((unsigned)(32 * s) ^ swh16));
                    PT = MFMA32(ka, qb, PT);
                }
                { const int i = 32 * ibp + r; const float ri = RI[i]; float rsum = 0.f;
#pragma unroll
                  for (int g = 0; g < 4; ++g) { const f32x4 cj4 = *(const LAS f32x4*)(CJ + 32 * jb + 8 * g + 4 * h);
#pragma unroll
                      for (int e = 0; e < 4; ++e) { const int j = 32 * jb + 8 * g + 4 * h + e; const bool ok = dir == 0 ? (j <= i) : (j >= i);
                          const float f = ok ? __builtin_amdgcn_exp2f(cj4[e] - ri) : 0.f; const float pv = PT[4 * g + e] * f; PT[4 * g + e] = pv; rsum += pv; } }
                  if (br == 1) { rsum += bperm_f(rsum, lane ^ 32); if (h == 0) RSUM[jb * 128 + i] = rsum; } }
                if (hf == 0) VM_WAIT();
                __syncthreads();
                if (hf == 1 && n >= NSPLIT) reduce_ss(PSUMh, PSUMh2, tid, SSh + row0 + 0);
#pragma unroll
                for (int g = 0; g < 4; ++g) { u32x2 w; w.x = pk2(PT[4 * g], PT[4 * g + 1]); w.y = pk2(PT[4 * g + 2], PT[4 * g + 3]);
                    *(LAS u32x2*)(LP + 8192 * (wave & 1) + rb8h + ((unsigned)(64 * jb + 16 * g) ^ sw16)) = w; }
                if (br == 1 && tid < 64) { const int i = 64 * hf + tid; const float den = (RSUM[i] + RSUM[128 + i]) + (RSUM[256 + i] + RSUM[384 + i]) + RS[i] * QN[i]; INV[i] = 1.0f / fmaxf(fabsf(den), EMT[i]); }
                __syncthreads();
                {
                    u32x4 pw[2][2];
                    if (n >= NSPLIT) { const char* pp = IMGq + (size_t)(NCH + 1 - n) * 8 * 8192 + (2 * hf) * 32;
                        pw[0][0] = *(const u32x4*)pp; pw[0][1] = *(const u32x4*)(pp + 16); pw[1][0] = *(const u32x4*)(pp + 32); pw[1][1] = *(const u32x4*)(pp + 48); }
#pragma unroll
                    for (int q = 0; q < 2; ++q) {
                        const int ib = 2 * hf + q;
                        f32x16 Y;
#pragma unroll
                        for (int e = 0; e < 16; ++e) Y[e] = 0.f;
#pragma unroll
                        for (int t = 0; t < 4; ++t)
#pragma unroll
                            for (int s = 0; s < 2; ++s) {
                                u32x4 sw_; sw_.x = pk2(S[t][8 * s], S[t][8 * s + 1]); sw_.y = pk2(S[t][8 * s + 2], S[t][8 * s + 3]); sw_.z = pk2(S[t][8 * s + 4], S[t][8 * s + 5]); sw_.w = pk2(S[t][8 * s + 6], S[t][8 * s + 7]);
                                const bf16x8 bs = __builtin_bit_cast(bf16x8, sw_);
                                const s16x4 a0 = *(const LAS s16x4*)(LQ + 8192 * ib + rb8h + ((unsigned)((4 * t + 2 * s) * 16) ^ sw16));
                                const s16x4 a1 = *(const LAS s16x4*)(LQ + 8192 * ib + rb8h + ((unsigned)((4 * t + 2 * s + 1) * 16) ^ sw16));
                                const bf16x8 av = __builtin_shufflevector(a0, a1, 0, 1, 2, 3, 4, 5, 6, 7);
                                Y = MFMA32(av, bs, Y);
                            }
#pragma unroll
                        for (int g = 0; g < 4; ++g) { const f32x4 rs4 = *(const LAS f32x4*)(RS + 32 * ib + 8 * g + 4 * h);
#pragma unroll
                            for (int e = 0; e < 4; ++e) Y[4 * g + e] *= rs4[e]; }
#pragma unroll
                        for (int ks = 0; ks < 8; ++ks) { const bf16x8 bvk = tr_frag2(vb0 + 4096 * ks, vb1 + 4096 * ks);
                            const bf16x8 pa = *(const LAS bf16x8*)(LP + 8192 * q + rb + ((unsigned)(32 * ks) ^ swh16)); Y = MFMA32(pa, bvk, Y); }
                        if (br == 1) {
#pragma unroll
                            for (int g = 0; g < 4; ++g) { const f32x4 sc4 = *(const LAS f32x4*)(INV + 32 * ib + 8 * g + 4 * h);
#pragma unroll
                                for (int e = 0; e < 4; ++e) Y[4 * g + e] *= sc4[e]; } }
                        if (n < NSPLIT) { char* op = IMGs + (size_t)n * 8 * 8192 + (2 * hf + q) * 32;
                            u32x4 w0, w1; w0.x = pk2(Y[0], Y[1]); w0.y = pk2(Y[2], Y[3]); w0.z = pk2(Y[4], Y[5]); w0.w = pk2(Y[6], Y[7]);
                            w1.x = pk2(Y[8], Y[9]); w1.y = pk2(Y[10], Y[11]); w1.z = pk2(Y[12], Y[13]); w1.w = pk2(Y[14], Y[15]);
                            *(u32x4*)op = w0; *(u32x4*)(op + 16) = w1;
                        } else { add_image(Y, pw[q][0], pw[q][1]); emit_q(Y, q, PSUMh, PSUMh2, wave, lane, r, h, Yrow, hf); }
                    }
                }
            }
#pragma unroll
            for (int t = 0; t < 4; ++t)
#pragma unroll
                for (int e = 0; e < 16; ++e) S[t][e] *= dec;
#pragma unroll
            for (int ks = 0; ks < 8; ++ks) {
                const f32x4 w0 = *(const LAS f32x4*)(WW + 16 * ks + 8 * h), w1 = *(const LAS f32x4*)(WW + 16 * ks + 8 * h + 4);
                const bf16x8 bvk = tr_frag2(vb0 + 4096 * ks, vb1 + 4096 * ks);
                const u32x4 vw = __builtin_bit_cast(u32x4, bvk);
                u32x4 sw; sw.x = pk2(bflo(vw.x) * w0[0], bfhi(vw.x) * w0[1]); sw.y = pk2(bflo(vw.y) * w0[2], bfhi(vw.y) * w0[3]); sw.z = pk2(bflo(vw.z) * w1[0], bfhi(vw.z) * w1[1]); sw.w = pk2(bflo(vw.w) * w1[2], bfhi(vw.w) * w1[3]);
                const bf16x8 bw = __builtin_bit_cast(bf16x8, sw);
                bf16x8 ka[4];
#pragma unroll
                for (int t = 0; t < 4; ++t) ka[t] = tr_frag2(LK + 4096 * ks + tb0 + ((unsigned)(64 * t) ^ txs0), LK + 4096 * ks + tb1 + ((unsigned)(64 * t) ^ txs1));
                __builtin_amdgcn_sched_barrier(0);
#pragma unroll
                for (int t = 0; t < 4; ++t) S[t] = MFMA32(ka[t], bw, S[t]);
            }
            if (br == 1) {
                const int dg = tid & 15, jp = tid >> 4; float s8[8];
#pragma unroll
                for (int e = 0; e < 8; ++e) s8[e] = 0.f;
#pragma unroll
                for (int jj = 0; jj < 4; ++jj) { const int j = 4 * jp + jj; const u32x4 kw = *(const LAS u32x4*)(LK + off_b(j, dg)); const float wj = WW[j];
                    s8[0] += wj * bflo(kw.x); s8[1] += wj * bfhi(kw.x); s8[2] += wj * bflo(kw.y); s8[3] += wj * bfhi(kw.y); s8[4] += wj * bflo(kw.z); s8[5] += wj * bfhi(kw.z); s8[6] += wj * bflo(kw.w); s8[7] += wj * bfhi(kw.w); }
#pragma unroll
                for (int e = 0; e < 8; ++e) { s8[e] += swz_xor16(s8[e]); s8[e] += bperm_f(s8[e], lane ^ 32); }
                if ((tid & 63) < 16) {
#pragma unroll
                    for (int e = 0; e < 8; ++e) NP2[wave * 128 + 8 * dg + e] = s8[e]; }
            }
            __syncthreads();
            if (n >= NSPLIT) reduce_ss(PSUMh, PSUMh2, tid, SSh + row0 + 64);
            if (br == 1) { if (tid < 128) NV[tid] = dec * NV[tid] + ((NP2[tid] + NP2[128 + tid]) + (NP2[256 + tid] + NP2[384 + tid])) + ((NP2[512 + tid] + NP2[640 + tid]) + (NP2[768 + tid] + NP2[896 + tid])); m = m_next; }
        }
        { __syncthreads();
          int tidc = tid_; asm volatile("" : "+v"(tidc));
          const int lanec = tidc & 63, rc = tidc & 31, hc = (tidc >> 5) & 1;
          char* const IMGoc = (char*)(C.ws + WS_IMG) + ((size_t)u * NSPLIT * 8 + wave) * 8192 + lanec * 128; const char* const IMGpc = (const char*)(C.ws + WS_IMG) + ((size_t)(u ^ 1) * NSPLIT * 8 + wave) * 8192 + lanec * 128;
          char* const YNc = Yob + ((size_t)b * TT + (dir == 0 ? 0 : 128)) * (size_t)(DM * 2);
#pragma unroll
          for (int hf = 0; hf < 2; ++hf) {
#pragma unroll
              for (int q = 0; q < 2; ++q) { f32x16 Yc;
#pragma unroll
                  for (int e = 0; e < 16; ++e) Yc[e] = 0.f;
                  const u32x4 o0 = *(const u32x4*)(IMGoc + (2 * hf + q) * 32), o1 = *(const u32x4*)(IMGoc + (2 * hf + q) * 32 + 16);
                  const u32x4 p0 = *(const u32x4*)(IMGpc + (size_t)8 * 8192 + (2 * hf + q) * 32), p1 = *(const u32x4*)(IMGpc + (size_t)8 * 8192 + (2 * hf + q) * 32 + 16);
                  add_image(Yc, o0, o1); add_image(Yc, p0, p1); emit_q(Yc, q, PSUMh, PSUMh2, wave, lanec, rc, hc, YNc, hf); }
              __syncthreads(); reduce_ss(PSUMh, PSUMh2, tidc, SSh + (size_t)b * TT + (dir == 0 ? 0 : 128) + 64 * hf); __syncthreads(); } }
    }
}
__device__ __forceinline__ void unpack8(const u32x4 w, float (&f)[8]) { f[0] = bflo(w.x); f[1] = bfhi(w.x); f[2] = bflo(w.y); f[3] = bfhi(w.y); f[4] = bflo(w.z); f[5] = bfhi(w.z); f[6] = bflo(w.w); f[7] = bfhi(w.w); }
__device__ __forceinline__ void conv_fix_phase(const Ctx& C, int l) {
    const bf16* RAW = (const bf16*)(C.ws + WS_RAW); bf16* ACT = (bf16*)(C.ws + WS_ACT);
    const float* fw = C.inp(17) + (size_t)l * 3 * UPN; const float* fb = C.inp(18) + (size_t)l * UPN;
    const int gt = C.vcu * NTHR + C.tid, NT = C.G * NTHR;
    for (int idx = gt; idx < (MROWS / 256) * 2 * 704; idx += NT) {
        const int pm = idx / 1408, rem = idx - pm * 1408, k = rem / 704, cg = rem - k * 704, j = pm % 17;
        if (j == 0 || (k == 0 && j == 1) || (k == 1 && j == 16)) continue;
        const bf16* P = k == 0 ? RAW + ((size_t)(pm - 1) * 4 + 3) * UPN : RAW + ((size_t)pm * 4 + 2) * UPN;
        const bf16* Cc = k == 0 ? RAW + ((size_t)pm * 4 + 0) * UPN : RAW + ((size_t)pm * 4 + 3) * UPN;
        const bf16* Nn = k == 0 ? RAW + ((size_t)pm * 4 + 1) * UPN : RAW + ((size_t)(pm + 1) * 4 + 0) * UPN;
        const size_t row = (size_t)pm * 256 + (k ? 255 : 0);
        float pa[8], ca[8], na[8], pg[8], cgv[8], ng[8];
        unpack8(*(const u32x4*)(P + cg * 8), pa); unpack8(*(const u32x4*)(Cc + cg * 8), ca); unpack8(*(const u32x4*)(Nn + cg * 8), na);
        unpack8(*(const u32x4*)(P + FF + cg * 8), pg); unpack8(*(const u32x4*)(Cc + FF + cg * 8), cgv); unpack8(*(const u32x4*)(Nn + FF + cg * 8), ng);
        float o[8];
#pragma unroll
        for (int e = 0; e < 8; ++e) { const int ca_ = cg * 8 + e, cgc = FF + cg * 8 + e;
            const float a = fb[ca_] + fw[ca_] * pa[e] + fw[UPN + ca_] * ca[e] + fw[2 * UPN + ca_] * na[e];
            const float g = fb[cgc] + fw[cgc] * pg[e] + fw[UPN + cgc] * cgv[e] + fw[2 * UPN + cgc] * ng[e];
            o[e] = silu_f(a) * g; }
        u32x4 w; w.x = pk2(o[0], o[1]); w.y = pk2(o[2], o[3]); w.z = pk2(o[4], o[5]); w.w = pk2(o[6], o[7]);
        *(u32x4*)(ACT + row * FF + cg * 8) = w;
    }
}
#ifndef PHASE_MASK
#define PHASE_MASK 0xFFFFFFFFu
#endif
#ifndef DOUBLE_MASK
#define DOUBLE_MASK 0u
#endif
constexpr int CV_TF0 = 0, CV_TF1 = 4500, CV_TG1 = CV_I3, CV_TK = CV_I5;
#define TAILCV(lo, hi) if (l + 1 < NLAYER && C.G == 256) { __syncthreads(); refresh(C); const int ci_ = BX - 64; convert_weights(C, l + 1, (lo), (hi), ci_ >= 0 ? ci_ * NWAVES + C.wave : -1, 192 * NWAVES); } \
                       else if (l + 1 < NLAYER) { __syncthreads(); refresh(C); convert_weights(C, l + 1, (lo), (hi), C.vcu * NWAVES + C.wave, C.G * NWAVES); }
#define BX ((C.vcu & 31) * 8 + (C.vcu >> 5))
#define RUN(n) refresh(C); if ((PHASE_MASK >> (n)) & 1u)
#define DUP(n, ...) if ((DOUBLE_MASK >> (n)) & 1u) { __syncthreads(); refresh(C); __VA_ARGS__; }
__device__ __forceinline__ void refresh(Ctx& C) {
    asm volatile("" : "+v"(C.tid)); asm volatile("" : "+s"(C.vcu)); C.lane = C.tid & 63;
}
#define GRID_BAR() do { XcdBarrier b2_ = bar; asm volatile("" : "+s"(b2_.bar), "+s"(b2_.x)); xcd_barrier(b2_); } while (0)
constexpr int WGM_NARROW = 4;
constexpr bool GEMM_SP2 = true, GEMM_ALIGN = true;
struct Params { const float* in[20]; float* out; unsigned char* ws; };
__global__ void __launch_bounds__(NTHR, 2) fwd_kernel(Params prm) {
    extern __shared__ __attribute__((aligned(16))) unsigned char lds_raw[];
    Ctx C;
    C.lds = (LAS unsigned char*)lds_raw;
    C.tid = threadIdx.x; C.lane = C.tid & 63; C.wave = __builtin_amdgcn_readfirstlane(C.tid >> 6);
    C.G = 256; { const int bx = blockIdx.x; C.vcu = (bx % 8) * (C.G / 8) + bx / 8; }
    C.out = prm.out; C.ws = prm.ws;
    volatile LAS unsigned* MISC = (volatile LAS unsigned*)(C.lds + MISC_OFF);
    if (C.tid < 16) MISC[C.tid] = 0u;
    __syncthreads();
    XcdBarrier bar = xcd_barrier_post((unsigned*)(C.ws + WS_CTL), MISC + 8);
    unsigned char* ws = C.ws;
    const float* MOD = (const float*)(ws + WS_MOD);
    bf16* Hb = (bf16*)(ws + WS_H);
    float* XC = (float*)(ws + WS_XC);

    RUN(0) mod_phase(C, 0, NLAYER, C.vcu, C.G); RUN(1) rope_table(C); __syncthreads(); RUN(2) convert_weights(C, 0, 0, CV_I4, C.vcu * NWAVES + C.wave, C.G * NWAVES);
    DUP(2, convert_weights(C, 0, 0, CV_I4, C.vcu * NWAVES + C.wave, C.G * NWAVES))
    DUP(0, mod_phase(C, 0, NLAYER, C.vcu, C.G))
    GRID_BAR();
    RUN(3) rn_phase<false, true>(C, 0, C.inp(0), C.inp(2), nullptr, nullptr, nullptr, nullptr, 0, nullptr, MOD, 0, 1, C.inp(6), Hb);
    DUP(3, rn_phase<false, true>(C, 0, C.inp(0), C.inp(2), nullptr, nullptr, nullptr, nullptr, 0, nullptr, MOD, 0, 1, C.inp(6), Hb))
    GRID_BAR();

    for (int l = 0; l < NLAYER; ++l) {
        const float* MODl = MOD + (size_t)l * 9 * MODW;
        const int lastl = (l == NLAYER - 1) ? 1 : 0;
        const int MG = lastl ? NB * SEQ : MROWS;
        RUN(4) { pg8::Gemm g{Hb, (const bf16*)(ws + WS_W1T), MROWS, N1, DM}; pg8::StaticOrder S; S.init(MROWS, N1, C.G, BX);
          pg8::EpiProj1 E{(bf16*)(ws + WS_PROJ), (float*)(ws + WS_GATES), C.inp(10) + (size_t)l * 32, (const float*)(ws + WS_ROPE), (const float*)(ws + WS_ROPE) + 2048,
                           (bf16*)(ws + WS_MQK), (bf16*)(ws + WS_RAWQ), C.inp(8) + (size_t)l * 3 * 2048, C.inp(9) + (size_t)l * 2048, (LAS float*)(C.lds + PBUF_OFF)};
          pg8::gemm_phase<pg8::EpiProj1, pg8::StaticOrder, GEMM_ALIGN, GEMM_SP2>(C.lds, g, S, E, C.tid); }
        DUP(4, { pg8::Gemm g{Hb, (const bf16*)(ws + WS_W1T), MROWS, N1, DM}; pg8::StaticOrder S; S.init(MROWS, N1, C.G, BX);
          pg8::EpiProj1 E{(bf16*)(ws + WS_PROJ), (float*)(ws + WS_GATES), C.inp(10) + (size_t)l * 32, (const float*)(ws + WS_ROPE), (const float*)(ws + WS_ROPE) + 2048,
                           (bf16*)(ws + WS_MQK), (bf16*)(ws + WS_RAWQ), C.inp(8) + (size_t)l * 3 * 2048, C.inp(9) + (size_t)l * 2048, (LAS float*)(C.lds + PBUF_OFF)};
          pg8::gemm_phase<pg8::EpiProj1, pg8::StaticOrder, GEMM_ALIGN, GEMM_SP2>(C.lds, g, S, E, C.tid); })
        { __syncthreads(); refresh(C); const int ci_ = BX - 136; const int iw_ = ci_ >= 0 ? ci_ * NWAVES + C.wave : -1;
          convert_weights(C, l, CV_I4, CV_I6, iw_, 120 * NWAVES);
          if (l > 0) convert_weights(C, l, CV_I3, CV_I4, iw_, 120 * NWAVES); }
        GRID_BAR();
        RUN(5) conv_gate_phase(C, l);
        DUP(5, conv_gate_phase(C, l))
        GRID_BAR();
        RUN(6) scan_phase(C, l, bar);
        DUP(6, scan_phase(C, l, bar))
        GRID_BAR();
        RUN(7) { pg8::Gemm g{Hb, (const bf16*)(ws + WS_W2T), MROWS, N2, DM}; pg8::StaticOrder S; S.init(MG, N2, C.G, BX, lastl);
          pg8::EpiMerge E{(bf16*)(ws + WS_Y4), (size_t)MROWS * DM, C.inp(12) + (size_t)l * 2 * DM, (bf16*)(ws + WS_PROJ), LDP, (const float*)(ws + WS_SS), MROWS, EPSN};
          pg8::gemm_phase<pg8::EpiMerge, pg8::StaticOrder, true, GEMM_SP2>(C.lds, g, S, E, C.tid); }
        GRID_BAR();
        unsigned* const ctl = (unsigned*)(ws + WS_CTL);
        const int bb = C.vcu >> 5, clx = C.vcu & 31; const bool ctxcu = !lastl && clx < 8;
        RUN(9) { pg8::Gemm g{(const bf16*)(ws + WS_Y4), (const bf16*)(ws + WS_WRO), MROWS, DM, DM}; pg8::StaticOrder S; S.init(NB * SEQ, DM, C.G, BX, 1, WGM_NARROW);
          pg8::EpiGate<false> E{(bf16*)(ws + WS_Y4 + SLOT), DM, (const bf16*)(ws + WS_PROJ) + 4096, LDP, nullptr, nullptr};
          pg8::gemm_phase<pg8::EpiGate<false>, pg8::StaticOrder, GEMM_ALIGN, GEMM_SP2>(C.lds, g, S, E, C.tid); }
        RUN(10) { pg8::Gemm g{(const bf16*)(ws + WS_Y4 + 2 * SLOT), (const bf16*)(ws + WS_WMO), MROWS, DM, DM}; pg8::StaticOrder S; S.init(NB * SEQ, DM, C.G, BX, 1, WGM_NARROW); if (!lastl) S.sig = 1;
          pg8::EpiGate<true> E{(bf16*)(ws + WS_Y4 + SLOT), DM, (const bf16*)(ws + WS_PROJ) + 6144, LDP, ctl + 5120, ctl + 5376 + 64 * bb};
          pg8::gemm_phase<pg8::EpiGate<true>, pg8::StaticOrder, GEMM_ALIGN, GEMM_SP2>(C.lds, g, S, E, C.tid); }
        RUN(9) { pg8::Gemm g{(const bf16*)(ws + WS_Y4), (const bf16*)(ws + WS_WRO), MROWS, DM, DM}; pg8::StaticOrder S; S.init(0, DM, C.G, BX, 0, WGM_NARROW); if (ctxcu) { S.sig = 1; S.xpm = 17 * bb; S.xpn = clx; }
          pg8::EpiGate<false> E{(bf16*)(ws + WS_Y4 + SLOT), DM, (const bf16*)(ws + WS_PROJ) + 4096, LDP, nullptr, nullptr};
          pg8::gemm_phase<pg8::EpiGate<false>, pg8::StaticOrder, GEMM_ALIGN, GEMM_SP2>(C.lds, g, S, E, C.tid); }
        RUN(10) { pg8::Gemm g{(const bf16*)(ws + WS_Y4 + 2 * SLOT), (const bf16*)(ws + WS_WMO), MROWS, DM, DM}; pg8::StaticOrder S; S.init(0, DM, C.G, BX, 0, WGM_NARROW); if (ctxcu) { S.sig = 1; S.xpm = 17 * bb; S.xpn = clx; }
          pg8::EpiGate<true> E{(bf16*)(ws + WS_Y4 + SLOT), DM, (const bf16*)(ws + WS_PROJ) + 6144, LDP, ctl + 5120, ctl + 5376 + 64 * bb};
          pg8::gemm_phase<pg8::EpiGate<true>, pg8::StaticOrder, GEMM_ALIGN, GEMM_SP2>(C.lds, g, S, E, C.tid); }
        if (lastl) GRID_BAR();
        else { refresh(C); wait_count(C, ctl + 5120, 256u * (unsigned)(l + 1)); if (ctxcu) wait_count(C, ctl + 5376 + 64 * bb, 8u * (unsigned)(l + 1)); }
        RUN(11) { pg8::Gemm g{(const bf16*)(ws + WS_Y4 + SLOT), (const bf16*)(ws + WS_WO), MROWS, DM, DM}; pg8::StaticOrder S;
          if (lastl) S.init(NB * SEQ, DM, C.G, BX, 1, WGM_NARROW);
          else if (!ctxcu) { S.init(NB * SEQ, DM, 192, bb + 8 * (clx - 8), 1, WGM_NARROW); S.lim = 960; }
          else { S.init(NB * SEQ, DM, 64, bb + 8 * clx, 1, WGM_NARROW); S.base = 960; S.xpm = 17 * bb; S.xpn = clx; }
          pg8::EpiPlain E{(bf16*)(ws + WS_Y4 + 3 * SLOT), DM, nullptr, nullptr};
          pg8::gemm_phase<pg8::EpiPlain, pg8::StaticOrder, GEMM_ALIGN, GEMM_SP2>(C.lds, g, S, E, C.tid); }
        GRID_BAR();
        RUN(12) rn_phase<true, true>(C, lastl, l == 0 ? C.inp(0) : C.out, l == 0 ? C.inp(2) : XC, C.out, XC, (const bf16*)(ws + WS_Y4 + 3 * SLOT),
                             MODl, 2, C.inp(6) + ((size_t)l * 4 + 1) * DM, MODl, 3, 4, C.inp(6) + ((size_t)l * 4 + 2) * DM, Hb);
        GRID_BAR();
        RUN(13) { pg8::Gemm g{Hb, (const bf16*)(ws + WS_WUT), MROWS, UPN, DM}; pg8::StaticOrder S; S.init(MG, UPN, C.G, BX, lastl);
          pg8::EpiConvAct E{(bf16*)(ws + WS_ACT), (bf16*)(ws + WS_RAW), C.inp(17) + (size_t)l * 3 * UPN, C.inp(18) + (size_t)l * UPN, (LAS float*)(C.lds + PBUF_OFF), FF, UPN};
          pg8::gemm_phase<pg8::EpiConvAct, pg8::StaticOrder, true, GEMM_SP2>(C.lds, g, S, E, C.tid); }
        DUP(13, { pg8::Gemm g{Hb, (const bf16*)(ws + WS_WUT), MROWS, UPN, DM}; pg8::StaticOrder S; S.init(MG, UPN, C.G, BX, lastl);
          pg8::EpiConvAct E{(bf16*)(ws + WS_ACT), (bf16*)(ws + WS_RAW), C.inp(17) + (size_t)l * 3 * UPN, C.inp(18) + (size_t)l * UPN, (LAS float*)(C.lds + PBUF_OFF), FF, UPN};
          pg8::gemm_phase<pg8::EpiConvAct, pg8::StaticOrder, true, GEMM_SP2>(C.lds, g, S, E, C.tid); })
        if (l + 1 < NLAYER) { __syncthreads(); refresh(C); const int ci_ = BX - 96; convert_weights(C, l + 1, 0, CV_I3, ci_ >= 0 ? ci_ * NWAVES + C.wave : -1, 160 * NWAVES); }
        GRID_BAR();
        RUN(14) conv_fix_phase(C, l);
        GRID_BAR();
        RUN(15) { pg8::Gemm g{(const bf16*)(ws + WS_ACT), (const bf16*)(ws + WS_WDT), MROWS, DM, FF}; pg8::StaticOrder S; S.init(NB * SEQ, DM, C.G, BX, 1, WGM_NARROW);
          if (!lastl) { S.sig = 1; if ((C.vcu & 31) < 8) { S.xpm = 17 * (C.vcu >> 5); S.xpn = C.vcu & 31; } }
          pg8::EpiPlain E{(bf16*)(ws + WS_OUTF), DM, ctl + 4096, ctl + 4352 + 64 * (C.vcu >> 5)};
          pg8::gemm_phase<pg8::EpiPlain, pg8::StaticOrder, GEMM_ALIGN, GEMM_SP2>(C.lds, g, S, E, C.tid); }
        if (lastl) GRID_BAR();
        if (l + 1 < NLAYER) {
            RUN(16) rn_phase<true, true>(C, 0, C.out, XC, C.out, XC, (const bf16*)(ws + WS_OUTF), MODl, 5, C.inp(6) + ((size_t)l * 4 + 3) * DM,
                                 MODl + 9 * MODW, 0, 1, C.inp(6) + ((size_t)(l + 1) * 4) * DM, Hb, ctl + 4096, 256u * (unsigned)(l + 1), ctl + 4352 + 64 * (C.vcu >> 5), 8u * (unsigned)(l + 1));
            GRID_BAR();
        } else {
            RUN(16) rn_phase<true, false>(C, 1, C.out, XC, C.out, XC, (const bf16*)(ws + WS_OUTF), MODl, 5, C.inp(6) + ((size_t)l * 4 + 3) * DM, nullptr, 0, 0, nullptr, nullptr);
        }
    }
}

extern "C" void kernel_launch(void* const* d_in, const int* in_sizes, int n_in, void* d_out, int out_size, void* d_ws, size_t ws_size, hipStream_t stream) {
    static int grid = 0;
    if (grid == 0) {
        if (n_in != 20 || ws_size < WS_END) { fprintf(stderr, "kernel_launch: need 20 inputs and >= %zu bytes of workspace (got %d, %zu)\n", (size_t)WS_END, n_in, ws_size); grid = -1; return; }
        int dev = 0, cus = 0, per_cu = 0;
        if (hipGetDevice(&dev) != hipSuccess || hipDeviceGetAttribute(&cus, hipDeviceAttributeMultiprocessorCount, dev) != hipSuccess) { grid = -1; return; }
        if (hipFuncSetAttribute((const void*)fwd_kernel, hipFuncAttributeMaxDynamicSharedMemorySize, LDS_BYTES) != hipSuccess) { fprintf(stderr, "kernel_launch: hipFuncSetAttribute failed\n"); grid = -1; return; }
        if (hipOccupancyMaxActiveBlocksPerMultiprocessor(&per_cu, (const void*)fwd_kernel, NTHR, LDS_BYTES) != hipSuccess || per_cu < 1) { fprintf(stderr, "kernel_launch: occupancy query says %d blocks per CU\n", per_cu); (void)hipGetLastError(); grid = -1; return; }
        grid = cus;
        if (grid != 256) { fprintf(stderr, "kernel_launch: built for 256 CUs (one scan unit per workgroup, mid-phase grid barrier); this device has %d\n", cus); grid = -1; return; }
    }
    if (grid < 0) return;
    (void)in_sizes; (void)out_size;
    if (hipMemsetAsync((char*)d_ws + WS_CTL, 0, CTL_ZERO_BYTES, stream) != hipSuccess) return;
    Params p{};
    for (int i = 0; i < 20; ++i) p.in[i] = (const float*)d_in[i];
    p.out = (float*)d_out; p.ws = (unsigned char*)d_ws;
    hipLaunchKernelGGL(fwd_kernel, dim3(grid), dim3(NTHR), LDS_BYTES, stream, p);
}
```

```cpp
#include <hip/hip_runtime.h>
#include <cstdio>
#include <cstdint>

namespace pg8 {
#define PG8_LAS __attribute__((address_space(3)))
typedef unsigned short bf16_t;
typedef short bf16x8 __attribute__((ext_vector_type(8)));
typedef float f32x4 __attribute__((ext_vector_type(4)));
typedef unsigned u32x4 __attribute__((ext_vector_type(4)));
constexpr int BM = 256, BK = 64, HALF = 128, HTB = HALF * BK * 2  , STAGE_BYTES = 8 * HTB, NXCD = 8, WGM = 4;

__host__ __device__ __forceinline__ int lds_byte(int r, int c) { const int st = (r >> 4) * 2 + (c >> 5), rr = r & 15, cc = c & 31, ob = rr * 64 + cc * 2; return st * 1024 + (ob ^ (((ob >> 9) & 1) << 5)); }
__host__ __device__ __forceinline__ void stage_rc(int b, int& R, int& C) { const int st = b / 1024, sb = b % 1024, swz = sb ^ (((sb >> 9) & 1) << 5); R = (st >> 1) * 16 + swz / 64; C = (st & 1) * 32 + (swz % 64) / 2; }
__host__ __device__ __forceinline__ int perm32(int rho) { const int n = rho >> 4, i = rho & 15; return 8 * (i >> 2) + 4 * n + (i & 3); }

struct Unit { int pm, pn, flag; };
struct Gemm { const bf16_t* A; const bf16_t* Bt; int M, N, K; };

struct StaticOrder {
    int nM, nN, nwg, G, c, skip, wgm;
    int base, lim;
    int sig, xpm, xpn;
    __host__ __device__ void init(int M, int N, int G_, int c_, int skip_ = 0, int wgm_ = WGM) { nM = M / BM; nN = N / BM; nwg = nM * nN; G = G_; c = c_; skip = skip_; wgm = wgm_; sig = 0; xpm = 0; xpn = -1; base = 0; lim = 0x7fffffff; }
    __host__ __device__ bool next(int i, Unit& u) const {
        const long L = (long)base + (long)i * G + c; u.flag = (sig && L + G >= nwg) ? 1 : 0;
        if (L >= nwg || L >= lim) { if (xpn >= 0 && L >= nwg && L < nwg + G) { u.pm = xpm; u.pn = xpn; u.flag = sig ? 2 : 0; return true; } return false; }
        int wgid = (int)L; { const int q = nwg / NXCD, r = nwg % NXCD, xcd = wgid % NXCD, off = wgid / NXCD; wgid = (xcd < r ? xcd * (q + 1) : r * (q + 1) + (xcd - r) * q) + off; }
        const int nig = wgm * nN, gid = wgid / nig, fm = gid * wgm, gsz = (nM - fm) < wgm ? (nM - fm) : wgm;
        u.pm = fm + ((wgid % nig) % gsz); u.pn = (wgid % nig) / gsz; if (skip) u.pm += (u.pm >> 4) + 1; return true;
    }
    __device__ __forceinline__ void a_ready(const Unit&) const {}
    __device__ __forceinline__ void done(const Unit&) const {}
};
__device__ __forceinline__ unsigned pk2(float lo, float hi) {
    typedef __bf16 b2_t __attribute__((ext_vector_type(2))); typedef float f2_t __attribute__((ext_vector_type(2)));
    f2_t f = {lo, hi}; b2_t b = __builtin_convertvector(f, b2_t); return __builtin_bit_cast(unsigned, b); }
__device__ __forceinline__ float bflo(unsigned w) { return __uint_as_float(w << 16); }
__device__ __forceinline__ float bfhi(unsigned w) { return __uint_as_float(w & 0xffff0000u); }
typedef float f32x2_t __attribute__((ext_vector_type(2)));
__device__ __forceinline__ f32x2_t sigmoid2(f32x2_t x) { const f32x2_t t = x * -1.4426950408889634f; const f32x2_t d = (f32x2_t){__builtin_amdgcn_exp2f(t.x), __builtin_amdgcn_exp2f(t.y)} + 1.0f;
    return (f32x2_t){__builtin_amdgcn_rcpf(d.x), __builtin_amdgcn_rcpf(d.y)}; }
__device__ __forceinline__ unsigned pk2v(f32x2_t f) { typedef __bf16 b2_t __attribute__((ext_vector_type(2))); return __builtin_bit_cast(unsigned, __builtin_convertvector(f, b2_t)); }

#define PG8_DPP(old, src, ctrl) __builtin_bit_cast(float, __builtin_amdgcn_update_dpp(__builtin_bit_cast(int, (float)(old)), __builtin_bit_cast(int, (float)(src)), (ctrl), 0xf, 0xf, false))
struct EpiPlain {
    static constexpr bool PERM = true, AFTER_DRAIN = false, PERMA = false;
    bf16_t* O; int ldc; unsigned* cnt_lat; unsigned* cnt_ctx;
    __device__ __forceinline__ void operator()(const f32x4 (&acc)[2][2][4][2], const Unit& u, int wr, int wc, int fr, int fq) const {
        const int row0 = u.pm * BM + wr * 64 + fr, col0 = u.pn * BM + wc * 32 + 8 * fq;
#pragma unroll
        for (int ai = 0; ai < 2; ++ai)
#pragma unroll
            for (int m = 0; m < 4; ++m) { bf16_t* rowp = O + (size_t)(row0 + ai * HALF + m * 16) * ldc + col0;
#pragma unroll
                for (int bj = 0; bj < 2; ++bj) { const f32x4 v0 = acc[ai][bj][m][0], v1 = acc[ai][bj][m][1];
                    u32x4 w; w.x = pk2(v0[0], v0[1]); w.y = pk2(v0[2], v0[3]); w.z = pk2(v1[0], v1[1]); w.w = pk2(v1[2], v1[3]);
                    *(u32x4*)(rowp + bj * HALF) = w; } }
        if (u.flag) { asm volatile("s_waitcnt vmcnt(0)" ::: "memory"); __builtin_amdgcn_s_barrier();
            if (wr == 0 && wc == 0 && fr == 0 && fq == 0) { __builtin_amdgcn_fence(__ATOMIC_RELEASE, "agent"); asm volatile("s_waitcnt vmcnt(0)" ::: "memory");
                (void)__hip_atomic_fetch_add(u.flag == 1 ? cnt_lat : cnt_ctx, 1u, __ATOMIC_RELAXED, __HIP_MEMORY_SCOPE_AGENT); } }
    }
};
struct EpiProj1 {
    static constexpr bool PERM = true, AFTER_DRAIN = false, PERMA = false;
    bf16_t* O; float* gates; const float* gate_b; const float* ropeC; const float* ropeS;
    bf16_t* MQK; bf16_t* RAWQ; const float* cw; const float* cb; PG8_LAS float* EX;
    __device__ __forceinline__ void operator()(const f32x4 (&acc)[2][2][4][2], const Unit& u, int wr, int wc, int fr, int fq) const {
        const int row0 = u.pm * BM + wr * 64 + fr;
        if (u.pn >= 16 && u.pn < 24) {
            const int chb = (u.pn - 16) * BM + wc * 32 + 8 * fq;
            const float scl = u.pn < 20 ? 0.08838834764831845f : 1.0f;
#pragma unroll
            for (int ai = 0; ai < 2; ++ai) { const int blk = 2 * ai + wr;
                if (fr == 0) {
#pragma unroll
                    for (int bj = 0; bj < 2; ++bj)
#pragma unroll
                        for (int n = 0; n < 2; ++n) *(PG8_LAS f32x4*)(EX + (((wc * 8 + 2 * blk) * 4 + fq) * 16 + bj * 8 + n * 4)) = acc[ai][bj][0][n]; }
                if (fr == 15) {
#pragma unroll
                    for (int bj = 0; bj < 2; ++bj)
#pragma unroll
                        for (int n = 0; n < 2; ++n) *(PG8_LAS f32x4*)(EX + (((wc * 8 + 2 * blk + 1) * 4 + fq) * 16 + bj * 8 + n * 4)) = acc[ai][bj][3][n]; } }
            if (wr == 0 && fr < 2) {
#pragma unroll
                for (int bj = 0; bj < 2; ++bj) { const f32x4 v0 = acc[0][bj][0][0], v1 = acc[0][bj][0][1];
                    u32x4 w; w.x = pk2(v0[0], v0[1]); w.y = pk2(v0[2], v0[3]); w.z = pk2(v1[0], v1[1]); w.w = pk2(v1[2], v1[3]);
                    *(u32x4*)(RAWQ + ((size_t)u.pm * 4 + fr) * 2048 + bj * HALF + chb) = w; } }
            if (wr == 1 && fr >= 14) {
#pragma unroll
                for (int bj = 0; bj < 2; ++bj) { const f32x4 v0 = acc[1][bj][3][0], v1 = acc[1][bj][3][1];
                    u32x4 w; w.x = pk2(v0[0], v0[1]); w.y = pk2(v0[2], v0[3]); w.z = pk2(v1[0], v1[1]); w.w = pk2(v1[2], v1[3]);
                    *(u32x4*)(RAWQ + ((size_t)u.pm * 4 + 2 + (fr - 14)) * 2048 + bj * HALF + chb) = w; } }
            asm volatile("s_waitcnt lgkmcnt(0)" ::: "memory"); __builtin_amdgcn_s_barrier(); asm volatile("" ::: "memory");
#pragma unroll
            for (int bj = 0; bj < 2; ++bj)
#pragma unroll
                for (int n = 0; n < 2; ++n) {
                    const int c4 = chb + bj * HALF + 4 * n;
                    const f32x4 w0 = *(const f32x4*)(cw + c4), w1 = *(const f32x4*)(cw + 2048 + c4), w2 = *(const f32x4*)(cw + 4096 + c4), bb = *(const f32x4*)(cb + c4);
#pragma unroll
                    for (int ai = 0; ai < 2; ++ai) { const int blk = 2 * ai + wr;
                        const f32x4 pe = (blk == 0) ? (f32x4){0.f, 0.f, 0.f, 0.f} : *(const PG8_LAS f32x4*)(EX + (((wc * 8 + 2 * blk - 1) * 4 + fq) * 16 + bj * 8 + n * 4));
                        const f32x4 ne = (blk == 3) ? (f32x4){0.f, 0.f, 0.f, 0.f} : *(const PG8_LAS f32x4*)(EX + (((wc * 8 + 2 * blk + 2) * 4 + fq) * 16 + bj * 8 + n * 4));
#pragma unroll
                        for (int m = 0; m < 4; ++m) { float o[4];
#pragma unroll
                            for (int e = 0; e < 4; ++e) { const float cur = acc[ai][bj][m][n][e];
                                const float oldp = (m == 0) ? pe[e] : PG8_DPP(0.f, acc[ai][bj][m == 0 ? 0 : m - 1][n][e], 0x121);
                                const float prev = PG8_DPP(oldp, cur, 0x111);
                                const float oldn = (m == 3) ? ne[e] : PG8_DPP(0.f, acc[ai][bj][m == 3 ? 3 : m + 1][n][e], 0x12f);
                                const float next = PG8_DPP(oldn, cur, 0x101);
                                const float cv = bb[e] + w0[e] * prev + w1[e] * cur + w2[e] * next;
                                o[e] = (cv * __builtin_amdgcn_rcpf(1.0f + __expf(-cv))) * scl; }
                            typedef unsigned u32x2_t __attribute__((ext_vector_type(2)));
                            u32x2_t w; w.x = pk2(o[0], o[1]); w.y = pk2(o[2], o[3]);
                            *(u32x2_t*)(MQK + (size_t)(row0 + ai * HALF + m * 16) * 2048 + c4) = w; } } }
            return;
        }
        if (u.pn == 32) {
            if (wc == 0) { const f32x4 g0 = *(const f32x4*)(gate_b + 8 * fq), g1 = *(const f32x4*)(gate_b + 8 * fq + 4);
#pragma unroll
                for (int ai = 0; ai < 2; ++ai)
#pragma unroll
                    for (int m = 0; m < 4; ++m) { float* gp = gates + (size_t)(row0 + ai * HALF + m * 16) * 32 + 8 * fq;
                        *(f32x4*)gp = acc[ai][0][m][0] + g0; *(f32x4*)(gp + 4) = acc[ai][0][m][1] + g1; } }
            return;
        }
        const int col0 = u.pn * BM + wc * 32 + 8 * fq;
        const bool roped = (u.pn < 8) && ((u.pm % 17) != 0);
        const float sc = (u.pn < 4) ? 0.08838834764831845f : 1.0f;
        const int tbase = (u.pm % 17) * 256 - 256 + wr * 64 + fr;
        const int p0 = (wc & 1) * 16 + 4 * fq, blk = wc >> 1;
#pragma unroll
        for (int ai = 0; ai < 2; ++ai) {
#pragma unroll
          for (int mh = 0; mh < 2; ++mh) {
            f32x4 c4v[4], s4v[4];
#pragma unroll
            for (int m = 2 * mh; m < 2 * mh + 2; ++m) { c4v[m] = (f32x4){1.f, 1.f, 1.f, 1.f}; s4v[m] = (f32x4){0.f, 0.f, 0.f, 0.f};
                if (roped) { const int t = tbase + ai * HALF + m * 16; const int pos = blk ? (t & 63) : (t >> 6);
                    c4v[m] = *(const f32x4*)(ropeC + pos * 32 + p0); s4v[m] = *(const f32x4*)(ropeS + pos * 32 + p0); } }
#pragma unroll
            for (int m = 2 * mh; m < 2 * mh + 2; ++m) { bf16_t* rowp = O + (size_t)(row0 + ai * HALF + m * 16) * 8192 + col0;
                const f32x4 c4 = c4v[m], s4 = s4v[m];
#pragma unroll
                for (int bj = 0; bj < 2; ++bj) { f32x4 v0 = acc[ai][bj][m][0] * sc, v1 = acc[ai][bj][m][1] * sc;
                    const f32x4 r0 = (f32x4){v0[0] * c4[0] - v0[1] * s4[0], v0[0] * s4[0] + v0[1] * c4[0], v0[2] * c4[1] - v0[3] * s4[1], v0[2] * s4[1] + v0[3] * c4[1]};
                    const f32x4 r1 = (f32x4){v1[0] * c4[2] - v1[1] * s4[2], v1[0] * s4[2] + v1[1] * c4[2], v1[2] * c4[3] - v1[3] * s4[3], v1[2] * s4[3] + v1[3] * c4[3]};
                    u32x4 w; w.x = pk2(r0[0], r0[1]); w.y = pk2(r0[2], r0[3]); w.z = pk2(r1[0], r1[1]); w.w = pk2(r1[2], r1[3]);
                    *(u32x4*)(rowp + bj * HALF) = w; } }
          }
        }
    }
};
template <bool ACCUM> struct EpiGate {
    static constexpr bool PERM = true, AFTER_DRAIN = false, PERMA = false;
    bf16_t* Y; int ldc; const bf16_t* Gt; int ldg; unsigned* cnt_lat; unsigned* cnt_ctx;
    __device__ __forceinline__ void operator()(const f32x4 (&acc)[2][2][4][2], const Unit& u, int wr, int wc, int fr, int fq) const {
        const int row0 = u.pm * BM + wr * 64 + fr, col0 = u.pn * BM + wc * 32 + 8 * fq;
        u32x4 gall[2][4][2];
        if (!ACCUM) {
#pragma unroll
            for (int ai = 0; ai < 2; ++ai)
#pragma unroll
                for (int m = 0; m < 4; ++m)
#pragma unroll
                    for (int bj = 0; bj < 2; ++bj) gall[ai][m][bj] = *(const u32x4*)(Gt + (size_t)(row0 + ai * HALF + m * 16) * ldg + col0 + bj * HALF); }
#pragma unroll
        for (int ai = 0; ai < 2; ++ai) {
            u32x4 gwv[4][2], ywv[4][2];
#pragma unroll
            for (int m = 0; m < 4; ++m)
#pragma unroll
                for (int bj = 0; bj < 2; ++bj) { const size_t row = (size_t)(row0 + ai * HALF + m * 16);
                    if (ACCUM) { gwv[m][bj] = *(const u32x4*)(Gt + row * ldg + col0 + bj * HALF); ywv[m][bj] = *(const u32x4*)(Y + row * ldc + col0 + bj * HALF); }
                    else gwv[m][bj] = gall[ai][m][bj]; }
#pragma unroll
            for (int m = 0; m < 4; ++m) { const size_t row = (size_t)(row0 + ai * HALF + m * 16);
#pragma unroll
                for (int bj = 0; bj < 2; ++bj) { const f32x4 v0 = acc[ai][bj][m][0], v1 = acc[ai][bj][m][1];
                    const u32x4 gw = gwv[m][bj];
                    float o[8] = {v0[0], v0[1], v0[2], v0[3], v1[0], v1[1], v1[2], v1[3]};
                    const float g[8] = {bflo(gw.x), bfhi(gw.x), bflo(gw.y), bfhi(gw.y), bflo(gw.z), bfhi(gw.z), bflo(gw.w), bfhi(gw.w)};
#pragma unroll
                    for (int e = 0; e < 8; ++e) o[e] = o[e] * g[e];
                    bf16_t* yp = Y + row * ldc + col0 + bj * HALF;
                    if (ACCUM) { const u32x4 yw = ywv[m][bj];
                        o[0] += bflo(yw.x); o[1] += bfhi(yw.x); o[2] += bflo(yw.y); o[3] += bfhi(yw.y); o[4] += bflo(yw.z); o[5] += bfhi(yw.z); o[6] += bflo(yw.w); o[7] += bfhi(yw.w); }
                    u32x4 w; w.x = pk2(o[0], o[1]); w.y = pk2(o[2], o[3]); w.z = pk2(o[4], o[5]); w.w = pk2(o[6], o[7]);
                    *(u32x4*)yp = w; } }
        }
        if (ACCUM && u.flag) { asm volatile("s_waitcnt vmcnt(0)" ::: "memory"); __builtin_amdgcn_s_barrier();
            if (wr == 0 && wc == 0 && fr == 0 && fq == 0) { __builtin_amdgcn_fence(__ATOMIC_RELEASE, "agent"); asm volatile("s_waitcnt vmcnt(0)" ::: "memory");
                (void)__hip_atomic_fetch_add(u.flag == 1 ? cnt_lat : cnt_ctx, 1u, __ATOMIC_RELAXED, __HIP_MEMORY_SCOPE_AGENT); } }
    }
};

struct EpiMerge {
    static constexpr bool PERM = true, AFTER_DRAIN = false, PERMA = false;
    bf16_t* Y4; size_t slot; const float* hnw; bf16_t* G; int ldg; const float* SS; int mrows; float eps;
    __device__ __forceinline__ void operator()(const f32x4 (&acc)[2][2][4][2], const Unit& u, int wr, int wc, int fr, int fq) const {
        const int row0 = u.pm * BM + wr * 64 + fr;
        if (u.pn >= 16) {
            const int col0 = u.pn * BM + wc * 32 + 8 * fq;
#pragma unroll
            for (int ai = 0; ai < 2; ++ai)
#pragma unroll
                for (int m = 0; m < 4; ++m) { bf16_t* rowp = G + (size_t)(row0 + ai * HALF + m * 16) * ldg + col0;
#pragma unroll
                    for (int bj = 0; bj < 2; ++bj) { const f32x4 v0 = acc[ai][bj][m][0], v1 = acc[ai][bj][m][1];
                        u32x4 w; w.x = pk2v(sigmoid2(__builtin_shufflevector(v0, v0, 0, 1))); w.y = pk2v(sigmoid2(__builtin_shufflevector(v0, v0, 2, 3)));
                        w.z = pk2v(sigmoid2(__builtin_shufflevector(v1, v1, 0, 1))); w.w = pk2v(sigmoid2(__builtin_shufflevector(v1, v1, 2, 3)));
                        *(u32x4*)(rowp + bj * HALF) = w; } }
            return;
        }
        const int br = u.pn >> 3, hh = u.pn & 7, col0 = hh * BM + wc * 32 + 8 * fq;
        bf16_t* Yn = Y4 + (size_t)(2 * br) * slot;
        f32x4 hw[2][2];
#pragma unroll
        for (int bj = 0; bj < 2; ++bj) { hw[bj][0] = *(const f32x4*)(hnw + br * 2048 + col0 + bj * HALF); hw[bj][1] = *(const f32x4*)(hnw + br * 2048 + col0 + bj * HALF + 4); }
        auto half_tile = [&](auto BR) {
#pragma unroll
        for (int am = 0; am < 4; ++am) { const int ai = am >> 1;
            u32x4 yv[2][2]; float ssv[2];
#pragma unroll
            for (int mm = 0; mm < 2; ++mm) { const int m = 2 * (am & 1) + mm; ssv[mm] = SS[(size_t)(br * 8 + hh) * mrows + row0 + ai * HALF + m * 16];
#pragma unroll
                for (int bj = 0; bj < 2; ++bj) yv[mm][bj] = *(const u32x4*)(Yn + (size_t)(row0 + ai * HALF + m * 16) * 2048 + col0 + bj * HALF); }
#pragma unroll
            for (int mm = 0; mm < 2; ++mm) { const int m = 2 * (am & 1) + mm; const size_t ro = (size_t)(row0 + ai * HALF + m * 16) * 2048 + col0;
                const float rstd = __builtin_amdgcn_rsqf(ssv[mm] * (1.0f / 256.0f) + eps);
#pragma unroll
                for (int bj = 0; bj < 2; ++bj) { const u32x4 a = yv[mm][bj]; const unsigned aw[4] = {a.x, a.y, a.z, a.w};
                    const f32x4 g0 = acc[ai][bj][m][0], g1 = acc[ai][bj][m][1];
                    const f32x2_t gp[4] = {__builtin_shufflevector(g0, g0, 0, 1), __builtin_shufflevector(g0, g0, 2, 3), __builtin_shufflevector(g1, g1, 0, 1), __builtin_shufflevector(g1, g1, 2, 3)};
                    const f32x2_t wp[4] = {__builtin_shufflevector(hw[bj][0], hw[bj][0], 0, 1), __builtin_shufflevector(hw[bj][0], hw[bj][0], 2, 3), __builtin_shufflevector(hw[bj][1], hw[bj][1], 0, 1), __builtin_shufflevector(hw[bj][1], hw[bj][1], 2, 3)};
                    unsigned ow[4];
#pragma unroll
                    for (int q = 0; q < 4; ++q) { const f32x2_t y2 = (f32x2_t){bflo(aw[q]), bfhi(aw[q])}; f32x2_t s2 = sigmoid2(gp[q]);
                        if (!decltype(BR)::value) s2 = s2 * gp[q];
                        ow[q] = pk2v((y2 * rstd) * (wp[q] * s2)); }
                    u32x4 w; w.x = ow[0]; w.y = ow[1]; w.z = ow[2]; w.w = ow[3];
                    *(u32x4*)(Yn + ro + bj * HALF) = w; } }
            asm volatile("" ::: "memory");
        }
        };
        if (br) half_tile(std::integral_constant<bool, true>{}); else half_tile(std::integral_constant<bool, false>{});
    }
};

struct EpiConvAct {
    static constexpr bool PERM = true, AFTER_DRAIN = false, PERMA = true;
    bf16_t* ACT; bf16_t* RAW; const float* fw; const float* fb; PG8_LAS float* EX; int FFn, UPNn;
    __device__ __forceinline__ void operator()(const f32x4 (&acc)[2][2][4][2], const Unit& u, int wr, int wc, int fr, int fq) const {
        const int chb = 128 * u.pn + 32 * wc + 8 * fq;
#pragma unroll
        for (int ai = 0; ai < 2; ++ai) { const int blk = 2 * ai + wr;
            if (fr == 0) {
#pragma unroll
                for (int bj = 0; bj < 2; ++bj)
#pragma unroll
                    for (int n = 0; n < 2; ++n) *(PG8_LAS f32x4*)(EX + (((wc * 8 + 2 * blk) * 4 + fq) * 16 + bj * 8 + n * 4)) = acc[ai][bj][0][n]; }
            if (fr == 15) {
#pragma unroll
                for (int bj = 0; bj < 2; ++bj)
#pragma unroll
                    for (int n = 0; n < 2; ++n) *(PG8_LAS f32x4*)(EX + (((wc * 8 + 2 * blk + 1) * 4 + fq) * 16 + bj * 8 + n * 4)) = acc[ai][bj][3][n]; } }
        if (wr == 0 && fr == 0) {
#pragma unroll
            for (int k = 0; k < 2; ++k)
#pragma unroll
                for (int bj = 0; bj < 2; ++bj) { const f32x4 v0 = acc[0][bj][k][0], v1 = acc[0][bj][k][1];
                    u32x4 w; w.x = pk2(v0[0], v0[1]); w.y = pk2(v0[2], v0[3]); w.z = pk2(v1[0], v1[1]); w.w = pk2(v1[2], v1[3]);
                    *(u32x4*)(RAW + ((size_t)u.pm * 4 + k) * UPNn + bj * FFn + chb) = w; } }
        if (wr == 1 && fr == 15) {
#pragma unroll
            for (int k = 0; k < 2; ++k)
#pragma unroll
                for (int bj = 0; bj < 2; ++bj) { const f32x4 v0 = acc[1][bj][2 + k][0], v1 = acc[1][bj][2 + k][1];
                    u32x4 w; w.x = pk2(v0[0], v0[1]); w.y = pk2(v0[2], v0[3]); w.z = pk2(v1[0], v1[1]); w.w = pk2(v1[2], v1[3]);
                    *(u32x4*)(RAW + ((size_t)u.pm * 4 + 2 + k) * UPNn + bj * FFn + chb) = w; } }
        asm volatile("s_waitcnt lgkmcnt(0)" ::: "memory"); __builtin_amdgcn_s_barrier(); asm volatile("" ::: "memory");
        const int row0 = u.pm * BM + wr * 64 + 4 * fr;
#pragma unroll
        for (int n = 0; n < 2; ++n) {
            const int c4 = chb + 4 * n;
            f32x4 w0[2], w1[2], w2[2], bb[2];
#pragma unroll
            for (int bj = 0; bj < 2; ++bj) { w0[bj] = *(const f32x4*)(fw + bj * FFn + c4); w1[bj] = *(const f32x4*)(fw + UPNn + bj * FFn + c4); w2[bj] = *(const f32x4*)(fw + 2 * UPNn + bj * FFn + c4); bb[bj] = *(const f32x4*)(fb + bj * FFn + c4); }
#pragma unroll
            for (int ai = 0; ai < 2; ++ai) { const int blk = 2 * ai + wr;
                f32x4 pe[2], ne[2];
#pragma unroll
                for (int bj = 0; bj < 2; ++bj) {
                    pe[bj] = (blk == 0) ? (f32x4){0.f, 0.f, 0.f, 0.f} : *(const PG8_LAS f32x4*)(EX + (((wc * 8 + 2 * blk - 1) * 4 + fq) * 16 + bj * 8 + n * 4));
                    ne[bj] = (blk == 3) ? (f32x4){0.f, 0.f, 0.f, 0.f} : *(const PG8_LAS f32x4*)(EX + (((wc * 8 + 2 * blk + 2) * 4 + fq) * 16 + bj * 8 + n * 4)); }
#pragma unroll
                for (int m = 0; m < 4; ++m) {
                    f32x4 cv[2];
#pragma unroll
                    for (int bj = 0; bj < 2; ++bj)
#pragma unroll
                        for (int e = 0; e < 4; ++e) { const float cur = acc[ai][bj][m][n][e];
                            const float prev = (m == 0) ? PG8_DPP(pe[bj][e], acc[ai][bj][3][n][e], 0x111) : acc[ai][bj][m == 0 ? 0 : m - 1][n][e];
                            const float next = (m == 3) ? PG8_DPP(ne[bj][e], acc[ai][bj][0][n][e], 0x101) : acc[ai][bj][m == 3 ? 3 : m + 1][n][e];
                            cv[bj][e] = bb[bj][e] + w0[bj][e] * prev + w1[bj][e] * cur + w2[bj][e] * next; }
                    float o[4];
#pragma unroll
                    for (int e = 0; e < 4; ++e) o[e] = (cv[0][e] * __builtin_amdgcn_rcpf(1.0f + __expf(-cv[0][e]))) * cv[1][e];
                    typedef unsigned u32x2_t __attribute__((ext_vector_type(2)));
                    u32x2_t w; w.x = pk2(o[0], o[1]); w.y = pk2(o[2], o[3]);
                    *(u32x2_t*)(ACT + (size_t)(row0 + ai * HALF + m) * FFn + c4) = w;
                }
            }
        }
    }
};
template <class Epi, class Sched, bool ALIGN_EPI = false, bool SP2 = false>
__device__ __forceinline__ void gemm_phase(PG8_LAS unsigned char* lds, const Gemm g, const Sched& S, const Epi& E, const int tid_) {
    const int tid = tid_, wid = __builtin_amdgcn_readfirstlane(tid >> 6), lane = tid & 63, wr = wid >> 2, wc = wid & 3, fr = lane & 15, fq = lane >> 4;
    const int K = g.K, nt = K / BK;
    unsigned voffA[2], voffB[2];
#pragma unroll
    for (int i = 0; i < 2; ++i) { int R, C; stage_rc(tid * 16 + i * 8192, R, C); const int Rb = Epi::PERM ? ((R & ~31) + perm32(R & 31)) : R;
        const int Ra = Epi::PERMA ? ((R & 64) + 4 * (R & 15) + ((R >> 4) & 3)) : R;
        voffA[i] = (unsigned)(Ra * K + C) * 2u; voffB[i] = (unsigned)(Rb * K + C) * 2u; }
    const size_t kstep = (size_t)(BK * 2);
    const size_t hstep = (size_t)HALF * K * 2;
    const size_t tstep = 2 * hstep;
    const unsigned ldsw = (unsigned)wid * 1024u;
    const int aoff = lds_byte(wr * 64 + fr, fq * 8), boff = lds_byte(wc * 32 + fr, fq * 8);
#define PG8_SA(b, h) (((b) * 2 + (h)) * HTB)
#define PG8_SB(b, h) ((4 + (b) * 2 + (h)) * HTB)
#define PG8_STAGE(bufoff, gbase, voff) do { _Pragma("unroll") for (int _i = 0; _i < 2; ++_i) \
        __builtin_amdgcn_global_load_lds((const unsigned*)((const char*)(gbase) + (voff)[_i]), (PG8_LAS unsigned*)(lds + (bufoff) + ldsw + _i * 8192), 16, 0, 0); } while (0)
#define PG8_LDA(dst, b, h) do { _Pragma("unroll") for (int m = 0; m < 4; ++m) _Pragma("unroll") for (int k = 0; k < 2; ++k) dst[m][k] = *(const PG8_LAS bf16x8*)(lds + PG8_SA(b, h) + aoff + m * 2048 + k * 1024); } while (0)
#define PG8_LDB(dst, b, h) do { _Pragma("unroll") for (int n = 0; n < 2; ++n) _Pragma("unroll") for (int k = 0; k < 2; ++k) dst[n][k] = *(const PG8_LAS bf16x8*)(lds + PG8_SB(b, h) + boff + n * 2048 + k * 1024); } while (0)
#define PG8_MMA(ai, bj, At, Bt) do { __builtin_amdgcn_s_setprio(1); _Pragma("unroll") for (int m = 0; m < 4; ++m) _Pragma("unroll") for (int n = 0; n < 2; ++n) _Pragma("unroll") for (int k = 0; k < 2; ++k) \
        acc[ai][bj][m][n] = __builtin_amdgcn_mfma_f32_16x16x32_bf16(Bt[n][k], At[m][k], acc[ai][bj][m][n], 0, 0, 0); __builtin_amdgcn_s_setprio(0); } while (0)
#define PG8_WAIT_V(n) asm volatile("s_waitcnt vmcnt(" #n ")" ::: "memory")
#define PG8_WAIT_L(n) asm volatile("s_waitcnt lgkmcnt(" #n ")" ::: "memory")
#define PG8_BAR __builtin_amdgcn_s_barrier()
#define PG8_SCHED __builtin_amdgcn_sched_barrier(0)
    Unit cur, nxt; int ui = 0;
    if (!S.next(0, cur)) return;
    f32x4 acc[2][2][4][2];
#pragma unroll
    for (int a = 0; a < 2; ++a)
#pragma unroll
        for (int b = 0; b < 2; ++b)
#pragma unroll
            for (int m = 0; m < 4; ++m)
#pragma unroll
                for (int n = 0; n < 2; ++n) acc[a][b][m][n] = (f32x4){0.f, 0.f, 0.f, 0.f};
    bf16x8 At[4][2], B0[2][2], B1[2][2];
    const char* cA = (const char*)g.A + (size_t)cur.pm * tstep; const char* cB = (const char*)g.Bt + (size_t)cur.pn * tstep;
    S.a_ready(cur);
    if constexpr (SP2) {
        PG8_STAGE(PG8_SB(0, 0), cB, voffB); PG8_STAGE(PG8_SB(0, 1), cB + hstep, voffB); PG8_STAGE(PG8_SA(0, 0), cA, voffA); PG8_STAGE(PG8_SA(0, 1), cA + hstep, voffA);
        if (wr == 1) PG8_BAR;
        PG8_WAIT_V(2); PG8_BAR;
        PG8_STAGE(PG8_SB(1, 0), cB + kstep, voffB); PG8_STAGE(PG8_SA(1, 0), cA + kstep, voffA); PG8_STAGE(PG8_SB(1, 1), cB + hstep + kstep, voffB);
        PG8_WAIT_V(6); PG8_BAR;
    } else {
    PG8_STAGE(PG8_SB(0, 0), cB, voffB); PG8_STAGE(PG8_SA(0, 0), cA, voffA); PG8_STAGE(PG8_SB(0, 1), cB + hstep, voffB); PG8_STAGE(PG8_SA(0, 1), cA + hstep, voffA);
    if (wr == 1) PG8_BAR;
    PG8_WAIT_V(4); PG8_BAR;
    PG8_STAGE(PG8_SB(1, 0), cB + kstep, voffB); PG8_STAGE(PG8_SA(1, 0), cA + kstep, voffA); PG8_STAGE(PG8_SB(1, 1), cB + hstep + kstep, voffB);
    PG8_WAIT_V(6); PG8_BAR;
    }
    for (;;) {
        const bool has_next = S.next(ui + 1, nxt);
        const char* nA = has_next ? (const char*)g.A + (size_t)nxt.pm * tstep : cA; const char* nB = has_next ? (const char*)g.Bt + (size_t)nxt.pn * tstep : cB;
        for (int t = 0; t < nt; t += 2) {
            const bool last = (t == nt - 2);
            const char* a1 = cA + (size_t)(t + 1) * kstep;
            const char* a2 = last ? nA : cA + (size_t)(t + 2) * kstep; const char* b2 = last ? nB : cB + (size_t)(t + 2) * kstep;
            const char* a3 = a2 + kstep; const char* b3 = b2 + kstep;
            if (last && has_next) S.a_ready(nxt);
            if constexpr (SP2) {
            PG8_LDB(B0, 0, 0); PG8_LDB(B1, 0, 1); PG8_SCHED; PG8_LDA(At, 0, 0); PG8_STAGE(PG8_SA(1, 1), a1 + hstep, voffA);
            PG8_WAIT_V(8); PG8_WAIT_L(0); PG8_BAR; PG8_MMA(0, 0, At, B0); PG8_MMA(0, 1, At, B1); PG8_BAR; PG8_SCHED;
            PG8_LDA(At, 0, 1); PG8_STAGE(PG8_SB(0, 0), b2, voffB); PG8_STAGE(PG8_SB(0, 1), b2 + hstep, voffB); PG8_STAGE(PG8_SA(0, 0), a2, voffA);
            PG8_WAIT_V(8); PG8_WAIT_L(0); PG8_BAR; PG8_MMA(1, 0, At, B0); PG8_MMA(1, 1, At, B1); PG8_BAR; PG8_SCHED;
            PG8_LDB(B0, 1, 0); PG8_LDB(B1, 1, 1); PG8_SCHED; PG8_LDA(At, 1, 0); PG8_STAGE(PG8_SA(0, 1), a2 + hstep, voffA);
            PG8_WAIT_V(8); PG8_WAIT_L(0); PG8_BAR; PG8_MMA(0, 0, At, B0); PG8_MMA(0, 1, At, B1); PG8_BAR; PG8_SCHED;
            PG8_LDA(At, 1, 1); PG8_STAGE(PG8_SB(1, 0), b3, voffB); PG8_STAGE(PG8_SB(1, 1), b3 + hstep, voffB); PG8_STAGE(PG8_SA(1, 0), a3, voffA);
            PG8_WAIT_V(8); PG8_WAIT_L(0); PG8_BAR; PG8_MMA(1, 0, At, B0); PG8_MMA(1, 1, At, B1); PG8_BAR; PG8_SCHED;
            } else {
            PG8_LDB(B0, 0, 0); PG8_SCHED; PG8_LDA(At, 0, 0); PG8_STAGE(PG8_SA(1, 1), a1 + hstep, voffA);
            PG8_WAIT_L(8); PG8_BAR; PG8_WAIT_L(0); PG8_MMA(0, 0, At, B0); PG8_BAR; PG8_SCHED;
            PG8_LDB(B1, 0, 1); PG8_STAGE(PG8_SB(0, 0), b2, voffB);
            PG8_BAR; PG8_WAIT_L(0); PG8_MMA(0, 1, At, B1); PG8_BAR;
            PG8_LDA(At, 0, 1); PG8_STAGE(PG8_SA(0, 0), a2, voffA);
            PG8_BAR; PG8_WAIT_L(0); PG8_MMA(1, 0, At, B0); PG8_BAR; PG8_SCHED;
            PG8_STAGE(PG8_SB(0, 1), b2 + hstep, voffB);
            PG8_WAIT_V(6); PG8_BAR; PG8_MMA(1, 1, At, B1); PG8_BAR;
            PG8_LDB(B0, 1, 0); PG8_SCHED; PG8_LDA(At, 1, 0); PG8_STAGE(PG8_SA(0, 1), a2 + hstep, voffA);
            PG8_WAIT_L(8); PG8_BAR; PG8_WAIT_L(0); PG8_MMA(0, 0, At, B0); PG8_BAR; PG8_SCHED;
            PG8_LDB(B1, 1, 1); PG8_STAGE(PG8_SB(1, 0), b3, voffB);
            PG8_BAR; PG8_WAIT_L(0); PG8_MMA(0, 1, At, B1); PG8_BAR;
            PG8_LDA(At, 1, 1); PG8_STAGE(PG8_SA(1, 0), a3, voffA);
            PG8_BAR; PG8_WAIT_L(0); PG8_MMA(1, 0, At, B0); PG8_BAR; PG8_SCHED;
            PG8_STAGE(PG8_SB(1, 1), b3 + hstep, voffB);
            PG8_WAIT_V(6); PG8_BAR; PG8_MMA(1, 1, At, B1); PG8_BAR;
            }
        }
        if constexpr (ALIGN_EPI) { if (wr == 0) PG8_BAR; }
        if constexpr (!Epi::AFTER_DRAIN) { E(acc, cur, wr, wc, fr, fq); S.done(cur); }
        if (!has_next) break;
#pragma unroll
        for (int a = 0; a < 2; ++a)
#pragma unroll
            for (int b = 0; b < 2; ++b)
#pragma unroll
                for (int m = 0; m < 4; ++m)
#pragma unroll
                    for (int n = 0; n < 2; ++n) acc[a][b][m][n] = (f32x4){0.f, 0.f, 0.f, 0.f};
        cur = nxt; cA = nA; cB = nB; ++ui;
        if constexpr (ALIGN_EPI) { if (wr == 1) PG8_BAR; }
    }
    PG8_WAIT_V(0);
    if constexpr (!ALIGN_EPI) { if (wr == 0) PG8_BAR; }
    PG8_BAR;
    if constexpr (Epi::AFTER_DRAIN) { E.fused(acc, cur, wr, wc, fr, fq, lds, wid, lane); S.done(cur); }
#undef PG8_SA
#undef PG8_SB
#undef PG8_STAGE
#undef PG8_LDA
#undef PG8_LDB
#undef PG8_MMA
#undef PG8_WAIT_V
#undef PG8_WAIT_L
#undef PG8_BAR
#undef PG8_SCHED
}
}

constexpr int DM = 2048, NB = 8, SEQ = 4096, CTXL = 256, TT = CTXL + SEQ, MROWS = NB * TT, NLAYER = 4;
constexpr int NH = 8, DK = 128, DV = 256, FF = 5632, UPN = 2 * FF, INC = 16416, MODW = 6 * DM;
constexpr int N1 = 8448, N2 = 8192, LDP = 8192;
constexpr int NCH = TT / 128;
constexpr float EPSN = 1e-6f, LOG2E = 1.4426950408889634f, QSCALE = 0.08838834764831845f;
constexpr int NWAVES = 8, NTHR = 512;

constexpr size_t WS_CTL = 0, CTL_ZERO_BYTES = 65536;
constexpr size_t WS_MOD = 1u << 20;
constexpr size_t WS_ROPE = WS_MOD + (size_t)NLAYER * 9 * MODW * 4;
constexpr size_t WS_GATES = WS_ROPE + 64 * 32 * 2 * 4;
constexpr size_t WS_GA = WS_GATES + (size_t)MROWS * 32 * 4;
constexpr size_t WS_GMX = WS_GA + (size_t)2 * MROWS * 8 * 4;
constexpr size_t WS_GCUM = WS_GMX + (size_t)2 * MROWS * 8 * 4;
constexpr size_t WS_XC = WS_GCUM + (size_t)2 * MROWS * 8 * 4;
constexpr size_t WS_W1T = WS_XC + (size_t)NB * CTXL * DM * 4;
constexpr size_t WS_W2T = WS_W1T + (size_t)N1 * DM * 2;
constexpr size_t WS_WRO = WS_W2T + (size_t)N2 * DM * 2;
constexpr size_t WS_WMO = WS_WRO + (size_t)DM * DM * 2;
constexpr size_t WS_WO = WS_WMO + (size_t)DM * DM * 2;
constexpr size_t WS_WUT = WS_WO + (size_t)DM * DM * 2;
constexpr size_t WS_WDT = WS_WUT + (size_t)UPN * DM * 2;
constexpr size_t WS_H = WS_WDT + (size_t)DM * FF * 2;
constexpr size_t SLOT = (size_t)MROWS * DM * 2;
constexpr size_t WS_ARENA = WS_H + SLOT;
constexpr size_t WS_PROJ = WS_ARENA;
constexpr size_t WS_MQK = WS_PROJ + (size_t)MROWS * LDP * 2;
constexpr size_t WS_Y4 = WS_MQK + SLOT;
constexpr size_t WS_U = WS_ARENA;
constexpr size_t WS_ACT = WS_U + (size_t)MROWS * UPN * 2;
constexpr size_t WS_OUTF = WS_ARENA;
constexpr size_t WS_RAW = WS_Y4 + 4 * SLOT;
constexpr size_t WS_RAWQ = WS_RAW + (size_t)(MROWS / 256) * 4 * UPN * 2;
constexpr size_t WS_IMG = WS_RAWQ + (size_t)(MROWS / 256) * 4 * 2048 * 2;
constexpr size_t WS_SS = WS_IMG + (size_t)256 * 18 * 8 * 8192;
constexpr size_t WS_END = WS_SS + (size_t)16 * MROWS * 4;
static_assert(WS_ACT + (size_t)MROWS * FF * 2 <= WS_RAW, "ACT inside the arena");
static_assert(WS_W1T % 256 == 0 && WS_H % 256 == 0 && WS_ARENA % 256 == 0 && WS_ACT % 256 == 0, "alignment");

constexpr int NP2_OFF = 156160;
constexpr int PSUM2_OFF = 160256;
constexpr int LDS_BYTES = 162304, AUX_OFF = 131072, MISC_OFF = 139264, PBUF_OFF = 139776;

#define LAS __attribute__((address_space(3)))
typedef unsigned short bf16;
typedef short bf16x8 __attribute__((ext_vector_type(8)));
typedef short s16x4 __attribute__((ext_vector_type(4)));
typedef float f32x4 __attribute__((ext_vector_type(4)));
typedef float f32x16 __attribute__((ext_vector_type(16)));
typedef unsigned u32x4 __attribute__((ext_vector_type(4)));
typedef unsigned u32x2 __attribute__((ext_vector_type(2)));
using pg8::pk2; using pg8::bflo; using pg8::bfhi;
#define LDS_WAIT() asm volatile("s_waitcnt lgkmcnt(0)" ::: "memory")
#define VM_WAIT() asm volatile("s_waitcnt vmcnt(0)" ::: "memory")

#define XB_TMO      128
#define XB_XCNT(j)  (256  + 64 * (j))
#define XB_XSUB(j)  (1280 + 64 * (j))
#define XB_XGEN(j)  (2304 + 64 * (j))
#define XB_TOP      3328
#define XB_TOPGEN   3392
#define XCD_BAR_WORDS 3456
#define XB_SPIN_CAP (1u << 18)

__device__ __forceinline__ unsigned xb_ld(unsigned* p)              { return __hip_atomic_load(p, __ATOMIC_RELAXED, __HIP_MEMORY_SCOPE_AGENT); }
__device__ __forceinline__ unsigned xb_add(unsigned* p, unsigned v) { return __hip_atomic_fetch_add(p, v, __ATOMIC_RELAXED, __HIP_MEMORY_SCOPE_AGENT); }
__device__ __forceinline__ unsigned xb_xcc_id() { return (unsigned)__builtin_amdgcn_s_getreg((3 << 11) | 20) & 0xFu; }
#define XB_SPIN(cond, bar) do { unsigned _sp = 0; while (cond) { __builtin_amdgcn_s_sleep(1); \
    if ((++_sp & 255u) == 0u) { if (xb_ld(&(bar)[XB_TMO])) break; if (_sp > XB_SPIN_CAP) { atomicAdd(&(bar)[XB_TMO], 1u); break; } } } } while (0)

struct XcdBarrier {
    unsigned* bar; unsigned x;
    volatile LAS unsigned* st;
};

__device__ __forceinline__ XcdBarrier xcd_barrier_post(unsigned* bar, volatile LAS unsigned* st) {
    XcdBarrier b; b.bar = bar; b.x = xb_xcc_id(); b.st = st;
    if (threadIdx.x == 0) (void)xb_add(&bar[XB_XCNT(b.x)], 1u);
    return b;
}
__device__ __forceinline__ void xcd_barrier_complete(unsigned* bar, unsigned x, unsigned& nloc, unsigned& nx) {
    const unsigned G = gridDim.x * gridDim.y * gridDim.z;
    unsigned sum, cnt, mine, sp = 0u;
    for (;;) {
        sum = 0u; cnt = 0u; mine = 0u;
#pragma unroll
        for (unsigned j = 0; j < 16; ++j) { const unsigned c = xb_ld(&bar[XB_XCNT(j)]); sum += c; cnt += (c > 0u) ? 1u : 0u; mine = (j == x) ? c : mine; }
        if (sum == G) break;
        __builtin_amdgcn_s_sleep(1);
        if ((++sp & 255u) == 0u) { if (xb_ld(&bar[XB_TMO])) break; if (sp > XB_SPIN_CAP) { atomicAdd(&bar[XB_TMO], 1u); break; } }
    }
    nloc = mine > 0u ? mine : 1u; nx = cnt > 0u ? cnt : 1u;
}

__device__ __forceinline__ void xcd_barrier(const XcdBarrier& b) {
    asm volatile("s_waitcnt vmcnt(0)" ::: "memory");
    __syncthreads();
    if (threadIdx.x == 0) {
        unsigned* bar = b.bar;
        __builtin_amdgcn_s_waitcnt(0);
        unsigned nloc = b.st[0], nx = b.st[1];
        if (nloc == 0u) { xcd_barrier_complete(bar, b.x, nloc, nx); b.st[0] = nloc; b.st[1] = nx; }
        const unsigned old = xb_add(&bar[XB_XSUB(b.x)], 1u);
        const unsigned gen = old / nloc;
        if (old + 1u == (gen + 1u) * nloc) {
            __builtin_amdgcn_fence(__ATOMIC_RELEASE, "agent");
            asm volatile("s_waitcnt vmcnt(0)" ::: "memory");
            const unsigned og = xb_add(&bar[XB_TOP], 1u);
            const unsigned tg = og / nx;
            if (og + 1u == (tg + 1u) * nx) xb_add(&bar[XB_TOPGEN], 1u);
            else XB_SPIN(xb_ld(&bar[XB_TOPGEN]) == tg, bar);
            __builtin_amdgcn_fence(__ATOMIC_ACQUIRE, "agent");
            xb_add(&bar[XB_XGEN(b.x)], 1u);
            asm volatile("s_waitcnt vmcnt(0)" ::: "memory");
        } else {
            XB_SPIN(xb_ld(&bar[XB_XGEN(b.x)]) == gen, bar);
            __builtin_amdgcn_fence(__ATOMIC_ACQUIRE, "agent");
            asm volatile("s_waitcnt vmcnt(0)" ::: "memory");
        }
    }
    __syncthreads();
}

struct Ctx {
    LAS unsigned char* lds;
    int tid, lane, wave, vcu, G;
    float* out; unsigned char* ws;
    __device__ __forceinline__ const float* inp(int i) const { const float* const* ka = (const float* const*)__builtin_amdgcn_kernarg_segment_ptr(); return ka[i]; }
};
#define GAS __attribute__((address_space(1)))
template <class T> __device__ __forceinline__ const GAS T* gptr(const T* p) { return (const GAS T*)p; }
template <class T> __device__ __forceinline__ GAS T* gptr(T* p) { return (GAS T*)p; }
#define WV_DPP(old, x, ctrl) __builtin_bit_cast(float, __builtin_amdgcn_update_dpp(__builtin_bit_cast(int, (float)(old)), __builtin_bit_cast(int, (float)(x)), (ctrl), 0xf, 0xf, false))
__device__ __forceinline__ float swz_xor16(float v) { return __builtin_bit_cast(float, __builtin_amdgcn_ds_swizzle(__builtin_bit_cast(int, v), 0x401F)); }
__device__ __forceinline__ float bperm_f(float v, int src_lane) { return __builtin_bit_cast(float, __builtin_amdgcn_ds_bpermute(src_lane << 2, __builtin_bit_cast(int, v))); }
__device__ __forceinline__ float quad_sum(float v) { v += WV_DPP(0.f, v, 0xB1); v += WV_DPP(0.f, v, 0x4E); return v; }
__device__ __forceinline__ float wave_sum(float v) {
    v = quad_sum(v); v += WV_DPP(0.f, v, 0x141); v += WV_DPP(0.f, v, 0x140);
    v += swz_xor16(v);
    return __builtin_bit_cast(float, __builtin_amdgcn_readlane(__builtin_bit_cast(int, v), 0)) + __builtin_bit_cast(float, __builtin_amdgcn_readlane(__builtin_bit_cast(int, v), 32));
}
__device__ __forceinline__ float silu_f(float x) { return x * __builtin_amdgcn_rcpf(1.0f + __expf(-x)); }
__device__ __forceinline__ float sigmoid_f(float x) { return __builtin_amdgcn_rcpf(1.0f + __expf(-x)); }

__device__ __forceinline__ void mod_phase(const Ctx& C, int l0, int nl, int start, int stride) {
    LAS float* SC = (LAS float*)C.lds;
    LAS float* RED = (LAS float*)(C.lds + 73728);
    const float* cin = C.inp(1); const float* cctx = C.inp(3); const float* w_ada = C.inp(4); const float* b_ada = C.inp(5);
    float* MOD = (float*)(C.ws + WS_MOD);
    for (int e = C.tid; e < 9 * DM; e += NTHR) { const float v = e < 8 * DM ? cin[e] : cctx[e - 8 * DM]; SC[e] = silu_f(v); }
    __syncthreads();
    for (int it = start; it < nl * 192; it += stride) {
        const int l = l0 + it / 192, cg = it % 192, col = cg * 64 + C.lane;
        const float* wp = w_ada + ((size_t)l * DM + C.wave * 256) * MODW + col;
        float acc[9];
#pragma unroll
        for (int b = 0; b < 9; ++b) acc[b] = 0.f;
        for (int k0 = 0; k0 < 256; k0 += 16) {
            float wv[16];
#pragma unroll
            for (int j = 0; j < 16; ++j) wv[j] = __builtin_nontemporal_load(wp + (size_t)(k0 + j) * MODW);
#pragma unroll
            for (int j = 0; j < 16; ++j) { const int k = C.wave * 256 + k0 + j;
#pragma unroll
                for (int b = 0; b < 9; ++b) acc[b] += SC[b * DM + k] * wv[j]; }
        }
#pragma unroll
        for (int b = 0; b < 9; ++b) RED[(C.wave * 9 + b) * 64 + C.lane] = acc[b];
        __syncthreads();
        for (int e = C.tid; e < 576; e += NTHR) { const int b = e >> 6, ln = e & 63; float s = 0.f;
#pragma unroll
            for (int w = 0; w < 8; ++w) s += RED[(w * 9 + b) * 64 + ln];
            MOD[((size_t)l * 9 + b) * MODW + cg * 64 + ln] = s + b_ada[(size_t)l * MODW + cg * 64 + ln]; }
        __syncthreads();
    }
}
__device__ __forceinline__ void rope_table(const Ctx& C) {
    const int gt = C.vcu * NTHR + C.tid;
    if (gt < 2048) {
        const int pos = gt >> 5, p = gt & 31;
        double f = 1.0; const double f1 = 0.74989420933245582;
        for (int i = 0; i < p; ++i) f *= f1;
        const double x = (double)pos * f;
        const double kq = __builtin_rint(x * 0.63661977236758134308);
        const double rr = (x - kq * 1.57079632679489655800) - kq * 6.12323399573676603587e-17;
        const double r2 = rr * rr;
        double sn = rr * (1.0 + r2 * (-1.0 / 6 + r2 * (1.0 / 120 + r2 * (-1.0 / 5040 + r2 * (1.0 / 362880 + r2 * (-1.0 / 39916800 + r2 * (1.0 / 6227020800.0)))))));
        double cs = 1.0 + r2 * (-0.5 + r2 * (1.0 / 24 + r2 * (-1.0 / 720 + r2 * (1.0 / 40320 + r2 * (-1.0 / 3628800 + r2 * (1.0 / 479001600.0 + r2 * (-1.0 / 87178291200.0)))))));
        const int q = ((int)kq) & 3;
        const double s_out = (q == 0) ? sn : (q == 1) ? cs : (q == 2) ? -sn : -cs;
        const double c_out = (q == 0) ? cs : (q == 1) ? -sn : (q == 2) ? -cs : sn;
        float* T = (float*)(C.ws + WS_ROPE);
        T[gt] = (float)c_out; T[2048 + gt] = (float)s_out;
    }
}
__device__ __forceinline__ int w1_src(int n) {
    if (n < 2048) { const int base = n < 1024 ? 0 : 1024, nn = n & 1023, head = nn >> 7, j = nn & 127, blk = j >> 6, jj = j & 63; return base + head * 128 + blk * 64 + (jj & 1) * 32 + (jj >> 1); }
    if (n < 4096) return 2048 + (n - 2048);
    if (n < 5120) return 6144 + (n - 4096);
    if (n < 6144) return 7168 + (n - 5120);
    if (n < 8192) return 8192 + (n - 6144);
    if (n < 8224) return 12288 + (n - 8192);
    return -1;
}
__device__ __forceinline__ int w2_src(int n) {
    if (n < 2048) return 4096 + n;
    if (n < 4096) return 10240 + (n - 2048);
    return 12320 + (n - 4096);
}
__device__ __forceinline__ void tr_item(const float* W, int K, int N, bf16* WT, int mode, LAS float* scr, int item, int nblk, int lane) {
    const int kb = item / nblk, nb = item % nblk, k0 = 128 * kb, n0 = 32 * nb;
    const int nd = n0 + (lane & 31);
    const int sc = mode == 1 ? w1_src(nd) : (mode == 2 ? w2_src(nd) : (mode == 3 ? ((nd & 128) ? FF + 128 * (nd >> 8) + (nd & 127) : 128 * (nd >> 8) + (nd & 127)) : nd));
    float wv[64];
    { const float* wp = W + (size_t)(k0 + (lane >> 5)) * N + (sc >= 0 ? sc : 0);
#pragma unroll
      for (int i = 0; i < 64; ++i) wv[i] = __builtin_nontemporal_load(gptr(wp + (size_t)(2 * i) * N)); }
#pragma unroll
    for (int i = 0; i < 64; ++i) { const int kk = 2 * i + (lane >> 5); scr[kk * 33 + (lane & 31)] = sc >= 0 ? wv[i] : 0.f; }
    LDS_WAIT(); asm volatile("" ::: "memory");
    const int c = lane & 15;
#pragma unroll
    for (int j = 0; j < 8; ++j) { const int n = (lane >> 4) + 4 * j; const LAS float* s = scr + (8 * c) * 33 + n;
        u32x4 o; o.x = pk2(s[0 * 33], s[1 * 33]); o.y = pk2(s[2 * 33], s[3 * 33]); o.z = pk2(s[4 * 33], s[5 * 33]); o.w = pk2(s[6 * 33], s[7 * 33]);
        *(u32x4*)(WT + (size_t)(n0 + n) * K + k0 + 8 * c) = o; }
    LDS_WAIT(); asm volatile("" ::: "memory");
}
constexpr int CV_I0 = 16 * 264, CV_I1 = CV_I0 + 16 * 256, CV_I2 = CV_I1 + 1024, CV_I3 = CV_I2 + 1024, CV_I4 = CV_I3 + 1024, CV_I5 = CV_I4 + 16 * 352, CV_I6 = CV_I5 + 44 * 64;
__device__ __forceinline__ void convert_weights(const Ctx& C, int l, int lo, int hi, int iw, int nw) {
    LAS float* scr = (LAS float*)(C.lds + C.wave * 17408);
    if (iw < 0) return;
    const float* w_in = C.inp(7) + (size_t)l * DM * INC;
    const float* w_ro = C.inp(13) + (size_t)l * DM * DM; const float* w_mo = C.inp(14) + (size_t)l * DM * DM; const float* w_o = C.inp(15) + (size_t)l * DM * DM;
    const float* w_up = C.inp(16) + (size_t)l * DM * UPN; const float* w_dn = C.inp(19) + (size_t)l * FF * DM;
    constexpr int I0 = CV_I0, I1 = CV_I1, I2 = CV_I2, I3 = CV_I3, I4 = CV_I4, I5 = CV_I5;
    for (int it = lo + iw; it < hi; it += nw) {
        if (it < I0) tr_item(w_in, DM, INC, (bf16*)(C.ws + WS_W1T), 1, scr, it, 264, C.lane);
        else if (it < I1) tr_item(w_in, DM, INC, (bf16*)(C.ws + WS_W2T), 2, scr, it - I0, 256, C.lane);
        else if (it < I2) tr_item(w_ro, DM, DM, (bf16*)(C.ws + WS_WRO), 0, scr, it - I1, 64, C.lane);
        else if (it < I3) tr_item(w_mo, DM, DM, (bf16*)(C.ws + WS_WMO), 0, scr, it - I2, 64, C.lane);
        else if (it < I4) tr_item(w_o, DM, DM, (bf16*)(C.ws + WS_WO), 0, scr, it - I3, 64, C.lane);
        else if (it < I5) tr_item(w_up, DM, UPN, (bf16*)(C.ws + WS_WUT), 3, scr, it - I4, 352, C.lane);
        else tr_item(w_dn, FF, DM, (bf16*)(C.ws + WS_WDT), 0, scr, it - I5, 64, C.lane);
    }
}
__device__ __forceinline__ void wait_count(const Ctx& C, unsigned* p, unsigned tgt) {
    if (C.tid == 0) { unsigned sp = 0u; while (xb_ld(p) < tgt) { __builtin_amdgcn_s_sleep(2); if (++sp > (1u << 22)) break; }
        __builtin_amdgcn_fence(__ATOMIC_ACQUIRE, "agent"); asm volatile("s_waitcnt vmcnt(0)" ::: "memory"); }
    __syncthreads();
}
template <bool UPD, bool MKH>
__device__ __forceinline__ void rn_phase(const Ctx& C, int skip_ctx, const float* xin_lat, const float* xin_ctx, float* xout_lat, float* xout_ctx, const bf16* OUT,
                                         const float* modu, int g_idx, const float* nw_post, const float* modh, int sh_idx, int sc_idx, const float* nw_pre, bf16* Hout,
                                         unsigned* cnt_lat = nullptr, unsigned tgt_lat = 0, unsigned* cnt_ctx = nullptr, unsigned tgt_ctx = 0) {
    LAS float* TAB = (LAS float*)C.lds;
    const int b = C.vcu >> 5, cl = C.vcu & 31;
    __syncthreads();
#pragma unroll
    for (int k = 0; k < 2; ++k) { const int idx = C.tid + NTHR * k, set = idx >> 9, col = (idx & 511) * 4, mi = set ? NB : b;
        if (UPD) { const f32x4 g = *(const f32x4*)(modu + (size_t)mi * MODW + g_idx * DM + col), nw = *(const f32x4*)(nw_post + col); *(LAS f32x4*)(TAB + (set * 3 + 0) * DM + col) = g * nw; }
        if (MKH) { const f32x4 nw = *(const f32x4*)(nw_pre + col), sh = *(const f32x4*)(modh + (size_t)mi * MODW + sh_idx * DM + col), sc = *(const f32x4*)(modh + (size_t)mi * MODW + sc_idx * DM + col);
            *(LAS f32x4*)(TAB + (set * 3 + 1) * DM + col) = nw * (sc + 1.0f); *(LAS f32x4*)(TAB + (set * 3 + 2) * DM + col) = sh; } }
    __syncthreads();
    auto run = [&](const bool isctx, const int t0, const int ts, const int n) {
        auto row_of = [&](int i, size_t& xoff) { const int t = t0 + i * ts; xoff = isctx ? ((size_t)b * CTXL + t) * DM : ((size_t)b * SEQ + t) * DM; return b * TT + (isctx ? t : CTXL + t); };
        auto load_row = [&](int i, f32x4 (&xv)[8], u32x2 (&ow)[8]) { size_t xo_; const int r = row_of(i, xo_); const float* xi = (isctx ? xin_ctx : xin_lat) + xo_;
#pragma unroll
            for (int j = 0; j < 8; ++j) { xv[j] = __builtin_nontemporal_load(gptr((const f32x4*)(xi + 4 * C.lane + 256 * j))); if (UPD) ow[j] = __builtin_nontemporal_load(gptr((const u32x2*)(OUT + (size_t)r * DM + 4 * C.lane + 256 * j))); } };
        auto process = [&](int i, f32x4 (&xv)[8], u32x2 (&ow)[8]) {
            size_t xoff; const int r = row_of(i, xoff);
            LAS const float* tb = TAB + (isctx ? 3 * DM : 0) + 4 * C.lane;
            if (UPD) {
                f32x4 ov[8]; float ss = 0.f;
#pragma unroll
                for (int j = 0; j < 8; ++j) { const u32x2 w = ow[j];
                    ov[j] = (f32x4){bflo(w.x), bfhi(w.x), bflo(w.y), bfhi(w.y)}; ss += (ov[j][0] * ov[j][0] + ov[j][1] * ov[j][1]) + (ov[j][2] * ov[j][2] + ov[j][3] * ov[j][3]); }
                const float r1 = __builtin_amdgcn_rsqf(wave_sum(ss) * (1.0f / DM) + EPSN);
                float* xo = (isctx ? xout_ctx : xout_lat) + xoff;
#pragma unroll
                for (int j = 0; j < 8; ++j) { const int col = 4 * C.lane + 256 * j; const f32x4 gn = *(LAS const f32x4*)(tb + 256 * j);
                    xv[j] = xv[j] + gn * (ov[j] * r1); __builtin_nontemporal_store(xv[j], gptr((f32x4*)(xo + col))); }
            }
            if (MKH) {
                float ss = 0.f;
#pragma unroll
                for (int j = 0; j < 8; ++j) ss += (xv[j][0] * xv[j][0] + xv[j][1] * xv[j][1]) + (xv[j][2] * xv[j][2] + xv[j][3] * xv[j][3]);
                const float r2 = __builtin_amdgcn_rsqf(wave_sum(ss) * (1.0f / DM) + EPSN);
#pragma unroll
                for (int j = 0; j < 8; ++j) { const int col = 4 * C.lane + 256 * j; const f32x4 aw = *(LAS const f32x4*)(tb + DM + 256 * j), sh = *(LAS const f32x4*)(tb + 2 * DM + 256 * j);
                    const f32x4 hv = (xv[j] * r2) * aw + sh;
                    u32x2 w; w.x = pk2(hv[0], hv[1]); w.y = pk2(hv[2], hv[3]); *gptr((u32x2*)(Hout + (size_t)r * DM + col)) = w; }
            } };
        f32x4 xa[8], xb[8]; u32x2 oa[8], ob[8];
        load_row(0, xa, oa);
#pragma unroll 1
        for (int i = 0; i + 1 < n; i += 2) {
            load_row(i + 1, xb, ob); __builtin_amdgcn_sched_barrier(0); process(i, xa, oa); __builtin_amdgcn_sched_barrier(0);
            load_row(i + 2 < n ? i + 2 : n - 1, xa, oa); __builtin_amdgcn_sched_barrier(0); process(i + 1, xb, ob); __builtin_amdgcn_sched_barrier(0);
        }
        if (n & 1) process(n - 1, xa, oa);
    };
    if (cnt_lat == nullptr) {
        run(false, cl * 8 + C.wave, 256, 16);
        if (!skip_ctx) run(true, cl * 8 + C.wave, 0, 1);
    } else {
        unsigned* const wp = cl < 8 ? cnt_ctx : cnt_lat; const unsigned tgt = cl < 8 ? tgt_ctx : tgt_lat;
        if (C.tid == 0) { unsigned sp = 0u; while (xb_ld(wp) < tgt) { __builtin_amdgcn_s_sleep(2); if (++sp > (1u << 22)) break; }
            __builtin_amdgcn_fence(__ATOMIC_ACQUIRE, "agent"); asm volatile("s_waitcnt vmcnt(0)" ::: "memory"); }
        __syncthreads();
        if (cl < 8) run(true, cl * 8 + C.wave, 64, 4);
        else { const int t0 = (cl - 8) * 8 + C.wave; run(false, t0, 192, t0 < 64 ? 22 : 21); }
    }
}
__device__ __forceinline__ float wave_scan_add(float v, int lane) {
#pragma unroll
    for (int o = 1; o < 64; o <<= 1) { const float t = bperm_f(v, lane - o); if (lane >= o) v += t; }
    return v;
}
__device__ __forceinline__ float wave_scan_max(float v, int lane) {
#pragma unroll
    for (int o = 1; o < 64; o <<= 1) { const float t = bperm_f(v, lane - o); if (lane >= o) v = fmaxf(v, t); }
    return v;
}
__device__ __forceinline__ void conv_gate_phase(const Ctx& C, int l) {
    bf16* MQK = (bf16*)(C.ws + WS_MQK);
    const float* cw = C.inp(8) + (size_t)l * 3 * 2048; const float* cb = C.inp(9) + (size_t)l * 2048;
    {
        const bf16* RAWQ = (const bf16*)(C.ws + WS_RAWQ);
        const int gt = C.vcu * NTHR + C.tid, NT = C.G * NTHR;
        for (int idx = gt; idx < (MROWS / 256) * 2 * 256; idx += NT) {
            const int pm = idx >> 9, k = (idx >> 8) & 1, cg = idx & 255, j = pm % 17;
            if (j == 0 || (k == 0 && j == 1) || (k == 1 && j == 16)) continue;
            const bf16* P = k == 0 ? RAWQ + ((size_t)(pm - 1) * 4 + 3) * 2048 : RAWQ + ((size_t)pm * 4 + 2) * 2048;
            const bf16* Cc = k == 0 ? RAWQ + ((size_t)pm * 4 + 0) * 2048 : RAWQ + ((size_t)pm * 4 + 3) * 2048;
            const bf16* Nn = k == 0 ? RAWQ + ((size_t)pm * 4 + 1) * 2048 : RAWQ + ((size_t)(pm + 1) * 4 + 0) * 2048;
            const u32x4 xp = *(const u32x4*)(P + cg * 8), xc = *(const u32x4*)(Cc + cg * 8), xn = *(const u32x4*)(Nn + cg * 8);
            const unsigned pw[4] = {xp.x, xp.y, xp.z, xp.w}, cwd[4] = {xc.x, xc.y, xc.z, xc.w}, nwd[4] = {xn.x, xn.y, xn.z, xn.w};
            const float scl = cg < 128 ? QSCALE : 1.0f; float o[8];
#pragma unroll
            for (int q = 0; q < 4; ++q) { const int c0 = cg * 8 + 2 * q, c1 = c0 + 1;
                o[2 * q] = silu_f(cb[c0] + cw[c0] * bflo(pw[q]) + cw[2048 + c0] * bflo(cwd[q]) + cw[4096 + c0] * bflo(nwd[q])) * scl;
                o[2 * q + 1] = silu_f(cb[c1] + cw[c1] * bfhi(pw[q]) + cw[2048 + c1] * bfhi(cwd[q]) + cw[4096 + c1] * bfhi(nwd[q])) * scl; }
            u32x4 w; w.x = pk2(o[0], o[1]); w.y = pk2(o[2], o[3]); w.z = pk2(o[4], o[5]); w.w = pk2(o[6], o[7]);
            *(u32x4*)(MQK + ((size_t)pm * 256 + (k ? 255 : 0)) * DM + cg * 8) = w;
        }
    }
    {
        const float* GATES = (const float*)(C.ws + WS_GATES);
        float* GA = (float*)(C.ws + WS_GA); float* GMX = (float*)(C.ws + WS_GMX); float* GCUM = (float*)(C.ws + WS_GCUM);
        const int gw = C.vcu * NWAVES + C.wave, NGW = C.G * NWAVES;
        for (int it = gw; it < NB * 2 * NH * NCH; it += NGW) {
            const int ch = it % NCH, hh = (it / NCH) % NH, dir = (it / (NCH * NH)) & 1, b = it / (NCH * NH * 2);
            const int s0 = 2 * C.lane, s1 = s0 + 1, i0 = dir ? 127 - s0 : s0, i1 = dir ? 127 - s1 : s1;
            const size_t r0 = (size_t)b * TT + ch * 128 + i0, r1 = (size_t)b * TT + ch * 128 + i1;
            const float ig0 = GATES[r0 * 32 + dir * 16 + hh], fg0 = GATES[r0 * 32 + dir * 16 + 8 + hh];
            const float ig1 = GATES[r1 * 32 + dir * 16 + hh], fg1 = GATES[r1 * 32 + dir * 16 + 8 + hh];
            const float lf0 = fminf(fg0, 0.f) - __logf(1.0f + __expf(-fabsf(fg0))), lf1 = fminf(fg1, 0.f) - __logf(1.0f + __expf(-fabsf(fg1)));
            const float c1 = lf0 + lf1; const float incl = wave_scan_add(c1, C.lane); const float off = incl - c1;
            const float cum0 = off + lf0, cum1 = off + c1;
            const float a0 = ig0 - cum0, a1 = ig1 - cum1;
            const float m1 = fmaxf(a0, a1); const float mincl = wave_scan_max(m1, C.lane);
            float mprev = bperm_f(mincl, C.lane - 1); const float mx0 = C.lane == 0 ? a0 : fmaxf(mprev, a0); const float mx1 = mincl;
            const size_t o0 = ((size_t)dir * MROWS + r0) * 8 + hh, o1 = ((size_t)dir * MROWS + r1) * 8 + hh;
            GA[o0] = a0; GA[o1] = a1; GMX[o0] = mx0; GMX[o1] = mx1; GCUM[o0] = cum0; GCUM[o1] = cum1;
        }
    }
}
__device__ __forceinline__ unsigned off_b(unsigned row, unsigned ch) { return 256u * row + 16u * (ch ^ (((row & 3u) << 2) | ((row >> 2) & 3u))); }
__device__ __forceinline__ unsigned tr_addr(unsigned lane, unsigned c, unsigned ks, unsigned t) {
    const unsigned h = lane >> 5, blk = (lane >> 4) & 1u, q = (lane & 15u) >> 2, p = lane & 3u;
    return off_b(16u * ks + 8u * h + 4u * t + q, 4u * c + 2u * blk + (p >> 1)) + 8u * (p & 1u);
}
__device__ __forceinline__ bf16x8 tr_frag(LAS unsigned char* tile, unsigned lane, unsigned c, unsigned ks) {
    const s16x4 lo = __builtin_amdgcn_ds_read_tr16_b64_v4i16((LAS s16x4*)(tile + tr_addr(lane, c, ks, 0)));
    const s16x4 hi = __builtin_amdgcn_ds_read_tr16_b64_v4i16((LAS s16x4*)(tile + tr_addr(lane, c, ks, 1)));
    return __builtin_shufflevector(lo, hi, 0, 1, 2, 3, 4, 5, 6, 7);
}
__device__ __forceinline__ bf16x8 tr_frag2(LAS unsigned char* a0, LAS unsigned char* a1) {
    const s16x4 lo = __builtin_amdgcn_ds_read_tr16_b64_v4i16((LAS s16x4*)a0);
    const s16x4 hi = __builtin_amdgcn_ds_read_tr16_b64_v4i16((LAS s16x4*)a1);
    return __builtin_shufflevector(lo, hi, 0, 1, 2, 3, 4, 5, 6, 7);
}
__device__ __forceinline__ void stage_tile(LAS unsigned char* tile, const bf16* g, int ld, int wave, int lane) {
    const char* gb = (const char*)g;
#pragma unroll
    for (int i = 0; i < 4; ++i) {
        const unsigned o = (unsigned)(wave * 4 + i) * 1024u + (unsigned)lane * 16u;
        const unsigned row = o >> 8, chs = (o >> 4) & 15u, ch = chs ^ (((row & 3u) << 2) | ((row >> 2) & 3u));
        const unsigned voff = (row * (unsigned)ld + ch * 8u) * 2u;
        __builtin_amdgcn_global_load_lds((const unsigned*)(gb + voff), (LAS unsigned*)(tile + (wave * 4 + i) * 1024), 16, 0, 0);
    }
}
#define SC_DPP(v, ctrl) __builtin_bit_cast(float, __builtin_amdgcn_update_dpp(0, __builtin_bit_cast(int, (float)(v)), (ctrl), 0xf, 0xf, false))
__device__ __forceinline__ void emit_q(const f32x16& Yq, int q, LAS float* PSUMh, LAS float* PSUMh2, int wave, int lane, int r, int h, char* YNrow, int hf) {
#pragma unroll
    for (int g = 0; g < 4; ++g) { f32x4 s4;
#pragma unroll
        for (int e = 0; e < 4; ++e) { const float y = Yq[4 * g + e];
            const unsigned voff = (unsigned)(64 * hf + 32 * q + 8 * g + 4 * h + e) * (unsigned)(DM * 2) + (unsigned)r * 2u;
            const unsigned yb = pk2(y, 0.f) & 0xffffu; *(bf16*)(YNrow + voff) = (bf16)yb;
            float v = y * y;
            v += SC_DPP(v, 0xB1); v += SC_DPP(v, 0x4E); v += SC_DPP(v, 0x141); v += SC_DPP(v, 0x140);
            s4[e] = v; }
        if ((lane & 15) == 0) *(LAS f32x4*)(((lane & 16) ? PSUMh2 : PSUMh) + wave * 64 + 32 * q + 8 * g + 4 * h) = s4; }
}
__device__ __forceinline__ void reduce_ss(const LAS float* PSUMh, const LAS float* PSUMh2, int tid, float* SSrow) {
    if (tid < 64) { float s = 0.f;
#pragma unroll
        for (int w = 0; w < 8; ++w) s += PSUMh[w * 64 + tid] + PSUMh2[w * 64 + tid];
        SSrow[tid] = s; }
}
__device__ __forceinline__ void add_image(f32x16& y, const u32x4 a, const u32x4 b) {
    y[0] += bflo(a.x); y[1] += bfhi(a.x); y[2] += bflo(a.y); y[3] += bfhi(a.y); y[4] += bflo(a.z); y[5] += bfhi(a.z); y[6] += bflo(a.w); y[7] += bfhi(a.w);
    y[8] += bflo(b.x); y[9] += bfhi(b.x); y[10] += bflo(b.y); y[11] += bfhi(b.y); y[12] += bflo(b.z); y[13] += bfhi(b.z); y[14] += bflo(b.w); y[15] += bfhi(b.w);
}
constexpr int NSPLIT = NCH / 2 + 1;
#define MFMA32(a, b, c) __builtin_amdgcn_mfma_f32_32x32x16_bf16((a), (b), (c), 0, 0, 0)
__device__ __forceinline__ void scan_phase(const Ctx& C, int l, const XcdBarrier& bar) {
    LAS unsigned char* LQ = C.lds; LAS unsigned char* LK = C.lds + 32768; LAS unsigned char* LV = C.lds + 65536; LAS unsigned char* LP = C.lds + PBUF_OFF;
    LAS float* AUX = (LAS float*)(C.lds + AUX_OFF);
    LAS float* CJ = AUX; LAS float* RI = AUX + 128; LAS float* RS = AUX + 256; LAS float* WW = AUX + 384; LAS float* EMT = AUX + 512; LAS float* INV = AUX + 640;
    LAS float* QN = AUX + 768; LAS float* NV = AUX + 896; LAS float* RSUM = AUX + 1024; LAS float* NP2 = (LAS float*)(C.lds + NP2_OFF);
    const int tid_ = C.tid, lane_ = C.lane, wave = C.wave, r_ = lane_ & 31, h_ = lane_ >> 5;
    const bf16* PROJ = (const bf16*)(C.ws + WS_PROJ); const bf16* MQK = (const bf16*)(C.ws + WS_MQK);
    const float* GA = (const float*)(C.ws + WS_GA); const float* GMX = (const float*)(C.ws + WS_GMX); const float* GCUM = (const float*)(C.ws + WS_GCUM);
    const float* decay_exp = C.inp(11) + (size_t)l * 16;
    for (int u = C.vcu; u < 256; u += C.G) {
        const int dir = u & 1, br = (u >> 1) & 1, hh = (u >> 2) & 7, b = u >> 5;
        const bf16* Qg = br ? MQK + hh * 128 : PROJ + hh * 128;
        const bf16* Kg = br ? MQK + 1024 + hh * 128 : PROJ + 1024 + hh * 128;
        const bf16* Vg = br ? PROJ + 6144 + hh * 256 : PROJ + 2048 + hh * 256;
        const int ldq = br ? DM : LDP;
        char* const Yob = (char*)(C.ws + WS_Y4 + (size_t)(br * 2) * SLOT) + (hh * 256 + wave * 32) * 2;
        LAS float* PSUMh = AUX + 1536; LAS float* PSUMh2 = (LAS float*)(C.lds + PSUM2_OFF);
        float* const SSh = (float*)(C.ws + WS_SS) + (size_t)(br * 8 + hh) * MROWS;
        f32x16 S[4];
#pragma unroll
        for (int t = 0; t < 4; ++t)
#pragma unroll
            for (int e = 0; e < 16; ++e) S[t][e] = 0.f;
        float dec = 1.f, m = 0.f, m_next = 0.f;
        __syncthreads();
        int tidp = tid_; asm volatile("" : "+v"(tidp));
        if (br == 0) {
            const float lg2 = __log2f(1.0f - exp2f(-decay_exp[dir * 8 + hh]));
            dec = exp2f(128.f * lg2);
            if (tidp < 128) { const float i = (float)tidp;
                if (dir == 0) { CJ[tidp] = -i * lg2; RI[tidp] = -i * lg2; RS[tidp] = exp2f((i + 1.f) * lg2); WW[tidp] = exp2f((127.f - i) * lg2); }
                else { CJ[tidp] = i * lg2; RI[tidp] = i * lg2; RS[tidp] = exp2f((128.f - i) * lg2); WW[tidp] = exp2f(i * lg2); } }
        } else if (tidp < 128) NV[tidp] = 0.f;
        float pf_a = 0.f, pf_mx = 0.f, pf_cum = 0.f, pf_mxl = 0.f, pf_total = 0.f;
        if (br == 1) { const int ch0 = dir == 0 ? 0 : 1; const size_t rown = (size_t)b * TT + ch0 * 128;
            const size_t gl = ((size_t)dir * MROWS + rown + (dir == 0 ? 127 : 0)) * 8 + hh; pf_mxl = GMX[gl]; pf_total = GCUM[gl];
            if (tidp < 128) { const size_t gi = ((size_t)dir * MROWS + rown + tidp) * 8 + hh; pf_a = GA[gi]; pf_mx = GMX[gi]; pf_cum = GCUM[gi]; } }
        for (int n = 0; n < NCH; ++n) {
            int tid = tid_;
            asm volatile("" : "+v"(tid));
            const int lane = tid & 63, r = tid & 31, h = (tid >> 5) & 1;
            if (n == NSPLIT) { XcdBarrier b2_ = bar; asm volatile("" : "+s"(b2_.bar), "+s"(b2_.x)); xcd_barrier(b2_); }
            const int ch = dir == 0 ? n : (n < 2 ? 1 - n : NCH + 1 - n);
            const unsigned sw16 = (unsigned)((((r & 3) << 2) | ((r >> 2) & 3)) << 4), rb = 256u * (unsigned)r, rb8h = rb + 8u * (unsigned)h, swh16 = sw16 ^ (16u * (unsigned)h);
            const unsigned tq = ((unsigned)lane & 15u) >> 2, tp = (unsigned)lane & 3u, tblk = ((unsigned)lane >> 4) & 1u, tx = 2u * tblk + (tp >> 1);
            const unsigned tb0 = 256u * (8u * h + tq) + 8u * (tp & 1u), tb1 = tb0 + 1024u;
            const unsigned txs0 = 16u * (tx ^ (4u * tq + 2u * h)), txs1 = 16u * (tx ^ (4u * tq + 2u * h + 1u));
            const size_t row0 = (size_t)b * TT + ch * 128;
            char* const IMGs = (char*)(C.ws + WS_IMG) + ((size_t)u * NSPLIT * 8 + wave) * 8192 + lane * 128; const char* const IMGq = (const char*)(C.ws + WS_IMG) + ((size_t)(u ^ 1) * NSPLIT * 8 + wave) * 8192 + lane * 128;
            char* const Yrow = Yob + row0 * (size_t)(DM * 2);
            if (br == 1) {
                const float mml = fmaxf(m, pf_mxl); dec = __expf(m - mml); m_next = pf_total + mml;
                if (tid < 128) { const float mm = fmaxf(m, pf_mx);
                    CJ[tid] = pf_a * LOG2E; RI[tid] = mm * LOG2E; RS[tid] = __expf(m - mm); WW[tid] = __expf(pf_a - mml); EMT[tid] = __expf(-(pf_cum + mm)); }
            }
            stage_tile(LQ, Qg + row0 * ldq, ldq, wave, lane); stage_tile(LK, Kg + row0 * ldq, ldq, wave, lane);
            stage_tile(LV, Vg + row0 * LDP, LDP, wave, lane); stage_tile(LV + 32768, Vg + row0 * LDP + 128, LDP, wave, lane);
            asm volatile("s_waitcnt vmcnt(8)" ::: "memory"); LDS_WAIT(); __builtin_amdgcn_s_barrier(); asm volatile("" ::: "memory");
            if (br == 1 && n + 1 < NCH) {
                const int chn = dir == 0 ? n + 1 : (n + 1 < 2 ? 1 - (n + 1) : NCH + 1 - (n + 1)); const size_t rown = (size_t)b * TT + chn * 128;
                const size_t gl = ((size_t)dir * MROWS + rown + (dir == 0 ? 127 : 0)) * 8 + hh; pf_mxl = GMX[gl]; pf_total = GCUM[gl];
                if (tid < 128) { const size_t gi = ((size_t)dir * MROWS + rown + tid) * 8 + hh; pf_a = GA[gi]; pf_mx = GMX[gi]; pf_cum = GCUM[gi]; } }
            if (br == 1) {
                const int i = tid >> 2, part = tid & 3; float s = 0.f;
#pragma unroll
                for (int c = 0; c < 4; ++c) { const u32x4 qw = *(const LAS u32x4*)(LQ + off_b(i, 4 * part + c)); const LAS float* nv = NV + 32 * part + 8 * c;
                    s += bflo(qw.x) * nv[0] + bfhi(qw.x) * nv[1] + bflo(qw.y) * nv[2] + bfhi(qw.y) * nv[3] + bflo(qw.z) * nv[4] + bfhi(qw.z) * nv[5] + bflo(qw.w) * nv[6] + bfhi(qw.w) * nv[7]; }
                s = quad_sum(s);
                if (part == 0) QN[i] = s;
            }
            LAS unsigned char* const vb0 = LV + (wave >> 2) * 32768 + tb0 + ((unsigned)(64 * (wave & 3)) ^ txs0); LAS unsigned char* const vb1 = LV + (wave >> 2) * 32768 + tb1 + ((unsigned)(64 * (wave & 3)) ^ txs1);
#pragma unroll
            for (int hf = 0; hf < 2; ++hf) {
                const int jb = wave >> 1, ibp = 2 * hf + (wave & 1);
                f32x16 PT;
#pragma unroll
                for (int e = 0; e < 16; ++e) PT[e] = 0.f;
#pragma unroll
                for (int s = 0; s < 8; ++s) {
                    const bf16x8 ka = *(const LAS bf16x8*)(LK + 8192 * jb + rb + ((unsigned)(32 * s) ^ swh16));
                    const bf16x8 qb = *(const LAS bf16x8*)(LQ + 8192 * ibp + rb + ((unsigned)(32 * s) ^ swh16));
                    PT = MFMA32(ka, qb, PT);
                }
                { const int i = 32 * ibp + r; const float ri = RI[i]; float rsum = 0.f;
#pragma unroll
                  for (int g = 0; g < 4; ++g) { const f32x4 cj4 = *(const LAS f32x4*)(CJ + 32 * jb + 8 * g + 4 * h);
#pragma unroll
                      for (int e = 0; e < 4; ++e) { const int j = 32 * jb + 8 * g + 4 * h + e; const bool ok = dir == 0 ? (j <= i) : (j >= i);
                          const float f = ok ? __builtin_amdgcn_exp2f(cj4[e] - ri) : 0.f; const float pv = PT[4 * g + e] * f; PT[4 * g + e] = pv; rsum += pv; } }
                  if (br == 1) { rsum += bperm_f(rsum, lane ^ 32); if (h == 0) RSUM[jb * 128 + i] = rsum; } }
                if (hf == 0) VM_WAIT();
                __syncthreads();
                if (hf == 1 && n >= NSPLIT) reduce_ss(PSUMh, PSUMh2, tid, SSh + row0 + 0);
#pragma unroll
                for (int g = 0; g < 4; ++g) { u32x2 w; w.x = pk2(PT[4 * g], PT[4 * g + 1]); w.y = pk2(PT[4 * g + 2], PT[4 * g + 3]);
                    *(LAS u32x2*)(LP + 8192 * (wave & 1) + rb8h + ((unsigned)(64 * jb + 16 * g) ^ sw16)) = w; }
                if (br == 1 && tid < 64) { const int i = 64 * hf + tid; const float den = (RSUM[i] + RSUM[128 + i]) + (RSUM[256 + i] + RSUM[384 + i]) + RS[i] * QN[i]; INV[i] = 1.0f / fmaxf(fabsf(den), EMT[i]); }
                __syncthreads();
                {
                    u32x4 pw[2][2];
                    if (n >= NSPLIT) { const char* pp = IMGq + (size_t)(NCH + 1 - n) * 8 * 8192 + (2 * hf) * 32;
                        pw[0][0] = *(const u32x4*)pp; pw[0][1] = *(const u32x4*)(pp + 16); pw[1][0] = *(const u32x4*)(pp + 32); pw[1][1] = *(const u32x4*)(pp + 48); }
#pragma unroll
                    for (int q = 0; q < 2; ++q) {
                        const int ib = 2 * hf + q;
                        f32x16 Y;
#pragma unroll
                        for (int e = 0; e < 16; ++e) Y[e] = 0.f;
#pragma unroll
                        for (int t = 0; t < 4; ++t)
#pragma unroll
                            for (int s = 0; s < 2; ++s) {
                                u32x4 sw_; sw_.x = pk2(S[t][8 * s], S[t][8 * s + 1]); sw_.y = pk2(S[t][8 * s + 2], S[t][8 * s + 3]); sw_.z = pk2(S[t][8 * s + 4], S[t][8 * s + 5]); sw_.w = pk2(S[t][8 * s + 6], S[t][8 * s + 7]);
                                const bf16x8 bs = __builtin_bit_cast(bf16x8, sw_);
                                const s16x4 a0 = *(const LAS s16x4*)(LQ + 8192 * ib + rb8h + ((unsigned)((4 * t + 2 * s) * 16) ^ sw16));
                                const s16x4 a1 = *(const LAS s16x4*)(LQ + 8192 * ib + rb8h + ((unsigned)((4 * t + 2 * s + 1) * 16) ^ sw16));
                                const bf16x8 av = __builtin_shufflevector(a0, a1, 0, 1, 2, 3, 4, 5, 6, 7);
                                Y = MFMA32(av, bs, Y);
                            }
#pragma unroll
                        for (int g = 0; g < 4; ++g) { const f32x4 rs4 = *(const LAS f32x4*)(RS + 32 * ib + 8 * g + 4 * h);
#pragma unroll
                            for (int e = 0; e < 4; ++e) Y[4 * g + e] *= rs4[e]; }
#pragma unroll
                        for (int ks = 0; ks < 8; ++ks) { const bf16x8 bvk = tr_frag2(vb0 + 4096 * ks, vb1 + 4096 * ks);
                            const bf16x8 pa = *(const LAS bf16x8*)(LP + 8192 * q + rb + ((unsigned)(32 * ks) ^ swh16)); Y = MFMA32(pa, bvk, Y); }
                        if (br == 1) {
#pragma unroll
                            for (int g = 0; g < 4; ++g) { const f32x4 sc4 = *(const LAS f32x4*)(INV + 32 * ib + 8 * g + 4 * h);
#pragma unroll
                                for (int e = 0; e < 4; ++e) Y[4 * g + e] *= sc4[e]; } }
                        if (n < NSPLIT) { char* op = IMGs + (size_t)n * 8 * 8192 + (2 * hf + q) * 32;
                            u32x4 w0, w1; w0.x = pk2(Y[0], Y[1]); w0.y = pk2(Y[2], Y[3]); w0.z = pk2(Y[4], Y[5]); w0.w = pk2(Y[6], Y[7]);
                            w1.x = pk2(Y[8], Y[9]); w1.y = pk2(Y[10], Y[11]); w1.z = pk2(Y[12], Y[13]); w1.w = pk2(Y[14], Y[15]);
                            *(u32x4*)op = w0; *(u32x4*)(op + 16) = w1;
                        } else { add_image(Y, pw[q][0], pw[q][1]); emit_q(Y, q, PSUMh, PSUMh2, wave, lane, r, h, Yrow, hf); }
                    }
                }
            }
#pragma unroll
            for (int t = 0; t < 4; ++t)
#pragma unroll
                for (int e = 0; e < 16; ++e) S[t][e] *= dec;
#pragma unroll
            for (int ks = 0; ks < 8; ++ks) {
                const f32x4 w0 = *(const LAS f32x4*)(WW + 16 * ks + 8 * h), w1 = *(const LAS f32x4*)(WW + 16 * ks + 8 * h + 4);
                const bf16x8 bvk = tr_frag2(vb0 + 4096 * ks, vb1 + 4096 * ks);
                const u32x4 vw = __builtin_bit_cast(u32x4, bvk);
                u32x4 sw; sw.x = pk2(bflo(vw.x) * w0[0], bfhi(vw.x) * w0[1]); sw.y = pk2(bflo(vw.y) * w0[2], bfhi(vw.y) * w0[3]); sw.z = pk2(bflo(vw.z) * w1[0], bfhi(vw.z) * w1[1]); sw.w = pk2(bflo(vw.w) * w1[2], bfhi(vw.w) * w1[3]);
                const bf16x8 bw = __builtin_bit_cast(bf16x8, sw);
                bf16x8 ka[4];
#pragma unroll
                for (int t = 0; t < 4; ++t) ka[t] = tr_frag2(LK + 4096 * ks + tb0 + ((unsigned)(64 * t) ^ txs0), LK + 4096 * ks + tb1 + ((unsigned)(64 * t) ^ txs1));
                __builtin_amdgcn_sched_barrier(0);
#pragma unroll
                for (int t = 0; t < 4; ++t) S[t] = MFMA32(ka[t], bw, S[t]);
            }
            if (br == 1) {
                const int dg = tid & 15, jp = tid >> 4; float s8[8];
#pragma unroll
                for (int e = 0; e < 8; ++e) s8[e] = 0.f;
#pragma unroll
                for (int jj = 0; jj < 4; ++jj) { const int j = 4 * jp + jj; const u32x4 kw = *(const LAS u32x4*)(LK + off_b(j, dg)); const float wj = WW[j];
                    s8[0] += wj * bflo(kw.x); s8[1] += wj * bfhi(kw.x); s8[2] += wj * bflo(kw.y); s8[3] += wj * bfhi(kw.y); s8[4] += wj * bflo(kw.z); s8[5] += wj * bfhi(kw.z); s8[6] += wj * bflo(kw.w); s8[7] += wj * bfhi(kw.w); }
#pragma unroll
                for (int e = 0; e < 8; ++e) { s8[e] += swz_xor16(s8[e]); s8[e] += bperm_f(s8[e], lane ^ 32); }
                if ((tid & 63) < 16) {
#pragma unroll
                    for (int e = 0; e < 8; ++e) NP2[wave * 128 + 8 * dg + e] = s8[e]; }
            }
            __syncthreads();
            if (n >= NSPLIT) reduce_ss(PSUMh, PSUMh2, tid, SSh + row0 + 64);
            if (br == 1) { if (tid < 128) NV[tid] = dec * NV[tid] + ((NP2[tid] + NP2[128 + tid]) + (NP2[256 + tid] + NP2[384 + tid])) + ((NP2[512 + tid] + NP2[640 + tid]) + (NP2[768 + tid] + NP2[896 + tid])); m = m_next; }
        }
        { __syncthreads();
          int tidc = tid_; asm volatile("" : "+v"(tidc));
          const int lanec = tidc & 63, rc = tidc & 31, hc = (tidc >> 5) & 1;
          char* const IMGoc = (char*)(C.ws + WS_IMG) + ((size_t)u * NSPLIT * 8 + wave) * 8192 + lanec * 128; const char* const IMGpc = (const char*)(C.ws + WS_IMG) + ((size_t)(u ^ 1) * NSPLIT * 8 + wave) * 8192 + lanec * 128;
          char* const YNc = Yob + ((size_t)b * TT + (dir == 0 ? 0 : 128)) * (size_t)(DM * 2);
#pragma unroll
          for (int hf = 0; hf < 2; ++hf) {
#pragma unroll
              for (int q = 0; q < 2; ++q) { f32x16 Yc;
#pragma unroll
                  for (int e = 0; e < 16; ++e) Yc[e] = 0.f;
                  const u32x4 o0 = *(const u32x4*)(IMGoc + (2 * hf + q) * 32), o1 = *(const u32x4*)(IMGoc + (2 * hf + q) * 32 + 16);
                  const u32x4 p0 = *(const u32x4*)(IMGpc + (size_t)8 * 8192 + (2 * hf + q) * 32), p1 = *(const u32x4*)(IMGpc + (size_t)8 * 8192 + (2 * hf + q) * 32 + 16);
                  add_image(Yc, o0, o1); add_image(Yc, p0, p1); emit_q(Yc, q, PSUMh, PSUMh2, wave, lanec, rc, hc, YNc, hf); }
              __syncthreads(); reduce_ss(PSUMh, PSUMh2, tidc, SSh + (size_t)b * TT + (dir == 0 ? 0 : 128) + 64 * hf); __syncthreads(); } }
    }
}
__device__ __forceinline__ void unpack8(const u32x4 w, float (&f)[8]) { f[0] = bflo(w.x); f[1] = bfhi(w.x); f[2] = bflo(w.y); f[3] = bfhi(w.y); f[4] = bflo(w.z); f[5] = bfhi(w.z); f[6] = bflo(w.w); f[7] = bfhi(w.w); }
__device__ __forceinline__ void conv_fix_phase(const Ctx& C, int l) {
    const bf16* RAW = (const bf16*)(C.ws + WS_RAW); bf16* ACT = (bf16*)(C.ws + WS_ACT);
    const float* fw = C.inp(17) + (size_t)l * 3 * UPN; const float* fb = C.inp(18) + (size_t)l * UPN;
    const int gt = C.vcu * NTHR + C.tid, NT = C.G * NTHR;
    for (int idx = gt; idx < (MROWS / 256) * 2 * 704; idx += NT) {
        const int pm = idx / 1408, rem = idx - pm * 1408, k = rem / 704, cg = rem - k * 704, j = pm % 17;
        if (j == 0 || (k == 0 && j == 1) || (k == 1 && j == 16)) continue;
        const bf16* P = k == 0 ? RAW + ((size_t)(pm - 1) * 4 + 3) * UPN : RAW + ((size_t)pm * 4 + 2) * UPN;
        const bf16* Cc = k == 0 ? RAW + ((size_t)pm * 4 + 0) * UPN : RAW + ((size_t)pm * 4 + 3) * UPN;
        const bf16* Nn = k == 0 ? RAW + ((size_t)pm * 4 + 1) * UPN : RAW + ((size_t)(pm + 1) * 4 + 0) * UPN;
        const size_t row = (size_t)pm * 256 + (k ? 255 : 0);
        float pa[8], ca[8], na[8], pg[8], cgv[8], ng[8];
        unpack8(*(const u32x4*)(P + cg * 8), pa); unpack8(*(const u32x4*)(Cc + cg * 8), ca); unpack8(*(const u32x4*)(Nn + cg * 8), na);
        unpack8(*(const u32x4*)(P + FF + cg * 8), pg); unpack8(*(const u32x4*)(Cc + FF + cg * 8), cgv); unpack8(*(const u32x4*)(Nn + FF + cg * 8), ng);
        float o[8];
#pragma unroll
        for (int e = 0; e < 8; ++e) { const int ca_ = cg * 8 + e, cgc = FF + cg * 8 + e;
            const float a = fb[ca_] + fw[ca_] * pa[e] + fw[UPN + ca_] * ca[e] + fw[2 * UPN + ca_] * na[e];
            const float g = fb[cgc] + fw[cgc] * pg[e] + fw[UPN + cgc] * cgv[e] + fw[2 * UPN + cgc] * ng[e];
            o[e] = silu_f(a) * g; }
        u32x4 w; w.x = pk2(o[0], o[1]); w.y = pk2(o[2], o[3]); w.z = pk2(o[4], o[5]); w.w = pk2(o[6], o[7]);
        *(u32x4*)(ACT + row * FF + cg * 8) = w;
    }
}
#ifndef PHASE_MASK
#define PHASE_MASK 0xFFFFFFFFu
#endif
#ifndef DOUBLE_MASK
#define DOUBLE_MASK 0u
#endif
constexpr int CV_TF0 = 0, CV_TF1 = 4500, CV_TG1 = CV_I3, CV_TK = CV_I5;
#define TAILCV(lo, hi) if (l + 1 < NLAYER && C.G == 256) { __syncthreads(); refresh(C); const int ci_ = BX - 64; convert_weights(C, l + 1, (lo), (hi), ci_ >= 0 ? ci_ * NWAVES + C.wave : -1, 192 * NWAVES); } \
                       else if (l + 1 < NLAYER) { __syncthreads(); refresh(C); convert_weights(C, l + 1, (lo), (hi), C.vcu * NWAVES + C.wave, C.G * NWAVES); }
#define BX ((C.vcu & 31) * 8 + (C.vcu >> 5))
#define RUN(n) refresh(C); if ((PHASE_MASK >> (n)) & 1u)
#define DUP(n, ...) if ((DOUBLE_MASK >> (n)) & 1u) { __syncthreads(); refresh(C); __VA_ARGS__; }
__device__ __forceinline__ void refresh(Ctx& C) {
    asm volatile("" : "+v"(C.tid)); asm volatile("" : "+s"(C.vcu)); C.lane = C.tid & 63;
}
#define GRID_BAR() do { XcdBarrier b2_ = bar; asm volatile("" : "+s"(b2_.bar), "+s"(b2_.x)); xcd_barrier(b2_); } while (0)
constexpr int WGM_NARROW = 4;
constexpr bool GEMM_SP2 = true, GEMM_ALIGN = true;
struct Params { const float* in[20]; float* out; unsigned char* ws; };
__global__ void __launch_bounds__(NTHR, 2) fwd_kernel(Params prm) {
    extern __shared__ __attribute__((aligned(16))) unsigned char lds_raw[];
    Ctx C;
    C.lds = (LAS unsigned char*)lds_raw;
    C.tid = threadIdx.x; C.lane = C.tid & 63; C.wave = __builtin_amdgcn_readfirstlane(C.tid >> 6);
    C.G = 256; { const int bx = blockIdx.x; C.vcu = (bx % 8) * (C.G / 8) + bx / 8; }
    C.out = prm.out; C.ws = prm.ws;
    volatile LAS unsigned* MISC = (volatile LAS unsigned*)(C.lds + MISC_OFF);
    if (C.tid < 16) MISC[C.tid] = 0u;
    __syncthreads();
    XcdBarrier bar = xcd_barrier_post((unsigned*)(C.ws + WS_CTL), MISC + 8);
    unsigned char* ws = C.ws;
    const float* MOD = (const float*)(ws + WS_MOD);
    bf16* Hb = (bf16*)(ws + WS_H);
    float* XC = (float*)(ws + WS_XC);

    RUN(0) mod_phase(C, 0, NLAYER, C.vcu, C.G); RUN(1) rope_table(C); __syncthreads(); RUN(2) convert_weights(C, 0, 0, CV_I4, C.vcu * NWAVES + C.wave, C.G * NWAVES);
    DUP(2, convert_weights(C, 0, 0, CV_I4, C.vcu * NWAVES + C.wave, C.G * NWAVES))
    DUP(0, mod_phase(C, 0, NLAYER, C.vcu, C.G))
    GRID_BAR();
    RUN(3) rn_phase<false, true>(C, 0, C.inp(0), C.inp(2), nullptr, nullptr, nullptr, nullptr, 0, nullptr, MOD, 0, 1, C.inp(6), Hb);
    DUP(3, rn_phase<false, true>(C, 0, C.inp(0), C.inp(2), nullptr, nullptr, nullptr, nullptr, 0, nullptr, MOD, 0, 1, C.inp(6), Hb))
    GRID_BAR();

    for (int l = 0; l < NLAYER; ++l) {
        const float* MODl = MOD + (size_t)l * 9 * MODW;
        const int lastl = (l == NLAYER - 1) ? 1 : 0;
        const int MG = lastl ? NB * SEQ : MROWS;
        RUN(4) { pg8::Gemm g{Hb, (const bf16*)(ws + WS_W1T), MROWS, N1, DM}; pg8::StaticOrder S; S.init(MROWS, N1, C.G, BX);
          pg8::EpiProj1 E{(bf16*)(ws + WS_PROJ), (float*)(ws + WS_GATES), C.inp(10) + (size_t)l * 32, (const float*)(ws + WS_ROPE), (const float*)(ws + WS_ROPE) + 2048,
                           (bf16*)(ws + WS_MQK), (bf16*)(ws + WS_RAWQ), C.inp(8) + (size_t)l * 3 * 2048, C.inp(9) + (size_t)l * 2048, (LAS float*)(C.lds + PBUF_OFF)};
          pg8::gemm_phase<pg8::EpiProj1, pg8::StaticOrder, GEMM_ALIGN, GEMM_SP2>(C.lds, g, S, E, C.tid); }
        DUP(4, { pg8::Gemm g{Hb, (const bf16*)(ws + WS_W1T), MROWS, N1, DM}; pg8::StaticOrder S; S.init(MROWS, N1, C.G, BX);
          pg8::EpiProj1 E{(bf16*)(ws + WS_PROJ), (float*)(ws + WS_GATES), C.inp(10) + (size_t)l * 32, (const float*)(ws + WS_ROPE), (const float*)(ws + WS_ROPE) + 2048,
                           (bf16*)(ws + WS_MQK), (bf16*)(ws + WS_RAWQ), C.inp(8) + (size_t)l * 3 * 2048, C.inp(9) + (size_t)l * 2048, (LAS float*)(C.lds + PBUF_OFF)};
          pg8::gemm_phase<pg8::EpiProj1, pg8::StaticOrder, GEMM_ALIGN, GEMM_SP2>(C.lds, g, S, E, C.tid); })
        { __syncthreads(); refresh(C); const int ci_ = BX - 136; const int iw_ = ci_ >= 0 ? ci_ * NWAVES + C.wave : -1;
          convert_weights(C, l, CV_I4, lastl ? CV_I6 : CV_I5, iw_, 120 * NWAVES);
          if (l > 0) convert_weights(C, l, CV_I3, CV_I4, iw_, 120 * NWAVES); }
        GRID_BAR();
        RUN(5) conv_gate_phase(C, l);
        DUP(5, conv_gate_phase(C, l))
        GRID_BAR();
        RUN(6) scan_phase(C, l, bar);
        DUP(6, scan_phase(C, l, bar))
        GRID_BAR();
        RUN(7) { pg8::Gemm g{Hb, (const bf16*)(ws + WS_W2T), MROWS, N2, DM}; pg8::StaticOrder S; S.init(MG, N2, C.G, BX, lastl);
          pg8::EpiMerge E{(bf16*)(ws + WS_Y4), (size_t)MROWS * DM, C.inp(12) + (size_t)l * 2 * DM, (bf16*)(ws + WS_PROJ), LDP, (const float*)(ws + WS_SS), MROWS, EPSN};
          pg8::gemm_phase<pg8::EpiMerge, pg8::StaticOrder, true, GEMM_SP2>(C.lds, g, S, E, C.tid); }
        GRID_BAR();
        unsigned* const ctl = (unsigned*)(ws + WS_CTL);
        const int bb = C.vcu >> 5, clx = C.vcu & 31; const bool ctxcu = !lastl && clx < 8;
        RUN(9) { pg8::Gemm g{(const bf16*)(ws + WS_Y4), (const bf16*)(ws + WS_WRO), MROWS, DM, DM}; pg8::StaticOrder S; S.init(NB * SEQ, DM, C.G, BX, 1, WGM_NARROW);
          pg8::EpiGate<false> E{(bf16*)(ws + WS_Y4 + SLOT), DM, (const bf16*)(ws + WS_PROJ) + 4096, LDP, nullptr, nullptr};
          pg8::gemm_phase<pg8::EpiGate<false>, pg8::StaticOrder, GEMM_ALIGN, GEMM_SP2>(C.lds, g, S, E, C.tid); }
        RUN(10) { pg8::Gemm g{(const bf16*)(ws + WS_Y4 + 2 * SLOT), (const bf16*)(ws + WS_WMO), MROWS, DM, DM}; pg8::StaticOrder S; S.init(NB * SEQ, DM, C.G, BX, 1, WGM_NARROW); if (!lastl) S.sig = 1;
          pg8::EpiGate<true> E{(bf16*)(ws + WS_Y4 + SLOT), DM, (const bf16*)(ws + WS_PROJ) + 6144, LDP, ctl + 5120, ctl + 5376 + 64 * bb};
          pg8::gemm_phase<pg8::EpiGate<true>, pg8::StaticOrder, GEMM_ALIGN, GEMM_SP2>(C.lds, g, S, E, C.tid); }
        RUN(9) { pg8::Gemm g{(const bf16*)(ws + WS_Y4), (const bf16*)(ws + WS_WRO), MROWS, DM, DM}; pg8::StaticOrder S; S.init(0, DM, C.G, BX, 0, WGM_NARROW); if (ctxcu) { S.sig = 1; S.xpm = 17 * bb; S.xpn = clx; }
          pg8::EpiGate<false> E{(bf16*)(ws + WS_Y4 + SLOT), DM, (const bf16*)(ws + WS_PROJ) + 4096, LDP, nullptr, nullptr};
          pg8::gemm_phase<pg8::EpiGate<false>, pg8::StaticOrder, GEMM_ALIGN, GEMM_SP2>(C.lds, g, S, E, C.tid); }
        RUN(10) { pg8::Gemm g{(const bf16*)(ws + WS_Y4 + 2 * SLOT), (const bf16*)(ws + WS_WMO), MROWS, DM, DM}; pg8::StaticOrder S; S.init(0, DM, C.G, BX, 0, WGM_NARROW); if (ctxcu) { S.sig = 1; S.xpm = 17 * bb; S.xpn = clx; }
          pg8::EpiGate<true> E{(bf16*)(ws + WS_Y4 + SLOT), DM, (const bf16*)(ws + WS_PROJ) + 6144, LDP, ctl + 5120, ctl + 5376 + 64 * bb};
          pg8::gemm_phase<pg8::EpiGate<true>, pg8::StaticOrder, GEMM_ALIGN, GEMM_SP2>(C.lds, g, S, E, C.tid); }
        if (lastl) GRID_BAR();
        else { refresh(C); wait_count(C, ctl + 5120, 256u * (unsigned)(l + 1)); if (ctxcu) wait_count(C, ctl + 5376 + 64 * bb, 8u * (unsigned)(l + 1)); }
        RUN(11) { pg8::Gemm g{(const bf16*)(ws + WS_Y4 + SLOT), (const bf16*)(ws + WS_WO), MROWS, DM, DM}; pg8::StaticOrder S;
          if (lastl) S.init(NB * SEQ, DM, C.G, BX, 1, WGM_NARROW);
          else if (!ctxcu) { S.init(NB * SEQ, DM, 192, bb + 8 * (clx - 8), 1, WGM_NARROW); S.lim = 960; }
          else { S.init(NB * SEQ, DM, 64, bb + 8 * clx, 1, WGM_NARROW); S.base = 960; S.xpm = 17 * bb; S.xpn = clx; }
          pg8::EpiPlain E{(bf16*)(ws + WS_Y4 + 3 * SLOT), DM, nullptr, nullptr};
          pg8::gemm_phase<pg8::EpiPlain, pg8::StaticOrder, GEMM_ALIGN, GEMM_SP2>(C.lds, g, S, E, C.tid); }
        if (!lastl) { __syncthreads(); refresh(C); convert_weights(C, l, CV_I5, CV_I6, ctxcu ? (bb * 8 + clx) * NWAVES + C.wave : -1, 64 * NWAVES); }
        GRID_BAR();
        RUN(12) rn_phase<true, true>(C, lastl, l == 0 ? C.inp(0) : C.out, l == 0 ? C.inp(2) : XC, C.out, XC, (const bf16*)(ws + WS_Y4 + 3 * SLOT),
                             MODl, 2, C.inp(6) + ((size_t)l * 4 + 1) * DM, MODl, 3, 4, C.inp(6) + ((size_t)l * 4 + 2) * DM, Hb);
        GRID_BAR();
        RUN(13) { pg8::Gemm g{Hb, (const bf16*)(ws + WS_WUT), MROWS, UPN, DM}; pg8::StaticOrder S; S.init(MG, UPN, C.G, BX, lastl);
          pg8::EpiConvAct E{(bf16*)(ws + WS_ACT), (bf16*)(ws + WS_RAW), C.inp(17) + (size_t)l * 3 * UPN, C.inp(18) + (size_t)l * UPN, (LAS float*)(C.lds + PBUF_OFF), FF, UPN};
          pg8::gemm_phase<pg8::EpiConvAct, pg8::StaticOrder, true, GEMM_SP2>(C.lds, g, S, E, C.tid); }
        DUP(13, { pg8::Gemm g{Hb, (const bf16*)(ws + WS_WUT), MROWS, UPN, DM}; pg8::StaticOrder S; S.init(MG, UPN, C.G, BX, lastl);
          pg8::EpiConvAct E{(bf16*)(ws + WS_ACT), (bf16*)(ws + WS_RAW), C.inp(17) + (size_t)l * 3 * UPN, C.inp(18) + (size_t)l * UPN, (LAS float*)(C.lds + PBUF_OFF), FF, UPN};
          pg8::gemm_phase<pg8::EpiConvAct, pg8::StaticOrder, true, GEMM_SP2>(C.lds, g, S, E, C.tid); })
        if (l + 1 < NLAYER) { __syncthreads(); refresh(C); const int ci_ = BX - 96; convert_weights(C, l + 1, 0, CV_I3, ci_ >= 0 ? ci_ * NWAVES + C.wave : -1, 160 * NWAVES); }
        GRID_BAR();
        RUN(14) conv_fix_phase(C, l);
        GRID_BAR();
        RUN(15) { pg8::Gemm g{(const bf16*)(ws + WS_ACT), (const bf16*)(ws + WS_WDT), MROWS, DM, FF}; pg8::StaticOrder S; S.init(NB * SEQ, DM, C.G, BX, 1, WGM_NARROW);
          if (!lastl) { S.sig = 1; if ((C.vcu & 31) < 8) { S.xpm = 17 * (C.vcu >> 5); S.xpn = C.vcu & 31; } }
          pg8::EpiPlain E{(bf16*)(ws + WS_OUTF), DM, ctl + 4096, ctl + 4352 + 64 * (C.vcu >> 5)};
          pg8::gemm_phase<pg8::EpiPlain, pg8::StaticOrder, GEMM_ALIGN, GEMM_SP2>(C.lds, g, S, E, C.tid); }
        if (lastl) GRID_BAR();
        if (l + 1 < NLAYER) {
            RUN(16) rn_phase<true, true>(C, 0, C.out, XC, C.out, XC, (const bf16*)(ws + WS_OUTF), MODl, 5, C.inp(6) + ((size_t)l * 4 + 3) * DM,
                                 MODl + 9 * MODW, 0, 1, C.inp(6) + ((size_t)(l + 1) * 4) * DM, Hb, ctl + 4096, 256u * (unsigned)(l + 1), ctl + 4352 + 64 * (C.vcu >> 5), 8u * (unsigned)(l + 1));
            GRID_BAR();
        } else {
            RUN(16) rn_phase<true, false>(C, 1, C.out, XC, C.out, XC, (const bf16*)(ws + WS_OUTF), MODl, 5, C.inp(6) + ((size_t)l * 4 + 3) * DM, nullptr, 0, 0, nullptr, nullptr);
        }
    }
}

extern "C" void kernel_launch(void* const* d_in, const int* in_sizes, int n_in, void* d_out, int out_size, void* d_ws, size_t ws_size, hipStream_t stream) {
    static int grid = 0;
    if (grid == 0) {
        if (n_in != 20 || ws_size < WS_END) { fprintf(stderr, "kernel_launch: need 20 inputs and >= %zu bytes of workspace (got %d, %zu)\n", (size_t)WS_END, n_in, ws_size); grid = -1; return; }
        int dev = 0, cus = 0, per_cu = 0;
        if (hipGetDevice(&dev) != hipSuccess || hipDeviceGetAttribute(&cus, hipDeviceAttributeMultiprocessorCount, dev) != hipSuccess) { grid = -1; return; }
        if (hipFuncSetAttribute((const void*)fwd_kernel, hipFuncAttributeMaxDynamicSharedMemorySize, LDS_BYTES) != hipSuccess) { fprintf(stderr, "kernel_launch: hipFuncSetAttribute failed\n"); grid = -1; return; }
        if (hipOccupancyMaxActiveBlocksPerMultiprocessor(&per_cu, (const void*)fwd_kernel, NTHR, LDS_BYTES) != hipSuccess || per_cu < 1) { fprintf(stderr, "kernel_launch: occupancy query says %d blocks per CU\n", per_cu); (void)hipGetLastError(); grid = -1; return; }
        grid = cus;
        if (grid != 256) { fprintf(stderr, "kernel_launch: built for 256 CUs (one scan unit per workgroup, mid-phase grid barrier); this device has %d\n", cus); grid = -1; return; }
    }
    if (grid < 0) return;
    (void)in_sizes; (void)out_size;
    if (hipMemsetAsync((char*)d_ws + WS_CTL, 0, CTL_ZERO_BYTES, stream) != hipSuccess) return;
    Params p{};
    for (int i = 0; i < 20; ++i) p.in[i] = (const float*)d_in[i];
    p.out = (float*)d_out; p.ws = (unsigned char*)d_ws;
    hipLaunchKernelGGL(fwd_kernel, dim3(grid), dim3(NTHR), LDS_BYTES, stream, p);
}
```

```cpp
#include <hip/hip_runtime.h>
#include <cstdio>
#include <cstdint>

namespace pg8 {
#define PG8_LAS __attribute__((address_space(3)))
typedef unsigned short bf16_t;
typedef short bf16x8 __attribute__((ext_vector_type(8)));
typedef float f32x4 __attribute__((ext_vector_type(4)));
typedef unsigned u32x4 __attribute__((ext_vector_type(4)));
constexpr int BM = 256, BK = 64, HALF = 128, HTB = HALF * BK * 2  , STAGE_BYTES = 8 * HTB, NXCD = 8, WGM = 4;

__host__ __device__ __forceinline__ int lds_byte(int r, int c) { const int st = (r >> 4) * 2 + (c >> 5), rr = r & 15, cc = c & 31, ob = rr * 64 + cc * 2; return st * 1024 + (ob ^ (((ob >> 9) & 1) << 5)); }
__host__ __device__ __forceinline__ void stage_rc(int b, int& R, int& C) { const int st = b / 1024, sb = b % 1024, swz = sb ^ (((sb >> 9) & 1) << 5); R = (st >> 1) * 16 + swz / 64; C = (st & 1) * 32 + (swz % 64) / 2; }
__host__ __device__ __forceinline__ int perm32(int rho) { const int n = rho >> 4, i = rho & 15; return 8 * (i >> 2) + 4 * n + (i & 3); }

struct Unit { int pm, pn, flag; };
struct Gemm { const bf16_t* A; const bf16_t* Bt; int M, N, K; };

struct StaticOrder {
    int nM, nN, nwg, G, c, skip, wgm;
    int base, lim;
    int sig, xpm, xpn;
    __host__ __device__ void init(int M, int N, int G_, int c_, int skip_ = 0, int wgm_ = WGM) { nM = M / BM; nN = N / BM; nwg = nM * nN; G = G_; c = c_; skip = skip_; wgm = wgm_; sig = 0; xpm = 0; xpn = -1; base = 0; lim = 0x7fffffff; }
    __host__ __device__ bool next(int i, Unit& u) const {
        const long L = (long)base + (long)i * G + c; u.flag = (sig && L + G >= nwg) ? 1 : 0;
        if (L >= nwg || L >= lim) { if (xpn >= 0 && L >= nwg && L < nwg + G) { u.pm = xpm; u.pn = xpn; u.flag = sig ? 2 : 0; return true; } return false; }
        int wgid = (int)L; { const int q = nwg / NXCD, r = nwg % NXCD, xcd = wgid % NXCD, off = wgid / NXCD; wgid = (xcd < r ? xcd * (q + 1) : r * (q + 1) + (xcd - r) * q) + off; }
        const int nig = wgm * nN, gid = wgid / nig, fm = gid * wgm, gsz = (nM - fm) < wgm ? (nM - fm) : wgm;
        u.pm = fm + ((wgid % nig) % gsz); u.pn = (wgid % nig) / gsz; if (skip) u.pm += (u.pm >> 4) + 1; return true;
    }
    __device__ __forceinline__ void a_ready(const Unit&) const {}
    __device__ __forceinline__ void done(const Unit&) const {}
};
__device__ __forceinline__ unsigned pk2(float lo, float hi) {
    typedef __bf16 b2_t __attribute__((ext_vector_type(2))); typedef float f2_t __attribute__((ext_vector_type(2)));
    f2_t f = {lo, hi}; b2_t b = __builtin_convertvector(f, b2_t); return __builtin_bit_cast(unsigned, b); }
__device__ __forceinline__ float bflo(unsigned w) { return __uint_as_float(w << 16); }
__device__ __forceinline__ float bfhi(unsigned w) { return __uint_as_float(w & 0xffff0000u); }
typedef float f32x2_t __attribute__((ext_vector_type(2)));
__device__ __forceinline__ f32x2_t sigmoid2(f32x2_t x) { const f32x2_t t = x * -1.4426950408889634f; const f32x2_t d = (f32x2_t){__builtin_amdgcn_exp2f(t.x), __builtin_amdgcn_exp2f(t.y)} + 1.0f;
    return (f32x2_t){__builtin_amdgcn_rcpf(d.x), __builtin_amdgcn_rcpf(d.y)}; }
__device__ __forceinline__ unsigned pk2v(f32x2_t f) { typedef __bf16 b2_t __attribute__((ext_vector_type(2))); return __builtin_bit_cast(unsigned, __builtin_convertvector(f, b2_t)); }

#define PG8_DPP(old, src, ctrl) __builtin_bit_cast(float, __builtin_amdgcn_update_dpp(__builtin_bit_cast(int, (float)(old)), __builtin_bit_cast(int, (float)(src)), (ctrl), 0xf, 0xf, false))
struct EpiPlain {
    static constexpr bool PERM = true, AFTER_DRAIN = false, PERMA = false;
    bf16_t* O; int ldc; unsigned* cnt_lat; unsigned* cnt_ctx;
    __device__ __forceinline__ void operator()(const f32x4 (&acc)[2][2][4][2], const Unit& u, int wr, int wc, int fr, int fq) const {
        const int row0 = u.pm * BM + wr * 64 + fr, col0 = u.pn * BM + wc * 32 + 8 * fq;
#pragma unroll
        for (int ai = 0; ai < 2; ++ai)
#pragma unroll
            for (int m = 0; m < 4; ++m) { bf16_t* rowp = O + (size_t)(row0 + ai * HALF + m * 16) * ldc + col0;
#pragma unroll
                for (int bj = 0; bj < 2; ++bj) { const f32x4 v0 = acc[ai][bj][m][0], v1 = acc[ai][bj][m][1];
                    u32x4 w; w.x = pk2(v0[0], v0[1]); w.y = pk2(v0[2], v0[3]); w.z = pk2(v1[0], v1[1]); w.w = pk2(v1[2], v1[3]);
                    *(u32x4*)(rowp + bj * HALF) = w; } }
        if (u.flag) { asm volatile("s_waitcnt vmcnt(0)" ::: "memory"); __builtin_amdgcn_s_barrier();
            if (wr == 0 && wc == 0 && fr == 0 && fq == 0) { __builtin_amdgcn_fence(__ATOMIC_RELEASE, "agent"); asm volatile("s_waitcnt vmcnt(0)" ::: "memory");
                (void)__hip_atomic_fetch_add(u.flag == 1 ? cnt_lat : cnt_ctx, 1u, __ATOMIC_RELAXED, __HIP_MEMORY_SCOPE_AGENT); } }
    }
};
struct EpiProj1 {
    static constexpr bool PERM = true, AFTER_DRAIN = false, PERMA = false;
    bf16_t* O; float* gates; const float* gate_b; const float* ropeC; const float* ropeS;
    bf16_t* MQK; bf16_t* RAWQ; const float* cw; const float* cb; PG8_LAS float* EX;
    __device__ __forceinline__ void operator()(const f32x4 (&acc)[2][2][4][2], const Unit& u, int wr, int wc, int fr, int fq) const {
        const int row0 = u.pm * BM + wr * 64 + fr;
        if (u.pn >= 16 && u.pn < 24) {
            const int chb = (u.pn - 16) * BM + wc * 32 + 8 * fq;
            const float scl = u.pn < 20 ? 0.08838834764831845f : 1.0f;
#pragma unroll
            for (int ai = 0; ai < 2; ++ai) { const int blk = 2 * ai + wr;
                if (fr == 0) {
#pragma unroll
                    for (int bj = 0; bj < 2; ++bj)
#pragma unroll
                        for (int n = 0; n < 2; ++n) *(PG8_LAS f32x4*)(EX + (((wc * 8 + 2 * blk) * 4 + fq) * 16 + bj * 8 + n * 4)) = acc[ai][bj][0][n]; }
                if (fr == 15) {
#pragma unroll
                    for (int bj = 0; bj < 2; ++bj)
#pragma unroll
                        for (int n = 0; n < 2; ++n) *(PG8_LAS f32x4*)(EX + (((wc * 8 + 2 * blk + 1) * 4 + fq) * 16 + bj * 8 + n * 4)) = acc[ai][bj][3][n]; } }
            if (wr == 0 && fr < 2) {
#pragma unroll
                for (int bj = 0; bj < 2; ++bj) { const f32x4 v0 = acc[0][bj][0][0], v1 = acc[0][bj][0][1];
                    u32x4 w; w.x = pk2(v0[0], v0[1]); w.y = pk2(v0[2], v0[3]); w.z = pk2(v1[0], v1[1]); w.w = pk2(v1[2], v1[3]);
                    *(u32x4*)(RAWQ + ((size_t)u.pm * 4 + fr) * 2048 + bj * HALF + chb) = w; } }
            if (wr == 1 && fr >= 14) {
#pragma unroll
                for (int bj = 0; bj < 2; ++bj) { const f32x4 v0 = acc[1][bj][3][0], v1 = acc[1][bj][3][1];
                    u32x4 w; w.x = pk2(v0[0], v0[1]); w.y = pk2(v0[2], v0[3]); w.z = pk2(v1[0], v1[1]); w.w = pk2(v1[2], v1[3]);
                    *(u32x4*)(RAWQ + ((size_t)u.pm * 4 + 2 + (fr - 14)) * 2048 + bj * HALF + chb) = w; } }
            asm volatile("s_waitcnt lgkmcnt(0)" ::: "memory"); __builtin_amdgcn_s_barrier(); asm volatile("" ::: "memory");
#pragma unroll
            for (int bj = 0; bj < 2; ++bj)
#pragma unroll
                for (int n = 0; n < 2; ++n) {
                    const int c4 = chb + bj * HALF + 4 * n;
                    const f32x4 w0 = *(const f32x4*)(cw + c4), w1 = *(const f32x4*)(cw + 2048 + c4), w2 = *(const f32x4*)(cw + 4096 + c4), bb = *(const f32x4*)(cb + c4);
#pragma unroll
                    for (int ai = 0; ai < 2; ++ai) { const int blk = 2 * ai + wr;
                        const f32x4 pe = (blk == 0) ? (f32x4){0.f, 0.f, 0.f, 0.f} : *(const PG8_LAS f32x4*)(EX + (((wc * 8 + 2 * blk - 1) * 4 + fq) * 16 + bj * 8 + n * 4));
                        const f32x4 ne = (blk == 3) ? (f32x4){0.f, 0.f, 0.f, 0.f} : *(const PG8_LAS f32x4*)(EX + (((wc * 8 + 2 * blk + 2) * 4 + fq) * 16 + bj * 8 + n * 4));
#pragma unroll
                        for (int m = 0; m < 4; ++m) { float o[4];
#pragma unroll
                            for (int e = 0; e < 4; ++e) { const float cur = acc[ai][bj][m][n][e];
                                const float oldp = (m == 0) ? pe[e] : PG8_DPP(0.f, acc[ai][bj][m == 0 ? 0 : m - 1][n][e], 0x121);
                                const float prev = PG8_DPP(oldp, cur, 0x111);
                                const float oldn = (m == 3) ? ne[e] : PG8_DPP(0.f, acc[ai][bj][m == 3 ? 3 : m + 1][n][e], 0x12f);
                                const float next = PG8_DPP(oldn, cur, 0x101);
                                const float cv = bb[e] + w0[e] * prev + w1[e] * cur + w2[e] * next;
                                o[e] = (cv * __builtin_amdgcn_rcpf(1.0f + __expf(-cv))) * scl; }
                            typedef unsigned u32x2_t __attribute__((ext_vector_type(2)));
                            u32x2_t w; w.x = pk2(o[0], o[1]); w.y = pk2(o[2], o[3]);
                            *(u32x2_t*)(MQK + (size_t)(row0 + ai * HALF + m * 16) * 2048 + c4) = w; } } }
            return;
        }
        if (u.pn == 32) {
            if (wc == 0) { const f32x4 g0 = *(const f32x4*)(gate_b + 8 * fq), g1 = *(const f32x4*)(gate_b + 8 * fq + 4);
#pragma unroll
                for (int ai = 0; ai < 2; ++ai)
#pragma unroll
                    for (int m = 0; m < 4; ++m) { float* gp = gates + (size_t)(row0 + ai * HALF + m * 16) * 32 + 8 * fq;
                        *(f32x4*)gp = acc[ai][0][m][0] + g0; *(f32x4*)(gp + 4) = acc[ai][0][m][1] + g1; } }
            return;
        }
        const int col0 = u.pn * BM + wc * 32 + 8 * fq;
        const bool roped = (u.pn < 8) && ((u.pm % 17) != 0);
        const float sc = (u.pn < 4) ? 0.08838834764831845f : 1.0f;
        const int tbase = (u.pm % 17) * 256 - 256 + wr * 64 + fr;
        const int p0 = (wc & 1) * 16 + 4 * fq, blk = wc >> 1;
#pragma unroll
        for (int ai = 0; ai < 2; ++ai) {
#pragma unroll
          for (int mh = 0; mh < 2; ++mh) {
            f32x4 c4v[4], s4v[4];
#pragma unroll
            for (int m = 2 * mh; m < 2 * mh + 2; ++m) { c4v[m] = (f32x4){1.f, 1.f, 1.f, 1.f}; s4v[m] = (f32x4){0.f, 0.f, 0.f, 0.f};
                if (roped) { const int t = tbase + ai * HALF + m * 16; const int pos = blk ? (t & 63) : (t >> 6);
                    c4v[m] = *(const f32x4*)(ropeC + pos * 32 + p0); s4v[m] = *(const f32x4*)(ropeS + pos * 32 + p0); } }
#pragma unroll
            for (int m = 2 * mh; m < 2 * mh + 2; ++m) { bf16_t* rowp = O + (size_t)(row0 + ai * HALF + m * 16) * 8192 + col0;
                const f32x4 c4 = c4v[m], s4 = s4v[m];
#pragma unroll
                for (int bj = 0; bj < 2; ++bj) { f32x4 v0 = acc[ai][bj][m][0] * sc, v1 = acc[ai][bj][m][1] * sc;
                    const f32x4 r0 = (f32x4){v0[0] * c4[0] - v0[1] * s4[0], v0[0] * s4[0] + v0[1] * c4[0], v0[2] * c4[1] - v0[3] * s4[1], v0[2] * s4[1] + v0[3] * c4[1]};
                    const f32x4 r1 = (f32x4){v1[0] * c4[2] - v1[1] * s4[2], v1[0] * s4[2] + v1[1] * c4[2], v1[2] * c4[3] - v1[3] * s4[3], v1[2] * s4[3] + v1[3] * c4[3]};
                    u32x4 w; w.x = pk2(r0[0], r0[1]); w.y = pk2(r0[2], r0[3]); w.z = pk2(r1[0], r1[1]); w.w = pk2(r1[2], r1[3]);
                    *(u32x4*)(rowp + bj * HALF) = w; } }
          }
        }
    }
};
template <bool ACCUM> struct EpiGate {
    static constexpr bool PERM = true, AFTER_DRAIN = false, PERMA = false;
    bf16_t* Y; int ldc; const bf16_t* Gt; int ldg; unsigned* cnt_lat; unsigned* cnt_ctx;
    __device__ __forceinline__ void operator()(const f32x4 (&acc)[2][2][4][2], const Unit& u, int wr, int wc, int fr, int fq) const {
        const int row0 = u.pm * BM + wr * 64 + fr, col0 = u.pn * BM + wc * 32 + 8 * fq;
        u32x4 gall[2][4][2];
        if (!ACCUM) {
#pragma unroll
            for (int ai = 0; ai < 2; ++ai)
#pragma unroll
                for (int m = 0; m < 4; ++m)
#pragma unroll
                    for (int bj = 0; bj < 2; ++bj) gall[ai][m][bj] = *(const u32x4*)(Gt + (size_t)(row0 + ai * HALF + m * 16) * ldg + col0 + bj * HALF); }
#pragma unroll
        for (int ai = 0; ai < 2; ++ai) {
            u32x4 gwv[4][2], ywv[4][2];
#pragma unroll
            for (int m = 0; m < 4; ++m)
#pragma unroll
                for (int bj = 0; bj < 2; ++bj) { const size_t row = (size_t)(row0 + ai * HALF + m * 16);
                    if (ACCUM) { gwv[m][bj] = *(const u32x4*)(Gt + row * ldg + col0 + bj * HALF); ywv[m][bj] = *(const u32x4*)(Y + row * ldc + col0 + bj * HALF); }
                    else gwv[m][bj] = gall[ai][m][bj]; }
#pragma unroll
            for (int m = 0; m < 4; ++m) { const size_t row = (size_t)(row0 + ai * HALF + m * 16);
#pragma unroll
                for (int bj = 0; bj < 2; ++bj) { const f32x4 v0 = acc[ai][bj][m][0], v1 = acc[ai][bj][m][1];
                    const u32x4 gw = gwv[m][bj];
                    float o[8] = {v0[0], v0[1], v0[2], v0[3], v1[0], v1[1], v1[2], v1[3]};
                    const float g[8] = {bflo(gw.x), bfhi(gw.x), bflo(gw.y), bfhi(gw.y), bflo(gw.z), bfhi(gw.z), bflo(gw.w), bfhi(gw.w)};
#pragma unroll
                    for (int e = 0; e < 8; ++e) o[e] = o[e] * g[e];
                    bf16_t* yp = Y + row * ldc + col0 + bj * HALF;
                    if (ACCUM) { const u32x4 yw = ywv[m][bj];
                        o[0] += bflo(yw.x); o[1] += bfhi(yw.x); o[2] += bflo(yw.y); o[3] += bfhi(yw.y); o[4] += bflo(yw.z); o[5] += bfhi(yw.z); o[6] += bflo(yw.w); o[7] += bfhi(yw.w); }
                    u32x4 w; w.x = pk2(o[0], o[1]); w.y = pk2(o[2], o[3]); w.z = pk2(o[4], o[5]); w.w = pk2(o[6], o[7]);
                    *(u32x4*)yp = w; } }
        }
        if (ACCUM && u.flag) { asm volatile("s_waitcnt vmcnt(0)" ::: "memory"); __builtin_amdgcn_s_barrier();
            if (wr == 0 && wc == 0 && fr == 0 && fq == 0) { __builtin_amdgcn_fence(__ATOMIC_RELEASE, "agent"); asm volatile("s_waitcnt vmcnt(0)" ::: "memory");
                (void)__hip_atomic_fetch_add(u.flag == 1 ? cnt_lat : cnt_ctx, 1u, __ATOMIC_RELAXED, __HIP_MEMORY_SCOPE_AGENT); } }
    }
};

struct EpiMerge {
    static constexpr bool PERM = true, AFTER_DRAIN = false, PERMA = false;
    bf16_t* Y4; size_t slot; const float* hnw; bf16_t* G; int ldg; const float* SS; int mrows; float eps;
    __device__ __forceinline__ void operator()(const f32x4 (&acc)[2][2][4][2], const Unit& u, int wr, int wc, int fr, int fq) const {
        const int row0 = u.pm * BM + wr * 64 + fr;
        if (u.pn >= 16) {
            const int col0 = u.pn * BM + wc * 32 + 8 * fq;
#pragma unroll
            for (int ai = 0; ai < 2; ++ai)
#pragma unroll
                for (int m = 0; m < 4; ++m) { bf16_t* rowp = G + (size_t)(row0 + ai * HALF + m * 16) * ldg + col0;
#pragma unroll
                    for (int bj = 0; bj < 2; ++bj) { const f32x4 v0 = acc[ai][bj][m][0], v1 = acc[ai][bj][m][1];
                        u32x4 w; w.x = pk2v(sigmoid2(__builtin_shufflevector(v0, v0, 0, 1))); w.y = pk2v(sigmoid2(__builtin_shufflevector(v0, v0, 2, 3)));
                        w.z = pk2v(sigmoid2(__builtin_shufflevector(v1, v1, 0, 1))); w.w = pk2v(sigmoid2(__builtin_shufflevector(v1, v1, 2, 3)));
                        *(u32x4*)(rowp + bj * HALF) = w; } }
            return;
        }
        const int br = u.pn >> 3, hh = u.pn & 7, col0 = hh * BM + wc * 32 + 8 * fq;
        bf16_t* Yn = Y4 + (size_t)(2 * br) * slot;
        f32x4 hw[2][2];
#pragma unroll
        for (int bj = 0; bj < 2; ++bj) { hw[bj][0] = *(const f32x4*)(hnw + br * 2048 + col0 + bj * HALF); hw[bj][1] = *(const f32x4*)(hnw + br * 2048 + col0 + bj * HALF + 4); }
        auto half_tile = [&](auto BR) {
#pragma unroll
        for (int am = 0; am < 4; ++am) { const int ai = am >> 1;
            u32x4 yv[2][2]; float ssv[2];
#pragma unroll
            for (int mm = 0; mm < 2; ++mm) { const int m = 2 * (am & 1) + mm; ssv[mm] = SS[(size_t)(br * 8 + hh) * mrows + row0 + ai * HALF + m * 16];
#pragma unroll
                for (int bj = 0; bj < 2; ++bj) yv[mm][bj] = *(const u32x4*)(Yn + (size_t)(row0 + ai * HALF + m * 16) * 2048 + col0 + bj * HALF); }
#pragma unroll
            for (int mm = 0; mm < 2; ++mm) { const int m = 2 * (am & 1) + mm; const size_t ro = (size_t)(row0 + ai * HALF + m * 16) * 2048 + col0;
                const float rstd = __builtin_amdgcn_rsqf(ssv[mm] * (1.0f / 256.0f) + eps);
#pragma unroll
                for (int bj = 0; bj < 2; ++bj) { const u32x4 a = yv[mm][bj]; const unsigned aw[4] = {a.x, a.y, a.z, a.w};
                    const f32x4 g0 = acc[ai][bj][m][0], g1 = acc[ai][bj][m][1];
                    const f32x2_t gp[4] = {__builtin_shufflevector(g0, g0, 0, 1), __builtin_shufflevector(g0, g0, 2, 3), __builtin_shufflevector(g1, g1, 0, 1), __builtin_shufflevector(g1, g1, 2, 3)};
                    const f32x2_t wp[4] = {__builtin_shufflevector(hw[bj][0], hw[bj][0], 0, 1), __builtin_shufflevector(hw[bj][0], hw[bj][0], 2, 3), __builtin_shufflevector(hw[bj][1], hw[bj][1], 0, 1), __builtin_shufflevector(hw[bj][1], hw[bj][1], 2, 3)};
                    unsigned ow[4];
#pragma unroll
                    for (int q = 0; q < 4; ++q) { const f32x2_t y2 = (f32x2_t){bflo(aw[q]), bfhi(aw[q])}; f32x2_t s2 = sigmoid2(gp[q]);
                        if (!decltype(BR)::value) s2 = s2 * gp[q];
                        ow[q] = pk2v((y2 * rstd) * (wp[q] * s2)); }
                    u32x4 w; w.x = ow[0]; w.y = ow[1]; w.z = ow[2]; w.w = ow[3];
                    *(u32x4*)(Yn + ro + bj * HALF) = w; } }
            asm volatile("" ::: "memory");
        }
        };
        if (br) half_tile(std::integral_constant<bool, true>{}); else half_tile(std::integral_constant<bool, false>{});
    }
};

struct EpiConvAct {
    static constexpr bool PERM = true, AFTER_DRAIN = false, PERMA = true;
    bf16_t* ACT; bf16_t* RAW; const float* fw; const float* fb; PG8_LAS float* EX; int FFn, UPNn;
    __device__ __forceinline__ void operator()(const f32x4 (&acc)[2][2][4][2], const Unit& u, int wr, int wc, int fr, int fq) const {
        const int chb = 128 * u.pn + 32 * wc + 8 * fq;
#pragma unroll
        for (int ai = 0; ai < 2; ++ai) { const int blk = 2 * ai + wr;
            if (fr == 0) {
#pragma unroll
                for (int bj = 0; bj < 2; ++bj)
#pragma unroll
                    for (int n = 0; n < 2; ++n) *(PG8_LAS f32x4*)(EX + (((wc * 8 + 2 * blk) * 4 + fq) * 16 + bj * 8 + n * 4)) = acc[ai][bj][0][n]; }
            if (fr == 15) {
#pragma unroll
                for (int bj = 0; bj < 2; ++bj)
#pragma unroll
                    for (int n = 0; n < 2; ++n) *(PG8_LAS f32x4*)(EX + (((wc * 8 + 2 * blk + 1) * 4 + fq) * 16 + bj * 8 + n * 4)) = acc[ai][bj][3][n]; } }
        if (wr == 0 && fr == 0) {
#pragma unroll
            for (int k = 0; k < 2; ++k)
#pragma unroll
                for (int bj = 0; bj < 2; ++bj) { const f32x4 v0 = acc[0][bj][k][0], v1 = acc[0][bj][k][1];
                    u32x4 w; w.x = pk2(v0[0], v0[1]); w.y = pk2(v0[2], v0[3]); w.z = pk2(v1[0], v1[1]); w.w = pk2(v1[2], v1[3]);
                    *(u32x4*)(RAW + ((size_t)u.pm * 4 + k) * UPNn + bj * FFn + chb) = w; } }
        if (wr == 1 && fr == 15) {
#pragma unroll
            for (int k = 0; k < 2; ++k)
#pragma unroll
                for (int bj = 0; bj < 2; ++bj) { const f32x4 v0 = acc[1][bj][2 + k][0], v1 = acc[1][bj][2 + k][1];
                    u32x4 w; w.x = pk2(v0[0], v0[1]); w.y = pk2(v0[2], v0[3]); w.z = pk2(v1[0], v1[1]); w.w = pk2(v1[2], v1[3]);
                    *(u32x4*)(RAW + ((size_t)u.pm * 4 + 2 + k) * UPNn + bj * FFn + chb) = w; } }
        asm volatile("s_waitcnt lgkmcnt(0)" ::: "memory"); __builtin_amdgcn_s_barrier(); asm volatile("" ::: "memory");
        const int row0 = u.pm * BM + wr * 64 + 4 * fr;
#pragma unroll
        for (int n = 0; n < 2; ++n) {
            const int c4 = chb + 4 * n;
            f32x4 w0[2], w1[2], w2[2], bb[2];
#pragma unroll
            for (int bj = 0; bj < 2; ++bj) { w0[bj] = *(const f32x4*)(fw + bj * FFn + c4); w1[bj] = *(const f32x4*)(fw + UPNn + bj * FFn + c4); w2[bj] = *(const f32x4*)(fw + 2 * UPNn + bj * FFn + c4); bb[bj] = *(const f32x4*)(fb + bj * FFn + c4); }
#pragma unroll
            for (int ai = 0; ai < 2; ++ai) { const int blk = 2 * ai + wr;
                f32x4 pe[2], ne[2];
#pragma unroll
                for (int bj = 0; bj < 2; ++bj) {
                    pe[bj] = (blk == 0) ? (f32x4){0.f, 0.f, 0.f, 0.f} : *(const PG8_LAS f32x4*)(EX + (((wc * 8 + 2 * blk - 1) * 4 + fq) * 16 + bj * 8 + n * 4));
                    ne[bj] = (blk == 3) ? (f32x4){0.f, 0.f, 0.f, 0.f} : *(const PG8_LAS f32x4*)(EX + (((wc * 8 + 2 * blk + 2) * 4 + fq) * 16 + bj * 8 + n * 4)); }
#pragma unroll
                for (int m = 0; m < 4; ++m) {
                    f32x4 cv[2];
#pragma unroll
                    for (int bj = 0; bj < 2; ++bj)
#pragma unroll
                        for (int e = 0; e < 4; ++e) { const float cur = acc[ai][bj][m][n][e];
                            const float prev = (m == 0) ? PG8_DPP(pe[bj][e], acc[ai][bj][3][n][e], 0x111) : acc[ai][bj][m == 0 ? 0 : m - 1][n][e];
                            const float next = (m == 3) ? PG8_DPP(ne[bj][e], acc[ai][bj][0][n][e], 0x101) : acc[ai][bj][m == 3 ? 3 : m + 1][n][e];
                            cv[bj][e] = bb[bj][e] + w0[bj][e] * prev + w1[bj][e] * cur + w2[bj][e] * next; }
                    float o[4];
#pragma unroll
                    for (int e = 0; e < 4; ++e) o[e] = (cv[0][e] * __builtin_amdgcn_rcpf(1.0f + __expf(-cv[0][e]))) * cv[1][e];
                    typedef unsigned u32x2_t __attribute__((ext_vector_type(2)));
                    u32x2_t w; w.x = pk2(o[0], o[1]); w.y = pk2(o[2], o[3]);
                    *(u32x2_t*)(ACT + (size_t)(row0 + ai * HALF + m) * FFn + c4) = w;
                }
            }
        }
    }
};
template <class Epi, class Sched, bool ALIGN_EPI = false, bool SP2 = false>
__device__ __forceinline__ void gemm_phase(PG8_LAS unsigned char* lds, const Gemm g, const Sched& S, const Epi& E, const int tid_) {
    const int tid = tid_, wid = __builtin_amdgcn_readfirstlane(tid >> 6), lane = tid & 63, wr = wid >> 2, wc = wid & 3, fr = lane & 15, fq = lane >> 4;
    const int K = g.K, nt = K / BK;
    unsigned voffA[2], voffB[2];
#pragma unroll
    for (int i = 0; i < 2; ++i) { int R, C; stage_rc(tid * 16 + i * 8192, R, C); const int Rb = Epi::PERM ? ((R & ~31) + perm32(R & 31)) : R;
        const int Ra = Epi::PERMA ? ((R & 64) + 4 * (R & 15) + ((R >> 4) & 3)) : R;
        voffA[i] = (unsigned)(Ra * K + C) * 2u; voffB[i] = (unsigned)(Rb * K + C) * 2u; }
    const size_t kstep = (size_t)(BK * 2);
    const size_t hstep = (size_t)HALF * K * 2;
    const size_t tstep = 2 * hstep;
    const unsigned ldsw = (unsigned)wid * 1024u;
    const int aoff = lds_byte(wr * 64 + fr, fq * 8), boff = lds_byte(wc * 32 + fr, fq * 8);
#define PG8_SA(b, h) (((b) * 2 + (h)) * HTB)
#define PG8_SB(b, h) ((4 + (b) * 2 + (h)) * HTB)
#define PG8_STAGE(bufoff, gbase, voff) do { _Pragma("unroll") for (int _i = 0; _i < 2; ++_i) \
        __builtin_amdgcn_global_load_lds((const unsigned*)((const char*)(gbase) + (voff)[_i]), (PG8_LAS unsigned*)(lds + (bufoff) + ldsw + _i * 8192), 16, 0, 0); } while (0)
#define PG8_LDA(dst, b, h) do { _Pragma("unroll") for (int m = 0; m < 4; ++m) _Pragma("unroll") for (int k = 0; k < 2; ++k) dst[m][k] = *(const PG8_LAS bf16x8*)(lds + PG8_SA(b, h) + aoff + m * 2048 + k * 1024); } while (0)
#define PG8_LDB(dst, b, h) do { _Pragma("unroll") for (int n = 0; n < 2; ++n) _Pragma("unroll") for (int k = 0; k < 2; ++k) dst[n][k] = *(const PG8_LAS bf16x8*)(lds + PG8_SB(b, h) + boff + n * 2048 + k * 1024); } while (0)
#define PG8_MMA(ai, bj, At, Bt) do { __builtin_amdgcn_s_setprio(1); _Pragma("unroll") for (int m = 0; m < 4; ++m) _Pragma("unroll") for (int n = 0; n < 2; ++n) _Pragma("unroll") for (int k = 0; k < 2; ++k) \
        acc[ai][bj][m][n] = __builtin_amdgcn_mfma_f32_16x16x32_bf16(Bt[n][k], At[m][k], acc[ai][bj][m][n], 0, 0, 0); __builtin_amdgcn_s_setprio(0); } while (0)
#define PG8_WAIT_V(n) asm volatile("s_waitcnt vmcnt(" #n ")" ::: "memory")
#define PG8_WAIT_L(n) asm volatile("s_waitcnt lgkmcnt(" #n ")" ::: "memory")
#define PG8_BAR __builtin_amdgcn_s_barrier()
#define PG8_SCHED __builtin_amdgcn_sched_barrier(0)
    Unit cur, nxt; int ui = 0;
    if (!S.next(0, cur)) return;
    f32x4 acc[2][2][4][2];
#pragma unroll
    for (int a = 0; a < 2; ++a)
#pragma unroll
        for (int b = 0; b < 2; ++b)
#pragma unroll
            for (int m = 0; m < 4; ++m)
#pragma unroll
                for (int n = 0; n < 2; ++n) acc[a][b][m][n] = (f32x4){0.f, 0.f, 0.f, 0.f};
    bf16x8 At[4][2], B0[2][2], B1[2][2];
    const char* cA = (const char*)g.A + (size_t)cur.pm * tstep; const char* cB = (const char*)g.Bt + (size_t)cur.pn * tstep;
    S.a_ready(cur);
    if constexpr (SP2) {
        PG8_STAGE(PG8_SB(0, 0), cB, voffB); PG8_STAGE(PG8_SB(0, 1), cB + hstep, voffB); PG8_STAGE(PG8_SA(0, 0), cA, voffA); PG8_STAGE(PG8_SA(0, 1), cA + hstep, voffA);
        if (wr == 1) PG8_BAR;
        PG8_WAIT_V(2); PG8_BAR;
        PG8_STAGE(PG8_SB(1, 0), cB + kstep, voffB); PG8_STAGE(PG8_SA(1, 0), cA + kstep, voffA); PG8_STAGE(PG8_SB(1, 1), cB + hstep + kstep, voffB);
        PG8_WAIT_V(6); PG8_BAR;
    } else {
    PG8_STAGE(PG8_SB(0, 0), cB, voffB); PG8_STAGE(PG8_SA(0, 0), cA, voffA); PG8_STAGE(PG8_SB(0, 1), cB + hstep, voffB); PG8_STAGE(PG8_SA(0, 1), cA + hstep, voffA);
    if (wr == 1) PG8_BAR;
    PG8_WAIT_V(4); PG8_BAR;
    PG8_STAGE(PG8_SB(1, 0), cB + kstep, voffB); PG8_STAGE(PG8_SA(1, 0), cA + kstep, voffA); PG8_STAGE(PG8_SB(1, 1), cB + hstep + kstep, voffB);
    PG8_WAIT_V(6); PG8_BAR;
    }
    for (;;) {
        const bool has_next = S.next(ui + 1, nxt);
        const char* nA = has_next ? (const char*)g.A + (size_t)nxt.pm * tstep : cA; const char* nB = has_next ? (const char*)g.Bt + (size_t)nxt.pn * tstep : cB;
        for (int t = 0; t < nt; t += 2) {
            const bool last = (t == nt - 2);
            const char* a1 = cA + (size_t)(t + 1) * kstep;
            const char* a2 = last ? nA : cA + (size_t)(t + 2) * kstep; const char* b2 = last ? nB : cB + (size_t)(t + 2) * kstep;
            const char* a3 = a2 + kstep; const char* b3 = b2 + kstep;
            if (last && has_next) S.a_ready(nxt);
            if constexpr (SP2) {
            PG8_LDB(B0, 0, 0); PG8_LDB(B1, 0, 1); PG8_SCHED; PG8_LDA(At, 0, 0); PG8_STAGE(PG8_SA(1, 1), a1 + hstep, voffA);
            PG8_WAIT_V(8); PG8_WAIT_L(0); PG8_BAR; PG8_MMA(0, 0, At, B0); PG8_MMA(0, 1, At, B1); PG8_BAR; PG8_SCHED;
            PG8_LDA(At, 0, 1); PG8_STAGE(PG8_SB(0, 0), b2, voffB); PG8_STAGE(PG8_SB(0, 1), b2 + hstep, voffB); PG8_STAGE(PG8_SA(0, 0), a2, voffA);
            PG8_WAIT_V(8); PG8_WAIT_L(0); PG8_BAR; PG8_MMA(1, 0, At, B0); PG8_MMA(1, 1, At, B1); PG8_BAR; PG8_SCHED;
            PG8_LDB(B0, 1, 0); PG8_LDB(B1, 1, 1); PG8_SCHED; PG8_LDA(At, 1, 0); PG8_STAGE(PG8_SA(0, 1), a2 + hstep, voffA);
            PG8_WAIT_V(8); PG8_WAIT_L(0); PG8_BAR; PG8_MMA(0, 0, At, B0); PG8_MMA(0, 1, At, B1); PG8_BAR; PG8_SCHED;
            PG8_LDA(At, 1, 1); PG8_STAGE(PG8_SB(1, 0), b3, voffB); PG8_STAGE(PG8_SB(1, 1), b3 + hstep, voffB); PG8_STAGE(PG8_SA(1, 0), a3, voffA);
            PG8_WAIT_V(8); PG8_WAIT_L(0); PG8_BAR; PG8_MMA(1, 0, At, B0); PG8_MMA(1, 1, At, B1); PG8_BAR; PG8_SCHED;
            } else {
            PG8_LDB(B0, 0, 0); PG8_SCHED; PG8_LDA(At, 0, 0); PG8_STAGE(PG8_SA(1, 1), a1 + hstep, voffA);
            PG8_WAIT_L(8); PG8_BAR; PG8_WAIT_L(0); PG8_MMA(0, 0, At, B0); PG8_BAR; PG8_SCHED;
            PG8_LDB(B1, 0, 1); PG8_STAGE(PG8_SB(0, 0), b2, voffB);
            PG8_BAR; PG8_WAIT_L(0); PG8_MMA(0, 1, At, B1); PG8_BAR;
            PG8_LDA(At, 0, 1); PG8_STAGE(PG8_SA(0, 0), a2, voffA);
            PG8_BAR; PG8_WAIT_L(0); PG8_MMA(1, 0, At, B0); PG8_BAR; PG8_SCHED;
            PG8_STAGE(PG8_SB(0, 1), b2 + hstep, voffB);
            PG8_WAIT_V(6); PG8_BAR; PG8_MMA(1, 1, At, B1); PG8_BAR;
            PG8_LDB(B0, 1, 0); PG8_SCHED; PG8_LDA(At, 1, 0); PG8_STAGE(PG8_SA(0, 1), a2 + hstep, voffA);
            PG8_WAIT_L(8); PG8_BAR; PG8_WAIT_L(0); PG8_MMA(0, 0, At, B0); PG8_BAR; PG8_SCHED;
            PG8_LDB(B1, 1, 1); PG8_STAGE(PG8_SB(1, 0), b3, voffB);
            PG8_BAR; PG8_WAIT_L(0); PG8_MMA(0, 1, At, B1); PG8_BAR;
            PG8_LDA(At, 1, 1); PG8_STAGE(PG8_SA(1, 0), a3, voffA);
            PG8_BAR; PG8_WAIT_L(0); PG8_MMA(1, 0, At, B0); PG8_BAR; PG8_SCHED;
            PG8_STAGE(PG8_SB(1, 1), b3 + hstep, voffB);
            PG8_WAIT_V(6); PG8_BAR; PG8_MMA(1, 1, At, B1); PG8_BAR;
            }
        }
        if constexpr (ALIGN_EPI) { if (wr == 0) PG8_BAR; }
        if constexpr (!Epi::AFTER_DRAIN) { E(acc, cur, wr, wc, fr, fq); S.done(cur); }
        if (!has_next) break;
#pragma unroll
        for (int a = 0; a < 2; ++a)
#pragma unroll
            for (int b = 0; b < 2; ++b)
#pragma unroll
                for (int m = 0; m < 4; ++m)
#pragma unroll
                    for (int n = 0; n < 2; ++n) acc[a][b][m][n] = (f32x4){0.f, 0.f, 0.f, 0.f};
        cur = nxt; cA = nA; cB = nB; ++ui;
        if constexpr (ALIGN_EPI) { if (wr == 1) PG8_BAR; }
    }
    PG8_WAIT_V(0);
    if constexpr (!ALIGN_EPI) { if (wr == 0) PG8_BAR; }
    PG8_BAR;
    if constexpr (Epi::AFTER_DRAIN) { E.fused(acc, cur, wr, wc, fr, fq, lds, wid, lane); S.done(cur); }
#undef PG8_SA
#undef PG8_SB
#undef PG8_STAGE
#undef PG8_LDA
#undef PG8_LDB
#undef PG8_MMA
#undef PG8_WAIT_V
#undef PG8_WAIT_L
#undef PG8_BAR
#undef PG8_SCHED
}
}

constexpr int DM = 2048, NB = 8, SEQ = 4096, CTXL = 256, TT = CTXL + SEQ, MROWS = NB * TT, NLAYER = 4;
constexpr int NH = 8, DK = 128, DV = 256, FF = 5632, UPN = 2 * FF, INC = 16416, MODW = 6 * DM;
constexpr int N1 = 8448, N2 = 8192, LDP = 8192;
constexpr int NCH = TT / 128;
constexpr float EPSN = 1e-6f, LOG2E = 1.4426950408889634f, QSCALE = 0.08838834764831845f;
constexpr int NWAVES = 8, NTHR = 512;

constexpr size_t WS_CTL = 0, CTL_ZERO_BYTES = 65536;
constexpr size_t WS_MOD = 1u << 20;
constexpr size_t WS_ROPE = WS_MOD + (size_t)NLAYER * 9 * MODW * 4;
constexpr size_t WS_GATES = WS_ROPE + 64 * 32 * 2 * 4;
constexpr size_t WS_GA = WS_GATES + (size_t)MROWS * 32 * 4;
constexpr size_t WS_GMX = WS_GA + (size_t)2 * MROWS * 8 * 4;
constexpr size_t WS_GCUM = WS_GMX + (size_t)2 * MROWS * 8 * 4;
constexpr size_t WS_XC = WS_GCUM + (size_t)2 * MROWS * 8 * 4;
constexpr size_t WS_W1T = WS_XC + (size_t)NB * CTXL * DM * 4;
constexpr size_t WS_W2T = WS_W1T + (size_t)N1 * DM * 2;
constexpr size_t WS_WRO = WS_W2T + (size_t)N2 * DM * 2;
constexpr size_t WS_WMO = WS_WRO + (size_t)DM * DM * 2;
constexpr size_t WS_WO = WS_WMO + (size_t)DM * DM * 2;
constexpr size_t WS_WUT = WS_WO + (size_t)DM * DM * 2;
constexpr size_t WS_WDT = WS_WUT + (size_t)UPN * DM * 2;
constexpr size_t WS_H = WS_WDT + (size_t)DM * FF * 2;
constexpr size_t SLOT = (size_t)MROWS * DM * 2;
constexpr size_t WS_ARENA = WS_H + SLOT;
constexpr size_t WS_PROJ = WS_ARENA;
constexpr size_t WS_MQK = WS_PROJ + (size_t)MROWS * LDP * 2;
constexpr size_t WS_Y4 = WS_MQK + SLOT;
constexpr size_t WS_U = WS_ARENA;
constexpr size_t WS_ACT = WS_U + (size_t)MROWS * UPN * 2;
constexpr size_t WS_OUTF = WS_ARENA;
constexpr size_t WS_RAW = WS_Y4 + 4 * SLOT;
constexpr size_t WS_RAWQ = WS_RAW + (size_t)(MROWS / 256) * 4 * UPN * 2;
constexpr size_t WS_IMG = WS_RAWQ + (size_t)(MROWS / 256) * 4 * 2048 * 2;
constexpr size_t WS_SS = WS_IMG + (size_t)256 * 18 * 8 * 8192;
constexpr size_t WS_END = WS_SS + (size_t)16 * MROWS * 4;
static_assert(WS_ACT + (size_t)MROWS * FF * 2 <= WS_RAW, "ACT inside the arena");
static_assert(WS_W1T % 256 == 0 && WS_H % 256 == 0 && WS_ARENA % 256 == 0 && WS_ACT % 256 == 0, "alignment");

constexpr int NP2_OFF = 156160;
constexpr int PSUM2_OFF = 160256;
constexpr int LDS_BYTES = 162304, AUX_OFF = 131072, MISC_OFF = 139264, PBUF_OFF = 139776;

#define LAS __attribute__((address_space(3)))
typedef unsigned short bf16;
typedef short bf16x8 __attribute__((ext_vector_type(8)));
typedef short s16x4 __attribute__((ext_vector_type(4)));
typedef float f32x4 __attribute__((ext_vector_type(4)));
typedef float f32x16 __attribute__((ext_vector_type(16)));
typedef unsigned u32x4 __attribute__((ext_vector_type(4)));
typedef unsigned u32x2 __attribute__((ext_vector_type(2)));
using pg8::pk2; using pg8::bflo; using pg8::bfhi;
#define LDS_WAIT() asm volatile("s_waitcnt lgkmcnt(0)" ::: "memory")
#define VM_WAIT() asm volatile("s_waitcnt vmcnt(0)" ::: "memory")

#define XB_TMO      128
#define XB_XCNT(j)  (256  + 64 * (j))
#define XB_XSUB(j)  (1280 + 64 * (j))
#define XB_XGEN(j)  (2304 + 64 * (j))
#define XB_TOP      3328
#define XB_TOPGEN   3392
#define XCD_BAR_WORDS 3456
#define XB_SPIN_CAP (1u << 18)

__device__ __forceinline__ unsigned xb_ld(unsigned* p)              { return __hip_atomic_load(p, __ATOMIC_RELAXED, __HIP_MEMORY_SCOPE_AGENT); }
__device__ __forceinline__ unsigned xb_add(unsigned* p, unsigned v) { return __hip_atomic_fetch_add(p, v, __ATOMIC_RELAXED, __HIP_MEMORY_SCOPE_AGENT); }
__device__ __forceinline__ unsigned xb_xcc_id() { return (unsigned)__builtin_amdgcn_s_getreg((3 << 11) | 20) & 0xFu; }
#define XB_SPIN(cond, bar) do { unsigned _sp = 0; while (cond) { __builtin_amdgcn_s_sleep(1); \
    if ((++_sp & 255u) == 0u) { if (xb_ld(&(bar)[XB_TMO])) break; if (_sp > XB_SPIN_CAP) { atomicAdd(&(bar)[XB_TMO], 1u); break; } } } } while (0)

struct XcdBarrier {
    unsigned* bar; unsigned x;
    volatile LAS unsigned* st;
};

__device__ __forceinline__ XcdBarrier xcd_barrier_post(unsigned* bar, volatile LAS unsigned* st) {
    XcdBarrier b; b.bar = bar; b.x = xb_xcc_id(); b.st = st;
    if (threadIdx.x == 0) (void)xb_add(&bar[XB_XCNT(b.x)], 1u);
    return b;
}
__device__ __forceinline__ void xcd_barrier_complete(unsigned* bar, unsigned x, unsigned& nloc, unsigned& nx) {
    const unsigned G = gridDim.x * gridDim.y * gridDim.z;
    unsigned sum, cnt, mine, sp = 0u;
    for (;;) {
        sum = 0u; cnt = 0u; mine = 0u;
#pragma unroll
        for (unsigned j = 0; j < 16; ++j) { const unsigned c = xb_ld(&bar[XB_XCNT(j)]); sum += c; cnt += (c > 0u) ? 1u : 0u; mine = (j == x) ? c : mine; }
        if (sum == G) break;
        __builtin_amdgcn_s_sleep(1);
        if ((++sp & 255u) == 0u) { if (xb_ld(&bar[XB_TMO])) break; if (sp > XB_SPIN_CAP) { atomicAdd(&bar[XB_TMO], 1u); break; } }
    }
    nloc = mine > 0u ? mine : 1u; nx = cnt > 0u ? cnt : 1u;
}

__device__ __forceinline__ void xcd_barrier(const XcdBarrier& b) {
    asm volatile("s_waitcnt vmcnt(0)" ::: "memory");
    __syncthreads();
    if (threadIdx.x == 0) {
        unsigned* bar = b.bar;
        __builtin_amdgcn_s_waitcnt(0);
        unsigned nloc = b.st[0], nx = b.st[1];
        if (nloc == 0u) { xcd_barrier_complete(bar, b.x, nloc, nx); b.st[0] = nloc; b.st[1] = nx; }
        const unsigned old = xb_add(&bar[XB_XSUB(b.x)], 1u);
        const unsigned gen = old / nloc;
        if (old + 1u == (gen + 1u) * nloc) {
            __builtin_amdgcn_fence(__ATOMIC_RELEASE, "agent");
            asm volatile("s_waitcnt vmcnt(0)" ::: "memory");
            const unsigned og = xb_add(&bar[XB_TOP], 1u);
            const unsigned tg = og / nx;
            if (og + 1u == (tg + 1u) * nx) xb_add(&bar[XB_TOPGEN], 1u);
            else XB_SPIN(xb_ld(&bar[XB_TOPGEN]) == tg, bar);
            __builtin_amdgcn_fence(__ATOMIC_ACQUIRE, "agent");
            xb_add(&bar[XB_XGEN(b.x)], 1u);
            asm volatile("s_waitcnt vmcnt(0)" ::: "memory");
        } else {
            XB_SPIN(xb_ld(&bar[XB_XGEN(b.x)]) == gen, bar);
            __builtin_amdgcn_fence(__ATOMIC_ACQUIRE, "agent");
            asm volatile("s_waitcnt vmcnt(0)" ::: "memory");
        }
    }
    __syncthreads();
}

struct Ctx {
    LAS unsigned char* lds;
    int tid, lane, wave, vcu, G;
    float* out; unsigned char* ws;
    __device__ __forceinline__ const float* inp(int i) const { const float* const* ka = (const float* const*)__builtin_amdgcn_kernarg_segment_ptr(); return ka[i]; }
};
#define GAS __attribute__((address_space(1)))
template <class T> __device__ __forceinline__ const GAS T* gptr(const T* p) { return (const GAS T*)p; }
template <class T> __device__ __forceinline__ GAS T* gptr(T* p) { return (GAS T*)p; }
#define WV_DPP(old, x, ctrl) __builtin_bit_cast(float, __builtin_amdgcn_update_dpp(__builtin_bit_cast(int, (float)(old)), __builtin_bit_cast(int, (float)(x)), (ctrl), 0xf, 0xf, false))
__device__ __forceinline__ float swz_xor16(float v) { return __builtin_bit_cast(float, __builtin_amdgcn_ds_swizzle(__builtin_bit_cast(int, v), 0x401F)); }
__device__ __forceinline__ float bperm_f(float v, int src_lane) { return __builtin_bit_cast(float, __builtin_amdgcn_ds_bpermute(src_lane << 2, __builtin_bit_cast(int, v))); }
__device__ __forceinline__ float quad_sum(float v) { v += WV_DPP(0.f, v, 0xB1); v += WV_DPP(0.f, v, 0x4E); return v; }
__device__ __forceinline__ float wave_sum(float v) {
    v = quad_sum(v); v += WV_DPP(0.f, v, 0x141); v += WV_DPP(0.f, v, 0x140);
    v += swz_xor16(v);
    return __builtin_bit_cast(float, __builtin_amdgcn_readlane(__builtin_bit_cast(int, v), 0)) + __builtin_bit_cast(float, __builtin_amdgcn_readlane(__builtin_bit_cast(int, v), 32));
}
__device__ __forceinline__ float silu_f(float x) { return x * __builtin_amdgcn_rcpf(1.0f + __expf(-x)); }
__device__ __forceinline__ float sigmoid_f(float x) { return __builtin_amdgcn_rcpf(1.0f + __expf(-x)); }

__device__ __forceinline__ void mod_phase(const Ctx& C, int l0, int nl, int start, int stride) {
    LAS float* SC = (LAS float*)C.lds;
    LAS float* RED = (LAS float*)(C.lds + 73728);
    const float* cin = C.inp(1); const float* cctx = C.inp(3); const float* w_ada = C.inp(4); const float* b_ada = C.inp(5);
    float* MOD = (float*)(C.ws + WS_MOD);
    for (int e = C.tid; e < 9 * DM; e += NTHR) { const float v = e < 8 * DM ? cin[e] : cctx[e - 8 * DM]; SC[e] = silu_f(v); }
    __syncthreads();
    for (int it = start; it < nl * 192; it += stride) {
        const int l = l0 + it / 192, cg = it % 192, col = cg * 64 + C.lane;
        const float* wp = w_ada + ((size_t)l * DM + C.wave * 256) * MODW + col;
        float acc[9];
#pragma unroll
        for (int b = 0; b < 9; ++b) acc[b] = 0.f;
        float wa[16], wb[16];
#pragma unroll
        for (int j = 0; j < 16; ++j) wa[j] = __builtin_nontemporal_load(gptr(wp + (size_t)j * MODW));
#pragma unroll 1
        for (int k0 = 0; k0 < 256; k0 += 32) {
#pragma unroll
            for (int j = 0; j < 16; ++j) wb[j] = __builtin_nontemporal_load(gptr(wp + (size_t)(k0 + 16 + j) * MODW));
            __builtin_amdgcn_sched_barrier(0);
#pragma unroll
            for (int j = 0; j < 16; ++j) { const int k = C.wave * 256 + k0 + j;
#pragma unroll
                for (int b = 0; b < 9; ++b) acc[b] += SC[b * DM + k] * wa[j]; }
            __builtin_amdgcn_sched_barrier(0);
            { const int kn = k0 + 32 < 256 ? k0 + 32 : 240;
#pragma unroll
              for (int j = 0; j < 16; ++j) wa[j] = __builtin_nontemporal_load(gptr(wp + (size_t)(kn + j) * MODW)); }
            __builtin_amdgcn_sched_barrier(0);
#pragma unroll
            for (int j = 0; j < 16; ++j) { const int k = C.wave * 256 + k0 + 16 + j;
#pragma unroll
                for (int b = 0; b < 9; ++b) acc[b] += SC[b * DM + k] * wb[j]; }
            __builtin_amdgcn_sched_barrier(0);
        }
#pragma unroll
        for (int b = 0; b < 9; ++b) RED[(C.wave * 9 + b) * 64 + C.lane] = acc[b];
        __syncthreads();
        for (int e = C.tid; e < 576; e += NTHR) { const int b = e >> 6, ln = e & 63; float s = 0.f;
#pragma unroll
            for (int w = 0; w < 8; ++w) s += RED[(w * 9 + b) * 64 + ln];
            MOD[((size_t)l * 9 + b) * MODW + cg * 64 + ln] = s + b_ada[(size_t)l * MODW + cg * 64 + ln]; }
        __syncthreads();
    }
}
__device__ __forceinline__ void rope_table(const Ctx& C) {
    const int gt = C.vcu * NTHR + C.tid;
    if (gt < 2048) {
        const int pos = gt >> 5, p = gt & 31;
        double f = 1.0; const double f1 = 0.74989420933245582;
        for (int i = 0; i < p; ++i) f *= f1;
        const double x = (double)pos * f;
        const double kq = __builtin_rint(x * 0.63661977236758134308);
        const double rr = (x - kq * 1.57079632679489655800) - kq * 6.12323399573676603587e-17;
        const double r2 = rr * rr;
        double sn = rr * (1.0 + r2 * (-1.0 / 6 + r2 * (1.0 / 120 + r2 * (-1.0 / 5040 + r2 * (1.0 / 362880 + r2 * (-1.0 / 39916800 + r2 * (1.0 / 6227020800.0)))))));
        double cs = 1.0 + r2 * (-0.5 + r2 * (1.0 / 24 + r2 * (-1.0 / 720 + r2 * (1.0 / 40320 + r2 * (-1.0 / 3628800 + r2 * (1.0 / 479001600.0 + r2 * (-1.0 / 87178291200.0)))))));
        const int q = ((int)kq) & 3;
        const double s_out = (q == 0) ? sn : (q == 1) ? cs : (q == 2) ? -sn : -cs;
        const double c_out = (q == 0) ? cs : (q == 1) ? -sn : (q == 2) ? -cs : sn;
        float* T = (float*)(C.ws + WS_ROPE);
        T[gt] = (float)c_out; T[2048 + gt] = (float)s_out;
    }
}
__device__ __forceinline__ int w1_src(int n) {
    if (n < 2048) { const int base = n < 1024 ? 0 : 1024, nn = n & 1023, head = nn >> 7, j = nn & 127, blk = j >> 6, jj = j & 63; return base + head * 128 + blk * 64 + (jj & 1) * 32 + (jj >> 1); }
    if (n < 4096) return 2048 + (n - 2048);
    if (n < 5120) return 6144 + (n - 4096);
    if (n < 6144) return 7168 + (n - 5120);
    if (n < 8192) return 8192 + (n - 6144);
    if (n < 8224) return 12288 + (n - 8192);
    return -1;
}
__device__ __forceinline__ int w2_src(int n) {
    if (n < 2048) return 4096 + n;
    if (n < 4096) return 10240 + (n - 2048);
    return 12320 + (n - 4096);
}
__device__ __forceinline__ void tr_item(const float* W, int K, int N, bf16* WT, int mode, LAS float* scr, int item, int nblk, int lane) {
    const int kb = item / nblk, nb = item % nblk, k0 = 128 * kb, n0 = 32 * nb;
    const int nd = n0 + (lane & 31);
    const int sc = mode == 1 ? w1_src(nd) : (mode == 2 ? w2_src(nd) : (mode == 3 ? ((nd & 128) ? FF + 128 * (nd >> 8) + (nd & 127) : 128 * (nd >> 8) + (nd & 127)) : nd));
    float wv[64];
    { const float* wp = W + (size_t)(k0 + (lane >> 5)) * N + (sc >= 0 ? sc : 0);
#pragma unroll
      for (int i = 0; i < 64; ++i) wv[i] = __builtin_nontemporal_load(gptr(wp + (size_t)(2 * i) * N)); }
#pragma unroll
    for (int i = 0; i < 64; ++i) { const int kk = 2 * i + (lane >> 5); scr[kk * 33 + (lane & 31)] = sc >= 0 ? wv[i] : 0.f; }
    LDS_WAIT(); asm volatile("" ::: "memory");
    const int c = lane & 15;
#pragma unroll
    for (int j = 0; j < 8; ++j) { const int n = (lane >> 4) + 4 * j; const LAS float* s = scr + (8 * c) * 33 + n;
        u32x4 o; o.x = pk2(s[0 * 33], s[1 * 33]); o.y = pk2(s[2 * 33], s[3 * 33]); o.z = pk2(s[4 * 33], s[5 * 33]); o.w = pk2(s[6 * 33], s[7 * 33]);
        *(u32x4*)(WT + (size_t)(n0 + n) * K + k0 + 8 * c) = o; }
    LDS_WAIT(); asm volatile("" ::: "memory");
}
constexpr int CV_I0 = 16 * 264, CV_I1 = CV_I0 + 16 * 256, CV_I2 = CV_I1 + 1024, CV_I3 = CV_I2 + 1024, CV_I4 = CV_I3 + 1024, CV_I5 = CV_I4 + 16 * 352, CV_I6 = CV_I5 + 44 * 64;
__device__ __forceinline__ void convert_weights(const Ctx& C, int l, int lo, int hi, int iw, int nw) {
    LAS float* scr = (LAS float*)(C.lds + C.wave * 17408);
    if (iw < 0) return;
    const float* w_in = C.inp(7) + (size_t)l * DM * INC;
    const float* w_ro = C.inp(13) + (size_t)l * DM * DM; const float* w_mo = C.inp(14) + (size_t)l * DM * DM; const float* w_o = C.inp(15) + (size_t)l * DM * DM;
    const float* w_up = C.inp(16) + (size_t)l * DM * UPN; const float* w_dn = C.inp(19) + (size_t)l * FF * DM;
    constexpr int I0 = CV_I0, I1 = CV_I1, I2 = CV_I2, I3 = CV_I3, I4 = CV_I4, I5 = CV_I5;
    for (int it = lo + iw; it < hi; it += nw) {
        if (it < I0) tr_item(w_in, DM, INC, (bf16*)(C.ws + WS_W1T), 1, scr, it, 264, C.lane);
        else if (it < I1) tr_item(w_in, DM, INC, (bf16*)(C.ws + WS_W2T), 2, scr, it - I0, 256, C.lane);
        else if (it < I2) tr_item(w_ro, DM, DM, (bf16*)(C.ws + WS_WRO), 0, scr, it - I1, 64, C.lane);
        else if (it < I3) tr_item(w_mo, DM, DM, (bf16*)(C.ws + WS_WMO), 0, scr, it - I2, 64, C.lane);
        else if (it < I4) tr_item(w_o, DM, DM, (bf16*)(C.ws + WS_WO), 0, scr, it - I3, 64, C.lane);
        else if (it < I5) tr_item(w_up, DM, UPN, (bf16*)(C.ws + WS_WUT), 3, scr, it - I4, 352, C.lane);
        else tr_item(w_dn, FF, DM, (bf16*)(C.ws + WS_WDT), 0, scr, it - I5, 64, C.lane);
    }
}
__device__ __forceinline__ void wait_count(const Ctx& C, unsigned* p, unsigned tgt) {
    if (C.tid == 0) { unsigned sp = 0u; while (xb_ld(p) < tgt) { __builtin_amdgcn_s_sleep(2); if (++sp > (1u << 22)) break; }
        __builtin_amdgcn_fence(__ATOMIC_ACQUIRE, "agent"); asm volatile("s_waitcnt vmcnt(0)" ::: "memory"); }
    __syncthreads();
}
template <bool UPD, bool MKH>
__device__ __forceinline__ void rn_phase(const Ctx& C, int skip_ctx, const float* xin_lat, const float* xin_ctx, float* xout_lat, float* xout_ctx, const bf16* OUT,
                                         const float* modu, int g_idx, const float* nw_post, const float* modh, int sh_idx, int sc_idx, const float* nw_pre, bf16* Hout,
                                         unsigned* cnt_lat = nullptr, unsigned tgt_lat = 0, unsigned* cnt_ctx = nullptr, unsigned tgt_ctx = 0) {
    LAS float* TAB = (LAS float*)C.lds;
    const int b = C.vcu >> 5, cl = C.vcu & 31;
    __syncthreads();
#pragma unroll
    for (int k = 0; k < 2; ++k) { const int idx = C.tid + NTHR * k, set = idx >> 9, col = (idx & 511) * 4, mi = set ? NB : b;
        if (UPD) { const f32x4 g = *(const f32x4*)(modu + (size_t)mi * MODW + g_idx * DM + col), nw = *(const f32x4*)(nw_post + col); *(LAS f32x4*)(TAB + (set * 3 + 0) * DM + col) = g * nw; }
        if (MKH) { const f32x4 nw = *(const f32x4*)(nw_pre + col), sh = *(const f32x4*)(modh + (size_t)mi * MODW + sh_idx * DM + col), sc = *(const f32x4*)(modh + (size_t)mi * MODW + sc_idx * DM + col);
            *(LAS f32x4*)(TAB + (set * 3 + 1) * DM + col) = nw * (sc + 1.0f); *(LAS f32x4*)(TAB + (set * 3 + 2) * DM + col) = sh; } }
    __syncthreads();
    auto run = [&](const bool isctx, const int t0, const int ts, const int n) {
        auto row_of = [&](int i, size_t& xoff) { const int t = t0 + i * ts; xoff = isctx ? ((size_t)b * CTXL + t) * DM : ((size_t)b * SEQ + t) * DM; return b * TT + (isctx ? t : CTXL + t); };
        auto load_row = [&](int i, f32x4 (&xv)[8], u32x2 (&ow)[8]) { size_t xo_; const int r = row_of(i, xo_); const float* xi = (isctx ? xin_ctx : xin_lat) + xo_;
#pragma unroll
            for (int j = 0; j < 8; ++j) { xv[j] = __builtin_nontemporal_load(gptr((const f32x4*)(xi + 4 * C.lane + 256 * j))); if (UPD) ow[j] = __builtin_nontemporal_load(gptr((const u32x2*)(OUT + (size_t)r * DM + 4 * C.lane + 256 * j))); } };
        auto process = [&](int i, f32x4 (&xv)[8], u32x2 (&ow)[8]) {
            size_t xoff; const int r = row_of(i, xoff);
            LAS const float* tb = TAB + (isctx ? 3 * DM : 0) + 4 * C.lane;
            if (UPD) {
                f32x4 ov[8]; float ss = 0.f;
#pragma unroll
                for (int j = 0; j < 8; ++j) { const u32x2 w = ow[j];
                    ov[j] = (f32x4){bflo(w.x), bfhi(w.x), bflo(w.y), bfhi(w.y)}; ss += (ov[j][0] * ov[j][0] + ov[j][1] * ov[j][1]) + (ov[j][2] * ov[j][2] + ov[j][3] * ov[j][3]); }
                const float r1 = __builtin_amdgcn_rsqf(wave_sum(ss) * (1.0f / DM) + EPSN);
                float* xo = (isctx ? xout_ctx : xout_lat) + xoff;
#pragma unroll
                for (int j = 0; j < 8; ++j) { const int col = 4 * C.lane + 256 * j; const f32x4 gn = *(LAS const f32x4*)(tb + 256 * j);
                    xv[j] = xv[j] + gn * (ov[j] * r1); __builtin_nontemporal_store(xv[j], gptr((f32x4*)(xo + col))); }
            }
            if (MKH) {
                float ss = 0.f;
#pragma unroll
                for (int j = 0; j < 8; ++j) ss += (xv[j][0] * xv[j][0] + xv[j][1] * xv[j][1]) + (xv[j][2] * xv[j][2] + xv[j][3] * xv[j][3]);
                const float r2 = __builtin_amdgcn_rsqf(wave_sum(ss) * (1.0f / DM) + EPSN);
#pragma unroll
                for (int j = 0; j < 8; ++j) { const int col = 4 * C.lane + 256 * j; const f32x4 aw = *(LAS const f32x4*)(tb + DM + 256 * j), sh = *(LAS const f32x4*)(tb + 2 * DM + 256 * j);
                    const f32x4 hv = (xv[j] * r2) * aw + sh;
                    u32x2 w; w.x = pk2(hv[0], hv[1]); w.y = pk2(hv[2], hv[3]); *gptr((u32x2*)(Hout + (size_t)r * DM + col)) = w; }
            } };
        f32x4 xa[8], xb[8]; u32x2 oa[8], ob[8];
        load_row(0, xa, oa);
#pragma unroll 1
        for (int i = 0; i + 1 < n; i += 2) {
            load_row(i + 1, xb, ob); __builtin_amdgcn_sched_barrier(0); process(i, xa, oa); __builtin_amdgcn_sched_barrier(0);
            load_row(i + 2 < n ? i + 2 : n - 1, xa, oa); __builtin_amdgcn_sched_barrier(0); process(i + 1, xb, ob); __builtin_amdgcn_sched_barrier(0);
        }
        if (n & 1) process(n - 1, xa, oa);
    };
    if (cnt_lat == nullptr) {
        run(false, cl * 8 + C.wave, 256, 16);
        if (!skip_ctx) run(true, cl * 8 + C.wave, 0, 1);
    } else {
        unsigned* const wp = cl < 8 ? cnt_ctx : cnt_lat; const unsigned tgt = cl < 8 ? tgt_ctx : tgt_lat;
        if (C.tid == 0) { unsigned sp = 0u; while (xb_ld(wp) < tgt) { __builtin_amdgcn_s_sleep(2); if (++sp > (1u << 22)) break; }
            __builtin_amdgcn_fence(__ATOMIC_ACQUIRE, "agent"); asm volatile("s_waitcnt vmcnt(0)" ::: "memory"); }
        __syncthreads();
        if (cl < 8) run(true, cl * 8 + C.wave, 64, 4);
        else { const int t0 = (cl - 8) * 8 + C.wave; run(false, t0, 192, t0 < 64 ? 22 : 21); }
    }
}
__device__ __forceinline__ float wave_scan_add(float v, int lane) {
#pragma unroll
    for (int o = 1; o < 64; o <<= 1) { const float t = bperm_f(v, lane - o); if (lane >= o) v += t; }
    return v;
}
__device__ __forceinline__ float wave_scan_max(float v, int lane) {
#pragma unroll
    for (int o = 1; o < 64; o <<= 1) { const float t = bperm_f(v, lane - o); if (lane >= o) v = fmaxf(v, t); }
    return v;
}
__device__ __forceinline__ void conv_gate_phase(const Ctx& C, int l) {
    bf16* MQK = (bf16*)(C.ws + WS_MQK);
    const float* cw = C.inp(8) + (size_t)l * 3 * 2048; const float* cb = C.inp(9) + (size_t)l * 2048;
    {
        const bf16* RAWQ = (const bf16*)(C.ws + WS_RAWQ);
        const int gt = C.vcu * NTHR + C.tid, NT = C.G * NTHR;
        for (int idx = gt; idx < (MROWS / 256) * 2 * 256; idx += NT) {
            const int pm = idx >> 9, k = (idx >> 8) & 1, cg = idx & 255, j = pm % 17;
            if (j == 0 || (k == 0 && j == 1) || (k == 1 && j == 16)) continue;
            const bf16* P = k == 0 ? RAWQ + ((size_t)(pm - 1) * 4 + 3) * 2048 : RAWQ + ((size_t)pm * 4 + 2) * 2048;
            const bf16* Cc = k == 0 ? RAWQ + ((size_t)pm * 4 + 0) * 2048 : RAWQ + ((size_t)pm * 4 + 3) * 2048;
            const bf16* Nn = k == 0 ? RAWQ + ((size_t)pm * 4 + 1) * 2048 : RAWQ + ((size_t)(pm + 1) * 4 + 0) * 2048;
            const u32x4 xp = *(const u32x4*)(P + cg * 8), xc = *(const u32x4*)(Cc + cg * 8), xn = *(const u32x4*)(Nn + cg * 8);
            const unsigned pw[4] = {xp.x, xp.y, xp.z, xp.w}, cwd[4] = {xc.x, xc.y, xc.z, xc.w}, nwd[4] = {xn.x, xn.y, xn.z, xn.w};
            const float scl = cg < 128 ? QSCALE : 1.0f; float o[8];
#pragma unroll
            for (int q = 0; q < 4; ++q) { const int c0 = cg * 8 + 2 * q, c1 = c0 + 1;
                o[2 * q] = silu_f(cb[c0] + cw[c0] * bflo(pw[q]) + cw[2048 + c0] * bflo(cwd[q]) + cw[4096 + c0] * bflo(nwd[q])) * scl;
                o[2 * q + 1] = silu_f(cb[c1] + cw[c1] * bfhi(pw[q]) + cw[2048 + c1] * bfhi(cwd[q]) + cw[4096 + c1] * bfhi(nwd[q])) * scl; }
            u32x4 w; w.x = pk2(o[0], o[1]); w.y = pk2(o[2], o[3]); w.z = pk2(o[4], o[5]); w.w = pk2(o[6], o[7]);
            *(u32x4*)(MQK + ((size_t)pm * 256 + (k ? 255 : 0)) * DM + cg * 8) = w;
        }
    }
    {
        const float* GATES = (const float*)(C.ws + WS_GATES);
        float* GA = (float*)(C.ws + WS_GA); float* GMX = (float*)(C.ws + WS_GMX); float* GCUM = (float*)(C.ws + WS_GCUM);
        const int gw = C.vcu * NWAVES + C.wave, NGW = C.G * NWAVES;
        for (int it = gw; it < NB * 2 * NH * NCH; it += NGW) {
            const int ch = it % NCH, hh = (it / NCH) % NH, dir = (it / (NCH * NH)) & 1, b = it / (NCH * NH * 2);
            const int s0 = 2 * C.lane, s1 = s0 + 1, i0 = dir ? 127 - s0 : s0, i1 = dir ? 127 - s1 : s1;
            const size_t r0 = (size_t)b * TT + ch * 128 + i0, r1 = (size_t)b * TT + ch * 128 + i1;
            const float ig0 = GATES[r0 * 32 + dir * 16 + hh], fg0 = GATES[r0 * 32 + dir * 16 + 8 + hh];
            const float ig1 = GATES[r1 * 32 + dir * 16 + hh], fg1 = GATES[r1 * 32 + dir * 16 + 8 + hh];
            const float lf0 = fminf(fg0, 0.f) - __logf(1.0f + __expf(-fabsf(fg0))), lf1 = fminf(fg1, 0.f) - __logf(1.0f + __expf(-fabsf(fg1)));
            const float c1 = lf0 + lf1; const float incl = wave_scan_add(c1, C.lane); const float off = incl - c1;
            const float cum0 = off + lf0, cum1 = off + c1;
            const float a0 = ig0 - cum0, a1 = ig1 - cum1;
            const float m1 = fmaxf(a0, a1); const float mincl = wave_scan_max(m1, C.lane);
            float mprev = bperm_f(mincl, C.lane - 1); const float mx0 = C.lane == 0 ? a0 : fmaxf(mprev, a0); const float mx1 = mincl;
            const size_t o0 = ((size_t)dir * MROWS + r0) * 8 + hh, o1 = ((size_t)dir * MROWS + r1) * 8 + hh;
            GA[o0] = a0; GA[o1] = a1; GMX[o0] = mx0; GMX[o1] = mx1; GCUM[o0] = cum0; GCUM[o1] = cum1;
        }
    }
}
__device__ __forceinline__ unsigned off_b(unsigned row, unsigned ch) { return 256u * row + 16u * (ch ^ (((row & 3u) << 2) | ((row >> 2) & 3u))); }
__device__ __forceinline__ unsigned tr_addr(unsigned lane, unsigned c, unsigned ks, unsigned t) {
    const unsigned h = lane >> 5, blk = (lane >> 4) & 1u, q = (lane & 15u) >> 2, p = lane & 3u;
    return off_b(16u * ks + 8u * h + 4u * t + q, 4u * c + 2u * blk + (p >> 1)) + 8u * (p & 1u);
}
__device__ __forceinline__ bf16x8 tr_frag(LAS unsigned char* tile, unsigned lane, unsigned c, unsigned ks) {
    const s16x4 lo = __builtin_amdgcn_ds_read_tr16_b64_v4i16((LAS s16x4*)(tile + tr_addr(lane, c, ks, 0)));
    const s16x4 hi = __builtin_amdgcn_ds_read_tr16_b64_v4i16((LAS s16x4*)(tile + tr_addr(lane, c, ks, 1)));
    return __builtin_shufflevector(lo, hi, 0, 1, 2, 3, 4, 5, 6, 7);
}
__device__ __forceinline__ bf16x8 tr_frag2(LAS unsigned char* a0, LAS unsigned char* a1) {
    const s16x4 lo = __builtin_amdgcn_ds_read_tr16_b64_v4i16((LAS s16x4*)a0);
    const s16x4 hi = __builtin_amdgcn_ds_read_tr16_b64_v4i16((LAS s16x4*)a1);
    return __builtin_shufflevector(lo, hi, 0, 1, 2, 3, 4, 5, 6, 7);
}
__device__ __forceinline__ void stage_tile(LAS unsigned char* tile, const bf16* g, int ld, int wave, int lane) {
    const char* gb = (const char*)g;
#pragma unroll
    for (int i = 0; i < 4; ++i) {
        const unsigned o = (unsigned)(wave * 4 + i) * 1024u + (unsigned)lane * 16u;
        const unsigned row = o >> 8, chs = (o >> 4) & 15u, ch = chs ^ (((row & 3u) << 2) | ((row >> 2) & 3u));
        const unsigned voff = (row * (unsigned)ld + ch * 8u) * 2u;
        __builtin_amdgcn_global_load_lds((const unsigned*)(gb + voff), (LAS unsigned*)(tile + (wave * 4 + i) * 1024), 16, 0, 0);
    }
}
#define SC_DPP(v, ctrl) __builtin_bit_cast(float, __builtin_amdgcn_update_dpp(0, __builtin_bit_cast(int, (float)(v)), (ctrl), 0xf, 0xf, false))
__device__ __forceinline__ void emit_q(const f32x16& Yq, int q, LAS float* PSUMh, LAS float* PSUMh2, int wave, int lane, int r, int h, char* YNrow, int hf) {
#pragma unroll
    for (int g = 0; g < 4; ++g) { f32x4 s4;
#pragma unroll
        for (int e = 0; e < 4; ++e) { const float y = Yq[4 * g + e];
            const unsigned voff = (unsigned)(64 * hf + 32 * q + 8 * g + 4 * h + e) * (unsigned)(DM * 2) + (unsigned)r * 2u;
            const unsigned yb = pk2(y, 0.f) & 0xffffu; *(bf16*)(YNrow + voff) = (bf16)yb;
            float v = y * y;
            v += SC_DPP(v, 0xB1); v += SC_DPP(v, 0x4E); v += SC_DPP(v, 0x141); v += SC_DPP(v, 0x140);
            s4[e] = v; }
        if ((lane & 15) == 0) *(LAS f32x4*)(((lane & 16) ? PSUMh2 : PSUMh) + wave * 64 + 32 * q + 8 * g + 4 * h) = s4; }
}
__device__ __forceinline__ void reduce_ss(const LAS float* PSUMh, const LAS float* PSUMh2, int tid, float* SSrow) {
    if (tid < 64) { float s = 0.f;
#pragma unroll
        for (int w = 0; w < 8; ++w) s += PSUMh[w * 64 + tid] + PSUMh2[w * 64 + tid];
        SSrow[tid] = s; }
}
__device__ __forceinline__ void add_image(f32x16& y, const u32x4 a, const u32x4 b) {
    y[0] += bflo(a.x); y[1] += bfhi(a.x); y[2] += bflo(a.y); y[3] += bfhi(a.y); y[4] += bflo(a.z); y[5] += bfhi(a.z); y[6] += bflo(a.w); y[7] += bfhi(a.w);
    y[8] += bflo(b.x); y[9] += bfhi(b.x); y[10] += bflo(b.y); y[11] += bfhi(b.y); y[12] += bflo(b.z); y[13] += bfhi(b.z); y[14] += bflo(b.w); y[15] += bfhi(b.w);
}
constexpr int NSPLIT = NCH / 2 + 1;
#define MFMA32(a, b, c) __builtin_amdgcn_mfma_f32_32x32x16_bf16((a), (b), (c), 0, 0, 0)
__device__ __forceinline__ void scan_phase(const Ctx& C, int l, const XcdBarrier& bar) {
    LAS unsigned char* LQ = C.lds; LAS unsigned char* LK = C.lds + 32768; LAS unsigned char* LV = C.lds + 65536; LAS unsigned char* LP = C.lds + PBUF_OFF;
    LAS float* AUX = (LAS float*)(C.lds + AUX_OFF);
    LAS float* CJ = AUX; LAS float* RI = AUX + 128; LAS float* RS = AUX + 256; LAS float* WW = AUX + 384; LAS float* EMT = AUX + 512; LAS float* INV = AUX + 640;
    LAS float* QN = AUX + 768; LAS float* NV = AUX + 896; LAS float* RSUM = AUX + 1024; LAS float* NP2 = (LAS float*)(C.lds + NP2_OFF);
    const int tid_ = C.tid, lane_ = C.lane, wave = C.wave, r_ = lane_ & 31, h_ = lane_ >> 5;
    const bf16* PROJ = (const bf16*)(C.ws + WS_PROJ); const bf16* MQK = (const bf16*)(C.ws + WS_MQK);
    const float* GA = (const float*)(C.ws + WS_GA); const float* GMX = (const float*)(C.ws + WS_GMX); const float* GCUM = (const float*)(C.ws + WS_GCUM);
    const float* decay_exp = C.inp(11) + (size_t)l * 16;
    for (int u = C.vcu; u < 256; u += C.G) {
        const int dir = u & 1, br = (u >> 1) & 1, hh = (u >> 2) & 7, b = u >> 5;
        const bf16* Qg = br ? MQK + hh * 128 : PROJ + hh * 128;
        const bf16* Kg = br ? MQK + 1024 + hh * 128 : PROJ + 1024 + hh * 128;
        const bf16* Vg = br ? PROJ + 6144 + hh * 256 : PROJ + 2048 + hh * 256;
        const int ldq = br ? DM : LDP;
        char* const Yob = (char*)(C.ws + WS_Y4 + (size_t)(br * 2) * SLOT) + (hh * 256 + wave * 32) * 2;
        LAS float* PSUMh = AUX + 1536; LAS float* PSUMh2 = (LAS float*)(C.lds + PSUM2_OFF);
        float* const SSh = (float*)(C.ws + WS_SS) + (size_t)(br * 8 + hh) * MROWS;
        f32x16 S[4];
#pragma unroll
        for (int t = 0; t < 4; ++t)
#pragma unroll
            for (int e = 0; e < 16; ++e) S[t][e] = 0.f;
        float dec = 1.f, m = 0.f, m_next = 0.f;
        __syncthreads();
        int tidp = tid_; asm volatile("" : "+v"(tidp));
        if (br == 0) {
            const float lg2 = __log2f(1.0f - exp2f(-decay_exp[dir * 8 + hh]));
            dec = exp2f(128.f * lg2);
            if (tidp < 128) { const float i = (float)tidp;
                if (dir == 0) { CJ[tidp] = -i * lg2; RI[tidp] = -i * lg2; RS[tidp] = exp2f((i + 1.f) * lg2); WW[tidp] = exp2f((127.f - i) * lg2); }
                else { CJ[tidp] = i * lg2; RI[tidp] = i * lg2; RS[tidp] = exp2f((128.f - i) * lg2); WW[tidp] = exp2f(i * lg2); } }
        } else if (tidp < 128) NV[tidp] = 0.f;
        float pf_a = 0.f, pf_mx = 0.f, pf_cum = 0.f, pf_mxl = 0.f, pf_total = 0.f;
        if (br == 1) { const int ch0 = dir == 0 ? 0 : 1; const size_t rown = (size_t)b * TT + ch0 * 128;
            const size_t gl = ((size_t)dir * MROWS + rown + (dir == 0 ? 127 : 0)) * 8 + hh; pf_mxl = GMX[gl]; pf_total = GCUM[gl];
            if (tidp < 128) { const size_t gi = ((size_t)dir * MROWS + rown + tidp) * 8 + hh; pf_a = GA[gi]; pf_mx = GMX[gi]; pf_cum = GCUM[gi]; } }
        for (int n = 0; n < NCH; ++n) {
            int tid = tid_;
            asm volatile("" : "+v"(tid));
            const int lane = tid & 63, r = tid & 31, h = (tid >> 5) & 1;
            if (n == NSPLIT) { XcdBarrier b2_ = bar; asm volatile("" : "+s"(b2_.bar), "+s"(b2_.x)); xcd_barrier(b2_); }
            const int ch = dir == 0 ? n : (n < 2 ? 1 - n : NCH + 1 - n);
            const unsigned sw16 = (unsigned)((((r & 3) << 2) | ((r >> 2) & 3)) << 4), rb = 256u * (unsigned)r, rb8h = rb + 8u * (unsigned)h, swh16 = sw16 ^ (16u * (unsigned)h);
            const unsigned tq = ((unsigned)lane & 15u) >> 2, tp = (unsigned)lane & 3u, tblk = ((unsigned)lane >> 4) & 1u, tx = 2u * tblk + (tp >> 1);
            const unsigned tb0 = 256u * (8u * h + tq) + 8u * (tp & 1u), tb1 = tb0 + 1024u;
            const unsigned txs0 = 16u * (tx ^ (4u * tq + 2u * h)), txs1 = 16u * (tx ^ (4u * tq + 2u * h + 1u));
            const size_t row0 = (size_t)b * TT + ch * 128;
            char* const IMGs = (char*)(C.ws + WS_IMG) + ((size_t)u * NSPLIT * 8 + wave) * 8192 + lane * 128; const char* const IMGq = (const char*)(C.ws + WS_IMG) + ((size_t)(u ^ 1) * NSPLIT * 8 + wave) * 8192 + lane * 128;
            char* const Yrow = Yob + row0 * (size_t)(DM * 2);
            if (br == 1) {
                const float mml = fmaxf(m, pf_mxl); dec = __expf(m - mml); m_next = pf_total + mml;
                if (tid < 128) { const float mm = fmaxf(m, pf_mx);
                    CJ[tid] = pf_a * LOG2E; RI[tid] = mm * LOG2E; RS[tid] = __expf(m - mm); WW[tid] = __expf(pf_a - mml); EMT[tid] = __expf(-(pf_cum + mm)); }
            }
            stage_tile(LQ, Qg + row0 * ldq, ldq, wave, lane); stage_tile(LK, Kg + row0 * ldq, ldq, wave, lane);
            stage_tile(LV, Vg + row0 * LDP, LDP, wave, lane); stage_tile(LV + 32768, Vg + row0 * LDP + 128, LDP, wave, lane);
            asm volatile("s_waitcnt vmcnt(8)" ::: "memory"); LDS_WAIT(); __builtin_amdgcn_s_barrier(); asm volatile("" ::: "memory");
            if (br == 1 && n + 1 < NCH) {
                const int chn = dir == 0 ? n + 1 : (n + 1 < 2 ? 1 - (n + 1) : NCH + 1 - (n + 1)); const size_t rown = (size_t)b * TT + chn * 128;
                const size_t gl = ((size_t)dir * MROWS + rown + (dir == 0 ? 127 : 0)) * 8 + hh; pf_mxl = GMX[gl]; pf_total = GCUM[gl];
                if (tid < 128) { const size_t gi = ((size_t)dir * MROWS + rown + tid) * 8 + hh; pf_a = GA[gi]; pf_mx = GMX[gi]; pf_cum = GCUM[gi]; } }
            if (br == 1) {
                const int i = tid >> 2, part = tid & 3; float s = 0.f;
#pragma unroll
                for (int c = 0; c < 4; ++c) { const u32x4 qw = *(const LAS u32x4*)(LQ + off_b(i, 4 * part + c)); const LAS float* nv = NV + 32 * part + 8 * c;
                    s += bflo(qw.x) * nv[0] + bfhi(qw.x) * nv[1] + bflo(qw.y) * nv[2] + bfhi(qw.y) * nv[3] + bflo(qw.z) * nv[4] + bfhi(qw.z) * nv[5] + bflo(qw.w) * nv[6] + bfhi(qw.w) * nv[7]; }
                s = quad_sum(s);
                if (part == 0) QN[i] = s;
            }
            LAS unsigned char* const vb0 = LV + (wave >> 2) * 32768 + tb0 + ((unsigned)(64 * (wave & 3)) ^ txs0); LAS unsigned char* const vb1 = LV + (wave >> 2) * 32768 + tb1 + ((unsigned)(64 * (wave & 3)) ^ txs1);
#pragma unroll
            for (int hf = 0; hf < 2; ++hf) {
                const int jb = wave >> 1, ibp = 2 * hf + (wave & 1);
                f32x16 PT;
#pragma unroll
                for (int e = 0; e < 16; ++e) PT[e] = 0.f;
#pragma unroll
                for (int s = 0; s < 8; ++s) {
                    const bf16x8 ka = *(const LAS bf16x8*)(LK + 8192 * jb + rb + ((unsigned)(32 * s) ^ swh16));
                    const bf16x8 qb = *(const LAS bf16x8*)(LQ + 8192 * ibp + rb + ((unsigned)(32 * s) ^ swh16));
                    PT = MFMA32(ka, qb, PT);
                }
                { const int i = 32 * ibp + r; const float ri = RI[i]; float rsum = 0.f;
#pragma unroll
                  for (int g = 0; g < 4; ++g) { const f32x4 cj4 = *(const LAS f32x4*)(CJ + 32 * jb + 8 * g + 4 * h);
#pragma unroll
                      for (int e = 0; e < 4; ++e) { const int j = 32 * jb + 8 * g + 4 * h + e; const bool ok = dir == 0 ? (j <= i) : (j >= i);
                          const float f = ok ? __builtin_amdgcn_exp2f(cj4[e] - ri) : 0.f; const float pv = PT[4 * g + e] * f; PT[4 * g + e] = pv; rsum += pv; } }
                  if (br == 1) { rsum += bperm_f(rsum, lane ^ 32); if (h == 0) RSUM[jb * 128 + i] = rsum; } }
                if (hf == 0) VM_WAIT();
                __syncthreads();
                if (hf == 1 && n >= NSPLIT) reduce_ss(PSUMh, PSUMh2, tid, SSh + row0 + 0);
#pragma unroll
                for (int g = 0; g < 4; ++g) { u32x2 w; w.x = pk2(PT[4 * g], PT[4 * g + 1]); w.y = pk2(PT[4 * g + 2], PT[4 * g + 3]);
                    *(LAS u32x2*)(LP + 8192 * (wave & 1) + rb8h + ((unsigned)(64 * jb + 16 * g) ^ sw16)) = w; }
                if (br == 1 && tid < 64) { const int i = 64 * hf + tid; const float den = (RSUM[i] + RSUM[128 + i]) + (RSUM[256 + i] + RSUM[384 + i]) + RS[i] * QN[i]; INV[i] = 1.0f / fmaxf(fabsf(den), EMT[i]); }
                __syncthreads();
                {
                    u32x4 pw[2][2];
                    if (n >= NSPLIT) { const char* pp = IMGq + (size_t)(NCH + 1 - n) * 8 * 8192 + (2 * hf) * 32;
                        pw[0][0] = *(const u32x4*)pp; pw[0][1] = *(const u32x4*)(pp + 16); pw[1][0] = *(const u32x4*)(pp + 32); pw[1][1] = *(const u32x4*)(pp + 48); }
#pragma unroll
                    for (int q = 0; q < 2; ++q) {
                        const int ib = 2 * hf + q;
                        f32x16 Y;
#pragma unroll
                        for (int e = 0; e < 16; ++e) Y[e] = 0.f;
#pragma unroll
                        for (int t = 0; t < 4; ++t)
#pragma unroll
                            for (int s = 0; s < 2; ++s) {
                                u32x4 sw_; sw_.x = pk2(S[t][8 * s], S[t][8 * s + 1]); sw_.y = pk2(S[t][8 * s + 2], S[t][8 * s + 3]); sw_.z = pk2(S[t][8 * s + 4], S[t][8 * s + 5]); sw_.w = pk2(S[t][8 * s + 6], S[t][8 * s + 7]);
                                const bf16x8 bs = __builtin_bit_cast(bf16x8, sw_);
                                const s16x4 a0 = *(const LAS s16x4*)(LQ + 8192 * ib + rb8h + ((unsigned)((4 * t + 2 * s) * 16) ^ sw16));
                                const s16x4 a1 = *(const LAS s16x4*)(LQ + 8192 * ib + rb8h + ((unsigned)((4 * t + 2 * s + 1) * 16) ^ sw16));
                                const bf16x8 av = __builtin_shufflevector(a0, a1, 0, 1, 2, 3, 4, 5, 6, 7);
                                Y = MFMA32(av, bs, Y);
                            }
#pragma unroll
                        for (int g = 0; g < 4; ++g) { const f32x4 rs4 = *(const LAS f32x4*)(RS + 32 * ib + 8 * g + 4 * h);
#pragma unroll
                            for (int e = 0; e < 4; ++e) Y[4 * g + e] *= rs4[e]; }
#pragma unroll
                        for (int ks = 0; ks < 8; ++ks) { const bf16x8 bvk = tr_frag2(vb0 + 4096 * ks, vb1 + 4096 * ks);
                            const bf16x8 pa = *(const LAS bf16x8*)(LP + 8192 * q + rb + ((unsigned)(32 * ks) ^ swh16)); Y = MFMA32(pa, bvk, Y); }
                        if (br == 1) {
#pragma unroll
                            for (int g = 0; g < 4; ++g) { const f32x4 sc4 = *(const LAS f32x4*)(INV + 32 * ib + 8 * g + 4 * h);
#pragma unroll
                                for (int e = 0; e < 4; ++e) Y[4 * g + e] *= sc4[e]; } }
                        if (n < NSPLIT) { char* op = IMGs + (size_t)n * 8 * 8192 + (2 * hf + q) * 32;
                            u32x4 w0, w1; w0.x = pk2(Y[0], Y[1]); w0.y = pk2(Y[2], Y[3]); w0.z = pk2(Y[4], Y[5]); w0.w = pk2(Y[6], Y[7]);
                            w1.x = pk2(Y[8], Y[9]); w1.y = pk2(Y[10], Y[11]); w1.z = pk2(Y[12], Y[13]); w1.w = pk2(Y[14], Y[15]);
                            *(u32x4*)op = w0; *(u32x4*)(op + 16) = w1;
                        } else { add_image(Y, pw[q][0], pw[q][1]); emit_q(Y, q, PSUMh, PSUMh2, wave, lane, r, h, Yrow, hf); }
                    }
                }
            }
#pragma unroll
            for (int t = 0; t < 4; ++t)
#pragma unroll
                for (int e = 0; e < 16; ++e) S[t][e] *= dec;
#pragma unroll
            for (int ks = 0; ks < 8; ++ks) {
                const f32x4 w0 = *(const LAS f32x4*)(WW + 16 * ks + 8 * h), w1 = *(const LAS f32x4*)(WW + 16 * ks + 8 * h + 4);
                const bf16x8 bvk = tr_frag2(vb0 + 4096 * ks, vb1 + 4096 * ks);
                const u32x4 vw = __builtin_bit_cast(u32x4, bvk);
                u32x4 sw; sw.x = pk2(bflo(vw.x) * w0[0], bfhi(vw.x) * w0[1]); sw.y = pk2(bflo(vw.y) * w0[2], bfhi(vw.y) * w0[3]); sw.z = pk2(bflo(vw.z) * w1[0], bfhi(vw.z) * w1[1]); sw.w = pk2(bflo(vw.w) * w1[2], bfhi(vw.w) * w1[3]);
                const bf16x8 bw = __builtin_bit_cast(bf16x8, sw);
                bf16x8 ka[4];
#pragma unroll
                for (int t = 0; t < 4; ++t) ka[t] = tr_frag2(LK + 4096 * ks + tb0 + ((unsigned)(64 * t) ^ txs0), LK + 4096 * ks + tb1 + ((unsigned)(64 * t) ^ txs1));
                __builtin_amdgcn_sched_barrier(0);
#pragma unroll
                for (int t = 0; t < 4; ++t) S[t] = MFMA32(ka[t], bw, S[t]);
            }
            if (br == 1) {
                const int dg = tid & 15, jp = tid >> 4; float s8[8];
#pragma unroll
                for (int e = 0; e < 8; ++e) s8[e] = 0.f;
#pragma unroll
                for (int jj = 0; jj < 4; ++jj) { const int j = 4 * jp + jj; const u32x4 kw = *(const LAS u32x4*)(LK + off_b(j, dg)); const float wj = WW[j];
                    s8[0] += wj * bflo(kw.x); s8[1] += wj * bfhi(kw.x); s8[2] += wj * bflo(kw.y); s8[3] += wj * bfhi(kw.y); s8[4] += wj * bflo(kw.z); s8[5] += wj * bfhi(kw.z); s8[6] += wj * bflo(kw.w); s8[7] += wj * bfhi(kw.w); }
#pragma unroll
                for (int e = 0; e < 8; ++e) { s8[e] += swz_xor16(s8[e]); s8[e] += bperm_f(s8[e], lane ^ 32); }
                if ((tid & 63) < 16) {
#pragma unroll
                    for (int e = 0; e < 8; ++e) NP2[wave * 128 + 8 * dg + e] = s8[e]; }
            }
            __syncthreads();
            if (n >= NSPLIT) reduce_ss(PSUMh, PSUMh2, tid, SSh + row0 + 64);
            if (br == 1) { if (tid < 128) NV[tid] = dec * NV[tid] + ((NP2[tid] + NP2[128 + tid]) + (NP2[256 + tid] + NP2[384 + tid])) + ((NP2[512 + tid] + NP2[640 + tid]) + (NP2[768 + tid] + NP2[896 + tid])); m = m_next; }
        }
        { __syncthreads();
          int tidc = tid_; asm volatile("" : "+v"(tidc));
          const int lanec = tidc & 63, rc = tidc & 31, hc = (tidc >> 5) & 1;
          char* const IMGoc = (char*)(C.ws + WS_IMG) + ((size_t)u * NSPLIT * 8 + wave) * 8192 + lanec * 128; const char* const IMGpc = (const char*)(C.ws + WS_IMG) + ((size_t)(u ^ 1) * NSPLIT * 8 + wave) * 8192 + lanec * 128;
          char* const YNc = Yob + ((size_t)b * TT + (dir == 0 ? 0 : 128)) * (size_t)(DM * 2);
#pragma unroll
          for (int hf = 0; hf < 2; ++hf) {
#pragma unroll
              for (int q = 0; q < 2; ++q) { f32x16 Yc;
#pragma unroll
                  for (int e = 0; e < 16; ++e) Yc[e] = 0.f;
                  const u32x4 o0 = *(const u32x4*)(IMGoc + (2 * hf + q) * 32), o1 = *(const u32x4*)(IMGoc + (2 * hf + q) * 32 + 16);
                  const u32x4 p0 = *(const u32x4*)(IMGpc + (size_t)8 * 8192 + (2 * hf + q) * 32), p1 = *(const u32x4*)(IMGpc + (size_t)8 * 8192 + (2 * hf + q) * 32 + 16);
                  add_image(Yc, o0, o1); add_image(Yc, p0, p1); emit_q(Yc, q, PSUMh, PSUMh2, wave, lanec, rc, hc, YNc, hf); }
              __syncthreads(); reduce_ss(PSUMh, PSUMh2, tidc, SSh + (size_t)b * TT + (dir == 0 ? 0 : 128) + 64 * hf); __syncthreads(); } }
    }
}
__device__ __forceinline__ void unpack8(const u32x4 w, float (&f)[8]) { f[0] = bflo(w.x); f[1] = bfhi(w.x); f[2] = bflo(w.y); f[3] = bfhi(w.y); f[4] = bflo(w.z); f[5] = bfhi(w.z); f[6] = bflo(w.w); f[7] = bfhi(w.w); }
__device__ __forceinline__ void conv_fix_phase(const Ctx& C, int l) {
    const bf16* RAW = (const bf16*)(C.ws + WS_RAW); bf16* ACT = (bf16*)(C.ws + WS_ACT);
    const float* fw = C.inp(17) + (size_t)l * 3 * UPN; const float* fb = C.inp(18) + (size_t)l * UPN;
    const int gt = C.vcu * NTHR + C.tid, NT = C.G * NTHR;
    for (int idx = gt; idx < (MROWS / 256) * 2 * 704; idx += NT) {
        const int pm = idx / 1408, rem = idx - pm * 1408, k = rem / 704, cg = rem - k * 704, j = pm % 17;
        if (j == 0 || (k == 0 && j == 1) || (k == 1 && j == 16)) continue;
        const bf16* P = k == 0 ? RAW + ((size_t)(pm - 1) * 4 + 3) * UPN : RAW + ((size_t)pm * 4 + 2) * UPN;
        const bf16* Cc = k == 0 ? RAW + ((size_t)pm * 4 + 0) * UPN : RAW + ((size_t)pm * 4 + 3) * UPN;
        const bf16* Nn = k == 0 ? RAW + ((size_t)pm * 4 + 1) * UPN : RAW + ((size_t)(pm + 1) * 4 + 0) * UPN;
        const size_t row = (size_t)pm * 256 + (k ? 255 : 0);
        float pa[8], ca[8], na[8], pg[8], cgv[8], ng[8];
        unpack8(*(const u32x4*)(P + cg * 8), pa); unpack8(*(const u32x4*)(Cc + cg * 8), ca); unpack8(*(const u32x4*)(Nn + cg * 8), na);
        unpack8(*(const u32x4*)(P + FF + cg * 8), pg); unpack8(*(const u32x4*)(Cc + FF + cg * 8), cgv); unpack8(*(const u32x4*)(Nn + FF + cg * 8), ng);
        float o[8];
#pragma unroll
        for (int e = 0; e < 8; ++e) { const int ca_ = cg * 8 + e, cgc = FF + cg * 8 + e;
            const float a = fb[ca_] + fw[ca_] * pa[e] + fw[UPN + ca_] * ca[e] + fw[2 * UPN + ca_] * na[e];
            const float g = fb[cgc] + fw[cgc] * pg[e] + fw[UPN + cgc] * cgv[e] + fw[2 * UPN + cgc] * ng[e];
            o[e] = silu_f(a) * g; }
        u32x4 w; w.x = pk2(o[0], o[1]); w.y = pk2(o[2], o[3]); w.z = pk2(o[4], o[5]); w.w = pk2(o[6], o[7]);
        *(u32x4*)(ACT + row * FF + cg * 8) = w;
    }
}
#ifndef PHASE_MASK
#define PHASE_MASK 0xFFFFFFFFu
#endif
#ifndef DOUBLE_MASK
#define DOUBLE_MASK 0u
#endif
constexpr int CV_TF0 = 0, CV_TF1 = 4500, CV_TG1 = CV_I3, CV_TK = CV_I5;
#define TAILCV(lo, hi) if (l + 1 < NLAYER && C.G == 256) { __syncthreads(); refresh(C); const int ci_ = BX - 64; convert_weights(C, l + 1, (lo), (hi), ci_ >= 0 ? ci_ * NWAVES + C.wave : -1, 192 * NWAVES); } \
                       else if (l + 1 < NLAYER) { __syncthreads(); refresh(C); convert_weights(C, l + 1, (lo), (hi), C.vcu * NWAVES + C.wave, C.G * NWAVES); }
#define BX ((C.vcu & 31) * 8 + (C.vcu >> 5))
#define RUN(n) refresh(C); if ((PHASE_MASK >> (n)) & 1u)
#define DUP(n, ...) if ((DOUBLE_MASK >> (n)) & 1u) { __syncthreads(); refresh(C); __VA_ARGS__; }
__device__ __forceinline__ void refresh(Ctx& C) {
    asm volatile("" : "+v"(C.tid)); asm volatile("" : "+s"(C.vcu)); C.lane = C.tid & 63;
}
#define GRID_BAR() do { XcdBarrier b2_ = bar; asm volatile("" : "+s"(b2_.bar), "+s"(b2_.x)); xcd_barrier(b2_); } while (0)
constexpr int WGM_NARROW = 4;
constexpr bool GEMM_SP2 = true, GEMM_ALIGN = true;
struct Params { const float* in[20]; float* out; unsigned char* ws; };
__global__ void __launch_bounds__(NTHR, 2) fwd_kernel(Params prm) {
    extern __shared__ __attribute__((aligned(16))) unsigned char lds_raw[];
    Ctx C;
    C.lds = (LAS unsigned char*)lds_raw;
    C.tid = threadIdx.x; C.lane = C.tid & 63; C.wave = __builtin_amdgcn_readfirstlane(C.tid >> 6);
    C.G = 256; { const int bx = blockIdx.x; C.vcu = (bx % 8) * (C.G / 8) + bx / 8; }
    C.out = prm.out; C.ws = prm.ws;
    volatile LAS unsigned* MISC = (volatile LAS unsigned*)(C.lds + MISC_OFF);
    if (C.tid < 16) MISC[C.tid] = 0u;
    __syncthreads();
    XcdBarrier bar = xcd_barrier_post((unsigned*)(C.ws + WS_CTL), MISC + 8);
    unsigned char* ws = C.ws;
    const float* MOD = (const float*)(ws + WS_MOD);
    bf16* Hb = (bf16*)(ws + WS_H);
    float* XC = (float*)(ws + WS_XC);

    RUN(0) mod_phase(C, 0, NLAYER, C.vcu, C.G); RUN(1) rope_table(C); __syncthreads(); RUN(2) convert_weights(C, 0, 0, CV_I4, C.vcu * NWAVES + C.wave, C.G * NWAVES);
    DUP(2, convert_weights(C, 0, 0, CV_I4, C.vcu * NWAVES + C.wave, C.G * NWAVES))
    DUP(0, mod_phase(C, 0, NLAYER, C.vcu, C.G))
    GRID_BAR();
    RUN(3) rn_phase<false, true>(C, 0, C.inp(0), C.inp(2), nullptr, nullptr, nullptr, nullptr, 0, nullptr, MOD, 0, 1, C.inp(6), Hb);
    DUP(3, rn_phase<false, true>(C, 0, C.inp(0), C.inp(2), nullptr, nullptr, nullptr, nullptr, 0, nullptr, MOD, 0, 1, C.inp(6), Hb))
    GRID_BAR();

    for (int l = 0; l < NLAYER; ++l) {
        const float* MODl = MOD + (size_t)l * 9 * MODW;
        const int lastl = (l == NLAYER - 1) ? 1 : 0;
        const int MG = lastl ? NB * SEQ : MROWS;
        RUN(4) { pg8::Gemm g{Hb, (const bf16*)(ws + WS_W1T), MROWS, N1, DM}; pg8::StaticOrder S; S.init(MROWS, N1, C.G, BX);
          pg8::EpiProj1 E{(bf16*)(ws + WS_PROJ), (float*)(ws + WS_GATES), C.inp(10) + (size_t)l * 32, (const float*)(ws + WS_ROPE), (const float*)(ws + WS_ROPE) + 2048,
                           (bf16*)(ws + WS_MQK), (bf16*)(ws + WS_RAWQ), C.inp(8) + (size_t)l * 3 * 2048, C.inp(9) + (size_t)l * 2048, (LAS float*)(C.lds + PBUF_OFF)};
          pg8::gemm_phase<pg8::EpiProj1, pg8::StaticOrder, GEMM_ALIGN, GEMM_SP2>(C.lds, g, S, E, C.tid); }
        DUP(4, { pg8::Gemm g{Hb, (const bf16*)(ws + WS_W1T), MROWS, N1, DM}; pg8::StaticOrder S; S.init(MROWS, N1, C.G, BX);
          pg8::EpiProj1 E{(bf16*)(ws + WS_PROJ), (float*)(ws + WS_GATES), C.inp(10) + (size_t)l * 32, (const float*)(ws + WS_ROPE), (const float*)(ws + WS_ROPE) + 2048,
                           (bf16*)(ws + WS_MQK), (bf16*)(ws + WS_RAWQ), C.inp(8) + (size_t)l * 3 * 2048, C.inp(9) + (size_t)l * 2048, (LAS float*)(C.lds + PBUF_OFF)};
          pg8::gemm_phase<pg8::EpiProj1, pg8::StaticOrder, GEMM_ALIGN, GEMM_SP2>(C.lds, g, S, E, C.tid); })
        { __syncthreads(); refresh(C); const int ci_ = BX - 136; const int iw_ = ci_ >= 0 ? ci_ * NWAVES + C.wave : -1;
          convert_weights(C, l, CV_I4, lastl ? CV_I6 : CV_I5, iw_, 120 * NWAVES);
          if (l > 0) convert_weights(C, l, CV_I3, CV_I4, iw_, 120 * NWAVES); }
        GRID_BAR();
        RUN(5) conv_gate_phase(C, l);
        DUP(5, conv_gate_phase(C, l))
        GRID_BAR();
        RUN(6) scan_phase(C, l, bar);
        DUP(6, scan_phase(C, l, bar))
        GRID_BAR();
        RUN(7) { pg8::Gemm g{Hb, (const bf16*)(ws + WS_W2T), MROWS, N2, DM}; pg8::StaticOrder S; S.init(MG, N2, C.G, BX, lastl);
          pg8::EpiMerge E{(bf16*)(ws + WS_Y4), (size_t)MROWS * DM, C.inp(12) + (size_t)l * 2 * DM, (bf16*)(ws + WS_PROJ), LDP, (const float*)(ws + WS_SS), MROWS, EPSN};
          pg8::gemm_phase<pg8::EpiMerge, pg8::StaticOrder, true, GEMM_SP2>(C.lds, g, S, E, C.tid); }
        GRID_BAR();
        unsigned* const ctl = (unsigned*)(ws + WS_CTL);
        const int bb = C.vcu >> 5, clx = C.vcu & 31; const bool ctxcu = !lastl && clx < 8;
        RUN(9) { pg8::Gemm g{(const bf16*)(ws + WS_Y4), (const bf16*)(ws + WS_WRO), MROWS, DM, DM}; pg8::StaticOrder S; S.init(NB * SEQ, DM, C.G, BX, 1, WGM_NARROW);
          pg8::EpiGate<false> E{(bf16*)(ws + WS_Y4 + SLOT), DM, (const bf16*)(ws + WS_PROJ) + 4096, LDP, nullptr, nullptr};
          pg8::gemm_phase<pg8::EpiGate<false>, pg8::StaticOrder, GEMM_ALIGN, GEMM_SP2>(C.lds, g, S, E, C.tid); }
        RUN(10) { pg8::Gemm g{(const bf16*)(ws + WS_Y4 + 2 * SLOT), (const bf16*)(ws + WS_WMO), MROWS, DM, DM}; pg8::StaticOrder S; S.init(NB * SEQ, DM, C.G, BX, 1, WGM_NARROW); if (!lastl) S.sig = 1;
          pg8::EpiGate<true> E{(bf16*)(ws + WS_Y4 + SLOT), DM, (const bf16*)(ws + WS_PROJ) + 6144, LDP, ctl + 5120, ctl + 5376 + 64 * bb};
          pg8::gemm_phase<pg8::EpiGate<true>, pg8::StaticOrder, GEMM_ALIGN, GEMM_SP2>(C.lds, g, S, E, C.tid); }
        RUN(9) { pg8::Gemm g{(const bf16*)(ws + WS_Y4), (const bf16*)(ws + WS_WRO), MROWS, DM, DM}; pg8::StaticOrder S; S.init(0, DM, C.G, BX, 0, WGM_NARROW); if (ctxcu) { S.sig = 1; S.xpm = 17 * bb; S.xpn = clx; }
          pg8::EpiGate<false> E{(bf16*)(ws + WS_Y4 + SLOT), DM, (const bf16*)(ws + WS_PROJ) + 4096, LDP, nullptr, nullptr};
          pg8::gemm_phase<pg8::EpiGate<false>, pg8::StaticOrder, GEMM_ALIGN, GEMM_SP2>(C.lds, g, S, E, C.tid); }
        RUN(10) { pg8::Gemm g{(const bf16*)(ws + WS_Y4 + 2 * SLOT), (const bf16*)(ws + WS_WMO), MROWS, DM, DM}; pg8::StaticOrder S; S.init(0, DM, C.G, BX, 0, WGM_NARROW); if (ctxcu) { S.sig = 1; S.xpm = 17 * bb; S.xpn = clx; }
          pg8::EpiGate<true> E{(bf16*)(ws + WS_Y4 + SLOT), DM, (const bf16*)(ws + WS_PROJ) + 6144, LDP, ctl + 5120, ctl + 5376 + 64 * bb};
          pg8::gemm_phase<pg8::EpiGate<true>, pg8::StaticOrder, GEMM_ALIGN, GEMM_SP2>(C.lds, g, S, E, C.tid); }
        if (lastl) GRID_BAR();
        else { refresh(C); wait_count(C, ctl + 5120, 256u * (unsigned)(l + 1)); if (ctxcu) wait_count(C, ctl + 5376 + 64 * bb, 8u * (unsigned)(l + 1)); }
        RUN(11) { pg8::Gemm g{(const bf16*)(ws + WS_Y4 + SLOT), (const bf16*)(ws + WS_WO), MROWS, DM, DM}; pg8::StaticOrder S;
          if (lastl) S.init(NB * SEQ, DM, C.G, BX, 1, WGM_NARROW);
          else if (!ctxcu) { S.init(NB * SEQ, DM, 192, bb + 8 * (clx - 8), 1, WGM_NARROW); S.lim = 960; }
          else { S.init(NB * SEQ, DM, 64, bb + 8 * clx, 1, WGM_NARROW); S.base = 960; S.xpm = 17 * bb; S.xpn = clx; }
          pg8::EpiPlain E{(bf16*)(ws + WS_Y4 + 3 * SLOT), DM, nullptr, nullptr};
          pg8::gemm_phase<pg8::EpiPlain, pg8::StaticOrder, GEMM_ALIGN, GEMM_SP2>(C.lds, g, S, E, C.tid); }
        if (!lastl) { __syncthreads(); refresh(C); convert_weights(C, l, CV_I5, CV_I6, ctxcu ? (bb * 8 + clx) * NWAVES + C.wave : -1, 64 * NWAVES); }
        GRID_BAR();
        RUN(12) rn_phase<true, true>(C, lastl, l == 0 ? C.inp(0) : C.out, l == 0 ? C.inp(2) : XC, C.out, XC, (const bf16*)(ws + WS_Y4 + 3 * SLOT),
                             MODl, 2, C.inp(6) + ((size_t)l * 4 + 1) * DM, MODl, 3, 4, C.inp(6) + ((size_t)l * 4 + 2) * DM, Hb);
        GRID_BAR();
        RUN(13) { pg8::Gemm g{Hb, (const bf16*)(ws + WS_WUT), MROWS, UPN, DM}; pg8::StaticOrder S; S.init(MG, UPN, C.G, BX, lastl);
          pg8::EpiConvAct E{(bf16*)(ws + WS_ACT), (bf16*)(ws + WS_RAW), C.inp(17) + (size_t)l * 3 * UPN, C.inp(18) + (size_t)l * UPN, (LAS float*)(C.lds + PBUF_OFF), FF, UPN};
          pg8::gemm_phase<pg8::EpiConvAct, pg8::StaticOrder, true, GEMM_SP2>(C.lds, g, S, E, C.tid); }
        DUP(13, { pg8::Gemm g{Hb, (const bf16*)(ws + WS_WUT), MROWS, UPN, DM}; pg8::StaticOrder S; S.init(MG, UPN, C.G, BX, lastl);
          pg8::EpiConvAct E{(bf16*)(ws + WS_ACT), (bf16*)(ws + WS_RAW), C.inp(17) + (size_t)l * 3 * UPN, C.inp(18) + (size_t)l * UPN, (LAS float*)(C.lds + PBUF_OFF), FF, UPN};
          pg8::gemm_phase<pg8::EpiConvAct, pg8::StaticOrder, true, GEMM_SP2>(C.lds, g, S, E, C.tid); })
        if (l + 1 < NLAYER) { __syncthreads(); refresh(C); const int ci_ = BX - 96; convert_weights(C, l + 1, 0, CV_I3, ci_ >= 0 ? ci_ * NWAVES + C.wave : -1, 160 * NWAVES); }
        GRID_BAR();
        RUN(14) conv_fix_phase(C, l);
        GRID_BAR();
        RUN(15) { pg8::Gemm g{(const bf16*)(ws + WS_ACT), (const bf16*)(ws + WS_WDT), MROWS, DM, FF}; pg8::StaticOrder S; S.init(NB * SEQ, DM, C.G, BX, 1, WGM_NARROW);
          if (!lastl) { S.sig = 1; if ((C.vcu & 31) < 8) { S.xpm = 17 * (C.vcu >> 5); S.xpn = C.vcu & 31; } }
          pg8::EpiPlain E{(bf16*)(ws + WS_OUTF), DM, ctl + 4096, ctl + 4352 + 64 * (C.vcu >> 5)};
          pg8::gemm_phase<pg8::EpiPlain, pg8::StaticOrder, GEMM_ALIGN, GEMM_SP2>(C.lds, g, S, E, C.tid); }
        if (lastl) GRID_BAR();
        if (l + 1 < NLAYER) {
            RUN(16) rn_phase<true, true>(C, 0, C.out, XC, C.out, XC, (const bf16*)(ws + WS_OUTF), MODl, 5, C.inp(6) + ((size_t)l * 4 + 3) * DM,
                                 MODl + 9 * MODW, 0, 1, C.inp(6) + ((size_t)(l + 1) * 4) * DM, Hb, ctl + 4096, 256u * (unsigned)(l + 1), ctl + 4352 + 64 * (C.vcu >> 5), 8u * (unsigned)(l + 1));
            GRID_BAR();
        } else {
            RUN(16) rn_phase<true, false>(C, 1, C.out, XC, C.out, XC, (const bf16*)(ws + WS_OUTF), MODl, 5, C.inp(6) + ((size_t)l * 4 + 3) * DM, nullptr, 0, 0, nullptr, nullptr);
        }
    }
}

extern "C" void kernel_launch(void* const* d_in, const int* in_sizes, int n_in, void* d_out, int out_size, void* d_ws, size_t ws_size, hipStream_t stream) {
    static int grid = 0;
    if (grid == 0) {
        if (n_in != 20 || ws_size < WS_END) { fprintf(stderr, "kernel_launch: need 20 inputs and >= %zu bytes of workspace (got %d, %zu)\n", (size_t)WS_END, n_in, ws_size); grid = -1; return; }
        int dev = 0, cus = 0, per_cu = 0;
        if (hipGetDevice(&dev) != hipSuccess || hipDeviceGetAttribute(&cus, hipDeviceAttributeMultiprocessorCount, dev) != hipSuccess) { grid = -1; return; }
        if (hipFuncSetAttribute((const void*)fwd_kernel, hipFuncAttributeMaxDynamicSharedMemorySize, LDS_BYTES) != hipSuccess) { fprintf(stderr, "kernel_launch: hipFuncSetAttribute failed\n"); grid = -1; return; }
        if (hipOccupancyMaxActiveBlocksPerMultiprocessor(&per_cu, (const void*)fwd_kernel, NTHR, LDS_BYTES) != hipSuccess || per_cu < 1) { fprintf(stderr, "kernel_launch: occupancy query says %d blocks per CU\n", per_cu); (void)hipGetLastError(); grid = -1; return; }
        grid = cus;
        if (grid != 256) { fprintf(stderr, "kernel_launch: built for 256 CUs (one scan unit per workgroup, mid-phase grid barrier); this device has %d\n", cus); grid = -1; return; }
    }
    if (grid < 0) return;
    (void)in_sizes; (void)out_size;
    if (hipMemsetAsync((char*)d_ws + WS_CTL, 0, CTL_ZERO_BYTES, stream) != hipSuccess) return;
    Params p{};
    for (int i = 0; i < 20; ++i) p.in[i] = (const float*)d_in[i];
    p.out = (float*)d_out; p.ws = (unsigned char*)d_ws;
    hipLaunchKernelGGL(fwd_kernel, dim3(grid), dim3(NTHR), LDS_BYTES, stream, p);
}
```
